# Optimizing an MI355X kernel written in HIP

```python
import math
import jax, jax.numpy as jnp
from jax import lax
import numpy as np

D_MODEL = 1024
BATCH = 2
SEQ = 8192
DEPTH = 4

SSM_GROUP = 16
N_GROUPS = D_MODEL // SSM_GROUP
SSM_STATE = 64
N_HEADS = 16
HEAD_DIM = D_MODEL // N_HEADS
ATTN_DIM = N_HEADS * HEAD_DIM
D_FF = 4 * D_MODEL
Q_BLOCK = 128
N_A_LAYERS = DEPTH // 2
N_B_LAYERS = DEPTH - N_A_LAYERS
RMS_EPS = 1e-6
DT_MIN = 1e-3
DT_MAX = 1e-1

kernel_name = "s5_fox_yoco_hybrid_trunk"


def rmsnorm(x, g):
    xf = x.astype(jnp.float32)
    y = xf * lax.rsqrt(jnp.mean(xf * xf, axis=-1, keepdims=True) + RMS_EPS)
    return (y * g.astype(jnp.float32)).astype(x.dtype)


def sqrelu_mlp(h, w1, w2):
    a = jnp.square(jax.nn.relu(h @ w1))
    return a @ w2


def _ssm_binop(e1, e2):
    a1, b1 = e1
    a2, b2 = e2
    return a2 * a1, a2 * b1 + b2


def s5_mixer(u, log_dt, a_re, a_im, b_re, b_im, c_re, c_im, d_skip, w_glu):
    f32 = jnp.float32
    bsz, length, _ = u.shape
    uf = u.astype(f32).reshape(bsz, length, N_GROUPS, SSM_GROUP)
    lam = lax.complex(a_re.astype(f32), a_im.astype(f32))
    dt = jnp.exp(log_dt.astype(f32))[:, None]
    lam_bar = jnp.exp(lam * dt)
    b = lax.complex(b_re.astype(f32), b_im.astype(f32))
    b_bar = ((lam_bar - 1.0) / lam)[..., None] * b
    bu = jnp.einsum('blgc,gpc->blgp', uf.astype(jnp.complex64), b_bar)
    a_elems = jnp.broadcast_to(lam_bar, bu.shape)
    _, states = lax.associative_scan(_ssm_binop, (a_elems, bu), axis=1)
    c = lax.complex(c_re.astype(f32), c_im.astype(f32))
    y = jnp.real(jnp.einsum('blgp,gcp->blgc', states, c))
    y = y + d_skip.astype(f32).reshape(N_GROUPS, SSM_GROUP) * uf
    z = jax.nn.gelu(y.reshape(bsz, length, D_MODEL)).astype(u.dtype)
    zw = z @ w_glu
    val, gate = zw[..., :D_MODEL], zw[..., D_MODEL:]
    return val * jax.nn.sigmoid(gate)


def shared_kv(h, kv_norm, w_kvf, b_f):
    bsz, length, _ = h.shape
    kvf = rmsnorm(h, kv_norm) @ w_kvf
    k = kvf[..., :ATTN_DIM].reshape(bsz, length, N_HEADS, HEAD_DIM).transpose(0, 2, 1, 3)
    v = kvf[..., ATTN_DIM:2 * ATTN_DIM].reshape(bsz, length, N_HEADS, HEAD_DIM).transpose(0, 2, 1, 3)
    f_logit = kvf[..., 2 * ATTN_DIM:].astype(jnp.float32) + b_f.astype(jnp.float32)
    log_f = jax.nn.log_sigmoid(f_logit)
    cum_log_f = jnp.cumsum(log_f, axis=1).transpose(0, 2, 1)
    return k, v, cum_log_f


def fox_attention(hn, wq, wo, k, v, cum_log_f):
    bsz, length, _ = hn.shape
    nb = length // Q_BLOCK
    q = (hn @ wq) * (HEAD_DIM ** -0.5)
    q_blocks = q.reshape(bsz, nb, Q_BLOCK, N_HEADS, HEAD_DIM).transpose(1, 0, 3, 2, 4)
    f_blocks = cum_log_f.reshape(bsz, N_HEADS, nb, Q_BLOCK).transpose(2, 0, 1, 3)
    pos_q = jnp.arange(length, dtype=jnp.int32).reshape(nb, Q_BLOCK)
    pos_k = jnp.arange(length, dtype=jnp.int32)

    def one_block(args):
        qb, fq, pq = args
        s = jnp.einsum('bhqd,bhkd->bhqk', qb, k).astype(jnp.float32)
        s = s + fq[..., None] - cum_log_f[:, :, None, :]
        mask = pq[:, None] >= pos_k[None, :]
        s = jnp.where(mask[None, None], s, -jnp.inf)
        p = jax.nn.softmax(s, axis=-1)
        return jnp.einsum('bhqk,bhkd->bhqd', p.astype(v.dtype), v)

    o = lax.map(one_block, (q_blocks, f_blocks, pos_q))
    o = o.transpose(1, 0, 3, 2, 4).reshape(bsz, length, ATTN_DIM)
    return o @ wo


def setup_inputs(seed: int = 0) -> dict:
    key = jax.random.key(seed)
    ks = jax.random.split(key, 20)
    f32 = jnp.float32

    def nrm(k, shape, scale):
        return scale * jax.random.normal(k, shape, f32)

    x = nrm(ks[0], (BATCH, SEQ, D_MODEL), 1.0)
    mix_norm = 1.0 + nrm(ks[1], (DEPTH, D_MODEL), 0.05)
    mlp_norm = 1.0 + nrm(ks[2], (DEPTH, D_MODEL), 0.05)
    mlp_w1 = nrm(ks[3], (DEPTH, D_MODEL, D_FF), D_MODEL ** -0.5)
    mlp_w2 = nrm(ks[4], (DEPTH, D_FF, D_MODEL), 0.5 * D_FF ** -0.5)
    ssm_log_dt = jax.random.uniform(ks[5], (N_A_LAYERS, N_GROUPS), f32,
                                    math.log(DT_MIN), math.log(DT_MAX))
    ssm_a_re = -0.5 + nrm(ks[6], (N_A_LAYERS, N_GROUPS, SSM_STATE), 0.01)
    ssm_a_im = math.pi * jnp.arange(SSM_STATE, dtype=f32) + nrm(ks[7], (N_A_LAYERS, N_GROUPS, SSM_STATE), 0.01)
    ssm_b_re = nrm(ks[8], (N_A_LAYERS, N_GROUPS, SSM_STATE, SSM_GROUP), (2 * SSM_GROUP) ** -0.5)
    ssm_b_im = nrm(ks[9], (N_A_LAYERS, N_GROUPS, SSM_STATE, SSM_GROUP), (2 * SSM_GROUP) ** -0.5)
    ssm_c_re = nrm(ks[10], (N_A_LAYERS, N_GROUPS, SSM_GROUP, SSM_STATE), (2 * SSM_STATE) ** -0.5)
    ssm_c_im = nrm(ks[11], (N_A_LAYERS, N_GROUPS, SSM_GROUP, SSM_STATE), (2 * SSM_STATE) ** -0.5)
    ssm_d = nrm(ks[12], (N_A_LAYERS, D_MODEL), 1.0)
    ssm_w_glu = nrm(ks[13], (N_A_LAYERS, D_MODEL, 2 * D_MODEL), D_MODEL ** -0.5)
    kv_norm = 1.0 + nrm(ks[14], (D_MODEL,), 0.05)
    w_kvf = nrm(ks[15], (D_MODEL, 2 * ATTN_DIM + N_HEADS), D_MODEL ** -0.5)
    b_f = jax.random.uniform(ks[16], (N_HEADS,), f32, 0.5, 3.0)
    attn_wq = nrm(ks[17], (N_B_LAYERS, D_MODEL, ATTN_DIM), D_MODEL ** -0.5)
    attn_wo = nrm(ks[18], (N_B_LAYERS, ATTN_DIM, D_MODEL), ATTN_DIM ** -0.5)
    final_norm = 1.0 + nrm(ks[19], (D_MODEL,), 0.05)
    return {"x": x, "mix_norm": mix_norm, "mlp_norm": mlp_norm, "mlp_w1": mlp_w1, "mlp_w2": mlp_w2,
            "ssm_log_dt": ssm_log_dt, "ssm_a_re": ssm_a_re, "ssm_a_im": ssm_a_im,
            "ssm_b_re": ssm_b_re, "ssm_b_im": ssm_b_im, "ssm_c_re": ssm_c_re, "ssm_c_im": ssm_c_im,
            "ssm_d": ssm_d, "ssm_w_glu": ssm_w_glu, "kv_norm": kv_norm, "w_kvf": w_kvf, "b_f": b_f,
            "attn_wq": attn_wq, "attn_wo": attn_wo, "final_norm": final_norm}


def reference(x, mix_norm, mlp_norm, mlp_w1, mlp_w2, ssm_log_dt, ssm_a_re, ssm_a_im,
              ssm_b_re, ssm_b_im, ssm_c_re, ssm_c_im, ssm_d, ssm_w_glu, kv_norm, w_kvf, b_f,
              attn_wq, attn_wo, final_norm):
    h = x
    k = v = cum_log_f = None
    for i in range(DEPTH):
        hn = rmsnorm(h, mix_norm[i])
        if i < N_A_LAYERS:
            h = h + s5_mixer(hn, ssm_log_dt[i], ssm_a_re[i], ssm_a_im[i], ssm_b_re[i], ssm_b_im[i],
                             ssm_c_re[i], ssm_c_im[i], ssm_d[i], ssm_w_glu[i])
        else:
            j = i - N_A_LAYERS
            h = h + fox_attention(hn, attn_wq[j], attn_wo[j], k, v, cum_log_f)
        h = h + sqrelu_mlp(rmsnorm(h, mlp_norm[i]), mlp_w1[i], mlp_w2[i])
        if i == N_A_LAYERS - 1:
            k, v, cum_log_f = shared_kv(h, kv_norm, w_kvf, b_f)
    return rmsnorm(h, final_norm)
```

```cpp
#include <hip/hip_runtime.h>
#include <hip/hip_cooperative_groups.h>
#include <hip/hip_bf16.h>
#include <cstdio>
#include <cstdint>
#include <cmath>
namespace cg = cooperative_groups;
#ifndef MK_MULTI_LAUNCH
#define MK_MULTI_LAUNCH 0
#endif
__device__ __forceinline__ int ltid() { int t = (int)threadIdx.x; asm volatile("" : "+v"(t)); return t; }
#ifndef DBG_KM
#define DBG_KM 0xffffu
#endif
#ifndef DBG_SYNC_REPS
#define DBG_SYNC_REPS 1
#endif
#ifndef DBG_DUP
#define DBG_DUP 0u
#endif
#ifndef DBG_SIDE_REPS
#define DBG_SIDE_REPS 1
#endif
#ifndef DBG_PROBE
#define DBG_PROBE 0
#endif
namespace pg8 {
#define PG8_LAS __attribute__((address_space(3)))
typedef unsigned short bf16_t;
typedef short bf16x8 __attribute__((ext_vector_type(8)));
typedef float f32x4 __attribute__((ext_vector_type(4)));
typedef unsigned u32x4 __attribute__((ext_vector_type(4)));
constexpr int BM = 256, BK = 64, HALF = 128, HTB = HALF * BK * 2  , STAGE_BYTES = 8 * HTB, NXCD = 8, WGM = 8;

__host__ __device__ __forceinline__ int lds_byte(int r, int c) { const int st = (r >> 4) * 2 + (c >> 5), rr = r & 15, cc = c & 31, ob = rr * 64 + cc * 2; return st * 1024 + (ob ^ (((ob >> 9) & 1) << 5)); }
__host__ __device__ __forceinline__ void stage_rc(int b, int& R, int& C) { const int st = b / 1024, sb = b % 1024, swz = sb ^ (((sb >> 9) & 1) << 5); R = (st >> 1) * 16 + swz / 64; C = (st & 1) * 32 + (swz % 64) / 2; }
__host__ __device__ __forceinline__ int perm32(int rho) { const int n = rho >> 4, i = rho & 15; return 8 * (i >> 2) + 4 * n + (i & 3); }

struct Unit { int pm, pn; };
struct Gemm { const bf16_t* A; const bf16_t* Bt; int lda, ldb, K; int a_gs = 32, a_ks = 128, a_ts = 512; };

struct StaticOrder {
    int nM, nN, nwg, G, c;
    __host__ __device__ void init(int M, int N, int G_, int c_) { nM = M / BM; nN = N / BM; nwg = nM * nN; G = G_; c = c_; }
    __host__ __device__ bool next(int i, Unit& u) const {
        const long L = (long)i * G + c; if (L >= nwg) return false;
        int wgid = (int)L; { const int q = nwg / NXCD, r = nwg % NXCD, xcd = wgid % NXCD, off = wgid / NXCD; wgid = (xcd < r ? xcd * (q + 1) : r * (q + 1) + (xcd - r) * q) + off; }
        const int nig = WGM * nN, gid = wgid / nig, fm = gid * WGM, gsz = (nM - fm) < WGM ? (nM - fm) : WGM;
        u.pm = fm + ((wgid % nig) % gsz); u.pn = (wgid % nig) / gsz; return true;
    }
    __device__ __forceinline__ void a_ready(const Unit&) const {}
    __device__ __forceinline__ void done(const Unit&) const {}
};

__device__ __forceinline__ unsigned cvt_pk_bf16(float lo, float hi) { unsigned r; asm volatile("v_cvt_pk_bf16_f32 %0, %1, %2" : "=v"(r) : "v"(lo), "v"(hi)); return r; }
typedef float f32x2 __attribute__((ext_vector_type(2)));
__device__ __forceinline__ f32x2 gelu_pk(f32x2 v) {
    const f32x2 av = __builtin_elementwise_abs(v), d = av * 0.2316418882f + 1.0f;
    f32x2 t; t.x = __builtin_amdgcn_rcpf(d.x); t.y = __builtin_amdgcn_rcpf(d.y);
    f32x2 q = t * 0.5307027145f + (-0.7265760135f); q = q * t + 0.7107068705f; q = q * t + (-0.142248368f); q = q * t + 0.127414796f; q = q * t;
    const f32x2 s = (v * v) * (-0.72134752044f);
    f32x2 e; e.x = __builtin_amdgcn_exp2f(s.x); e.y = __builtin_amdgcn_exp2f(s.y);
    const f32x2 m = v * (q * e), r = v - m;
    f32x2 o; o.x = v.x < 0.f ? m.x : r.x; o.y = v.y < 0.f ? m.y : r.y; return o;
}

template <int ACT  > struct EpiBf16 {
    static constexpr bool PERM = true, AFTER_DRAIN = false; static_assert(ACT == 0 || ACT == 1, "EpiBf16: ACT is 0 (none) or 1 (gelu_pk)");
    bf16_t* O; int ldc; const float* bias; int split_cols; size_t split_stride; float scale0;
    __device__ __forceinline__ void operator()(const f32x4 (&acc)[2][2][4][2], const Unit& u, int wr, int wc, int fr, int fq) const {
        const int row0 = u.pm * BM + wr * 64 + fr; int colt = u.pn * BM; bf16_t* base = O;
        float sc = 1.f; if (split_cols) { const int t = colt / split_cols; base += (size_t)t * split_stride; colt -= t * split_cols; if (t == 0) sc = scale0; }
        const int col0 = colt + wc * 32 + 8 * fq, bcol0 = u.pn * BM + wc * 32 + 8 * fq;
        f32x4 bv[2][2];
#pragma unroll
        for (int bj = 0; bj < 2; ++bj)
#pragma unroll
            for (int n = 0; n < 2; ++n) bv[bj][n] = bias ? *(const f32x4*)(bias + bcol0 + bj * HALF + 4 * n) : (f32x4){0.f, 0.f, 0.f, 0.f};
#pragma unroll
        for (int ai = 0; ai < 2; ++ai)
#pragma unroll
            for (int m = 0; m < 4; ++m) { bf16_t* rowp = base + (size_t)(row0 + ai * HALF + m * 16) * ldc + col0;
#pragma unroll
                for (int bj = 0; bj < 2; ++bj) { f32x4 v0 = acc[ai][bj][m][0] + bv[bj][0], v1 = acc[ai][bj][m][1] + bv[bj][1];
                    if (ACT == 1) { f32x2 a = gelu_pk((f32x2){v0[0], v0[1]}), b = gelu_pk((f32x2){v0[2], v0[3]}), c = gelu_pk((f32x2){v1[0], v1[1]}), d = gelu_pk((f32x2){v1[2], v1[3]});
                        v0 = (f32x4){a.x, a.y, b.x, b.y}; v1 = (f32x4){c.x, c.y, d.x, d.y}; }
                    v0 = v0 * sc; v1 = v1 * sc; u32x4 w; w.x = cvt_pk_bf16(v0[0], v0[1]); w.y = cvt_pk_bf16(v0[2], v0[3]); w.z = cvt_pk_bf16(v1[0], v1[1]); w.w = cvt_pk_bf16(v1[2], v1[3]);
                    *(u32x4*)(rowp + bj * HALF) = w; } }
    }
};


constexpr float RMS_EPS_F = 1e-6f;
__device__ __forceinline__ float rstd_of(float ss) { return 1.0f / sqrtf(ss * (1.0f / 1024.0f) + RMS_EPS_F); }
__device__ __forceinline__ float rstd_slots(const float* ss, int row, int ns, int fq) {
    const f32x4* p = (const f32x4*)(ss + (size_t)row * ns + fq * (ns >> 2)); f32x4 v = p[0]; float s = (v[0] + v[1]) + (v[2] + v[3]);
    if (ns == 32) { v = p[1]; s += (v[0] + v[1]) + (v[2] + v[3]); }
    s += __shfl_xor(s, 16); s += __shfl_xor(s, 32); return rstd_of(s); }
__device__ __forceinline__ u32x4 pack8(f32x4 v0, f32x4 v1) { u32x4 w; w.x = cvt_pk_bf16(v0[0], v0[1]); w.y = cvt_pk_bf16(v0[2], v0[3]); w.z = cvt_pk_bf16(v1[0], v1[1]); w.w = cvt_pk_bf16(v1[2], v1[3]); return w; }
__device__ __forceinline__ float fast_sigmoid(float x) { return __builtin_amdgcn_rcpf(1.0f + __builtin_amdgcn_exp2f(-1.4426950408889634f * x)); }
__device__ __forceinline__ f32x2 gelu_tanh2(f32x2 y) {
    const f32x2 t = y * y, u = y * (t * (-0.10294324f) + (-2.3022082f));
    f32x2 e; e.x = __builtin_amdgcn_exp2f(u.x); e.y = __builtin_amdgcn_exp2f(u.y);
    const f32x2 d = e + 1.0f; f32x2 r; r.x = __builtin_amdgcn_rcpf(d.x); r.y = __builtin_amdgcn_rcpf(d.y);
    return y * r;
}

struct EpiQKV {
    static constexpr bool PERM = true, AFTER_DRAIN = false;
    bf16_t* Kb; const PG8_LAS float* rb; float scale0; mutable int ui = 0;
    __device__ __forceinline__ void operator()(const f32x4 (&acc)[2][2][4][2], const Unit& u, int wr, int wc, int fr, int fq) const {
        int colt = u.pn * BM; const int t = colt >> 10; colt &= 1023; const int slot = (t == 0) ? 2 : (t - 1); bf16_t* base = Kb + (size_t)slot * (16u << 20); const float sc = (t == 0) ? scale0 : 1.f;
        const int col0 = colt + wc * 32 + 8 * fq, row0 = u.pm * BM + wr * 64 + fr;
        const PG8_LAS float* rq = rb + ui * 256; ++ui;
#pragma unroll
        for (int ai = 0; ai < 2; ++ai)
#pragma unroll
            for (int m = 0; m < 4; ++m) { const int row = row0 + ai * HALF + m * 16; const float rs = rq[wr * 64 + fr + ai * HALF + m * 16] * sc; bf16_t* rowp = base + (size_t)row * 1024 + col0;
#pragma unroll
                for (int bj = 0; bj < 2; ++bj) *(u32x4*)(rowp + bj * HALF) = pack8(acc[ai][bj][m][0] * rs, acc[ai][bj][m][1] * rs); }
    }
};
struct EpiMLP1 {
    static constexpr bool PERM = true, AFTER_DRAIN = false;
    bf16_t* O; const PG8_LAS float* rb; mutable int ui = 0;
    __device__ __forceinline__ void operator()(const f32x4 (&acc)[2][2][4][2], const Unit& u, int wr, int wc, int fr, int fq) const {
        const int row0 = u.pm * BM + wr * 64 + fr; const PG8_LAS float* rq = rb + ui * 256; ++ui;
#pragma unroll
        for (int ai = 0; ai < 2; ++ai)
#pragma unroll
            for (int m = 0; m < 4; ++m) { const int row = row0 + ai * HALF + m * 16; const float rs = rq[wr * 64 + fr + ai * HALF + m * 16]; bf16_t* rowp = O + ((size_t)u.pn * 16384 + row) * 256 + wc * 32 + 8 * fq;
#pragma unroll
                for (int bj = 0; bj < 2; ++bj) { f32x4 v0 = acc[ai][bj][m][0] * rs, v1 = acc[ai][bj][m][1] * rs;
#pragma unroll
                    for (int e = 0; e < 4; ++e) { const float a = fmaxf(v0[e], 0.f), b = fmaxf(v1[e], 0.f); v0[e] = a * a; v1[e] = b * b; }
                    *(u32x4*)(rowp + bj * HALF) = pack8(v0, v1); } }
    }
};
__device__ __forceinline__ float bflo(unsigned w) { return __uint_as_float(w << 16); }
__device__ __forceinline__ float bfhi(unsigned w) { return __uint_as_float(w & 0xffff0000u); }
template <bool GLU> struct EpiRes {
    static constexpr bool PERM = true, AFTER_DRAIN = false;
    const float* hin32; bf16_t* hb; float* ss;
    __device__ __forceinline__ void operator()(const f32x4 (&acc)[2][2][4][2], const Unit& u, int wr, int wc, int fr, int fq) const {
        constexpr int NB = GLU ? 1 : 2;
        const int row0 = u.pm * BM + wr * 64 + fr, colb = GLU ? (u.pn * HALF + wc * 32 + 8 * fq) : (u.pn * BM + wc * 32 + 8 * fq);
#pragma unroll
        for (int ai = 0; ai < 2; ++ai) {
            f32x4 r0[4][NB], r1[4][NB];
            if (hin32) {
#pragma unroll
                for (int m = 0; m < 4; ++m)
#pragma unroll
                    for (int bj = 0; bj < NB; ++bj) { const size_t off = (size_t)(row0 + ai * HALF + m * 16) * 1024 + colb + bj * HALF; r0[m][bj] = *(const f32x4*)(hin32 + off); r1[m][bj] = *(const f32x4*)(hin32 + off + 4); }
            } else { u32x4 w[4][NB];
#pragma unroll
                for (int m = 0; m < 4; ++m)
#pragma unroll
                    for (int bj = 0; bj < NB; ++bj) w[m][bj] = *(const u32x4*)(hb + (size_t)(row0 + ai * HALF + m * 16) * 1024 + colb + bj * HALF);
#pragma unroll
                for (int m = 0; m < 4; ++m)
#pragma unroll
                    for (int bj = 0; bj < NB; ++bj) { const u32x4 x = w[m][bj]; r0[m][bj] = (f32x4){bflo(x.x), bfhi(x.x), bflo(x.y), bfhi(x.y)}; r1[m][bj] = (f32x4){bflo(x.z), bfhi(x.z), bflo(x.w), bfhi(x.w)}; } }
#pragma unroll
            for (int m = 0; m < 4; ++m) { const int row = row0 + ai * HALF + m * 16; float s = 0.f;
#pragma unroll
                for (int bj = 0; bj < NB; ++bj) { const size_t off = (size_t)row * 1024 + colb + bj * HALF; f32x4 o[2] = {r0[m][bj], r1[m][bj]};
#pragma unroll
                    for (int n = 0; n < 2; ++n) { f32x4 v = acc[ai][bj][m][n];
                        if (GLU) { const f32x4 gt = acc[ai][1][m][n];
#pragma unroll
                            for (int e = 0; e < 4; ++e) v[e] = v[e] * fast_sigmoid(gt[e]); }
                        o[n] = o[n] + v;
                        s += (o[n][0] * o[n][0] + o[n][1] * o[n][1]) + (o[n][2] * o[n][2] + o[n][3] * o[n][3]); }
                    *(u32x4*)(hb + off) = pack8(o[0], o[1]); }
                s += __shfl_xor(s, 16); s += __shfl_xor(s, 32);
                if (ss && fq == 0) ss[(size_t)row * (GLU ? 32 : 16) + u.pn * 4 + wc] = s; } }
    }
};
typedef float f2v_t __attribute__((ext_vector_type(2)));
struct EpiSlocScan {
    static constexpr bool PERM = true, AFTER_DRAIN = true;
    const f2v_t* lampow; bf16_t* UX;
    __device__ __forceinline__ void fused(f32x4 (&acc)[2][2][4][2], const Unit& u, int wr, int wc, int fr, int fq, PG8_LAS unsigned char* lds, int wid, int lane) const {
        constexpr int TP = 132;
        PG8_LAS float* T = (PG8_LAS float*)lds; const int col = wc * 32 + 8 * fq;
#pragma unroll
        for (int ai = 0; ai < 2; ++ai)
#pragma unroll
            for (int m = 0; m < 4; ++m) { const int n = ai * HALF + wr * 64 + m * 16 + fr; PG8_LAS float* p = T + n * TP + col;
                *(PG8_LAS f32x4*)(p) = acc[ai][0][m][0]; *(PG8_LAS f32x4*)(p + 4) = acc[ai][0][m][1]; }
        asm volatile("s_waitcnt lgkmcnt(0)" ::: "memory"); __builtin_amdgcn_s_barrier(); asm volatile("" ::: "memory");
        { const int g = u.pn, p = lane; const f2v_t lt = lampow[(size_t)(g * 64 + p) * 33 + 32]; float xr = 0.f, xi = 0.f;
          PG8_LAS float* Tw = T + (wid * 32) * TP + p; PG8_LAS float* E = T + 256 * TP;
#pragma unroll 4
          for (int k = 0; k < 32; ++k) { const float sr = Tw[k * TP], si = Tw[k * TP + 64]; const float nr = lt.x * xr - lt.y * xi + sr, ni = lt.x * xi + lt.y * xr + si; xr = nr; xi = ni; }
          E[wid * 128 + p] = xr; E[wid * 128 + 64 + p] = xi;
          f2v_t l32 = lt;
#pragma unroll
          for (int q = 0; q < 5; ++q) { const float a = l32.x * l32.x - l32.y * l32.y, b = 2.f * l32.x * l32.y; l32.x = a; l32.y = b; }
          asm volatile("s_waitcnt lgkmcnt(0)" ::: "memory"); __builtin_amdgcn_s_barrier(); asm volatile("" ::: "memory");
          xr = 0.f; xi = 0.f;
          for (int v = 0; v < wid; ++v) { const float er = E[v * 128 + p], ei = E[v * 128 + 64 + p]; const float nr = l32.x * xr - l32.y * xi + er, ni = l32.x * xi + l32.y * xr + ei; xr = nr; xi = ni; }
          bf16_t* ux = UX + (size_t)(u.pm * 256 + wid * 32) * 640 + 512 + p;
#pragma unroll 4
          for (int k = 0; k < 32; ++k) { const float sr = Tw[k * TP], si = Tw[k * TP + 64]; const unsigned w = cvt_pk_bf16(xr, xi);
              ux[(size_t)k * 640] = (bf16_t)(w & 0xffffu); ux[(size_t)k * 640 + 64] = (bf16_t)(w >> 16);
              const float nr = lt.x * xr - lt.y * xi + sr, ni = lt.x * xi + lt.y * xr + si; xr = nr; xi = ni; } }
    }
};
struct EpiY {
    static constexpr bool PERM = true, AFTER_DRAIN = false;
    bf16_t* Z;
    __device__ __forceinline__ void operator()(const f32x4 (&acc)[2][2][4][2], const Unit& u, int wr, int wc, int fr, int fq) const {
        const int g = u.pm >> 1, i = u.pm & 1, j = u.pn & 1;
#pragma unroll
        for (int ai = 0; ai < 2; ++ai)
#pragma unroll
            for (int m = 0; m < 4; ++m) { const int n = 256 * i + ai * HALF + wr * 64 + m * 16 + fr;
#pragma unroll
                for (int bj = 0; bj < 2; ++bj) { const int cc = 256 * j + 128 * bj + 32 * wc + 8 * fq, t = cc >> 4, c0 = cc & 15;
                    f32x4 v0 = acc[ai][bj][m][0], v1 = acc[ai][bj][m][1];
                    { const f32x2 a = gelu_tanh2((f32x2){v0[0], v0[1]}), b = gelu_tanh2((f32x2){v0[2], v0[3]}), c = gelu_tanh2((f32x2){v1[0], v1[1]}), d = gelu_tanh2((f32x2){v1[2], v1[3]});
                      v0 = (f32x4){a.x, a.y, b.x, b.y}; v1 = (f32x4){c.x, c.y, d.x, d.y}; }
                    *(u32x4*)(Z + ((size_t)g * 16384 + (32 * n + t)) * 16 + c0) = pack8(v0, v1); } }
    }
};
struct OrderSloc {
    int G, c;
    __device__ __forceinline__ bool next(int i, Unit& u) const { const int L = i * G + c; if (L >= 128) return false;
        int g, h; if (G >= 128 && (G & 7) == 0) { const int x = L & 7, sl = L >> 3; g = x * 8 + (sl >> 1); h = sl & 1; } else { g = L >> 1; h = L & 1; }
        u.pm = 2 * g + h; u.pn = g; return true; }
    __device__ __forceinline__ void a_ready(const Unit&) const {}
    __device__ __forceinline__ void done(const Unit&) const {}
};
struct OrderY {
    int G, c;
    __device__ __forceinline__ bool next(int i, Unit& u) const { const int L = i * G + c; if (L >= 256) return false;
        int g, q; if (G == 256) { const int x = L & 7, sl = L >> 3; g = x * 8 + (sl >> 2); q = sl & 3; } else { g = L >> 2; q = L & 3; }
        u.pm = 2 * g + (q >> 1); u.pn = 2 * g + (q & 1); return true; }
    __device__ __forceinline__ void a_ready(const Unit&) const {}
    __device__ __forceinline__ void done(const Unit&) const {}
};

template <class Epi, class Sched, bool ALIGN_EPI = false, bool SP2 = false>
__device__ __forceinline__ void gemm_phase(PG8_LAS unsigned char* lds, const Gemm g, const Sched& S, const Epi& E) {
    const int tid = ltid(), wid = __builtin_amdgcn_readfirstlane(tid >> 6), lane = tid & 63, wr = wid >> 2, wc = wid & 3, fr = lane & 15, fq = lane >> 4;
    const int K = g.K, nt = K / BK;
    unsigned voffA[2], voffB[2];
#pragma unroll
    for (int i = 0; i < 2; ++i) { int R, C; stage_rc(tid * 16 + i * 8192, R, C); const int Rb = Epi::PERM ? ((R & ~31) + perm32(R & 31)) : R;
        voffA[i] = (unsigned)(R * g.lda * 2 + (C >> 4) * g.a_gs + (C & 15) * 2); voffB[i] = (unsigned)(Rb * g.ldb + C) * 2u; }
    const size_t kstep = (size_t)(BK * 2);
#define PG8_AOFF(x) ((size_t)((x) >> 2) * (size_t)g.a_ts + (size_t)((x) & 3) * (size_t)g.a_ks)
    const size_t hstepA = (size_t)HALF * g.lda * 2, hstepB = (size_t)HALF * g.ldb * 2;
    const size_t tstepA = 2 * hstepA, tstepB = 2 * hstepB;
    const unsigned ldsw = (unsigned)wid * 1024u;
    const int aoff = lds_byte(wr * 64 + fr, fq * 8), boff = lds_byte(wc * 32 + fr, fq * 8);
#define PG8_SA(b, h) (((b) * 2 + (h)) * HTB)
#define PG8_SB(b, h) ((4 + (b) * 2 + (h)) * HTB)
#define PG8_STAGE(bufoff, gbase, voff) do { _Pragma("unroll") for (int _i = 0; _i < 2; ++_i) \
        __builtin_amdgcn_global_load_lds((const unsigned*)((const char*)(gbase) + (voff)[_i]), (PG8_LAS unsigned*)(lds + (bufoff) + ldsw + _i * 8192), 16, 0, 0); } while (0)
#define PG8_LDA(dst, b, h) do { _Pragma("unroll") for (int m = 0; m < 4; ++m) _Pragma("unroll") for (int k = 0; k < 2; ++k) dst[m][k] = *(const PG8_LAS bf16x8*)(lds + PG8_SA(b, h) + aoff + m * 2048 + k * 1024); } while (0)
#define PG8_LDB(dst, b, h) do { _Pragma("unroll") for (int n = 0; n < 2; ++n) _Pragma("unroll") for (int k = 0; k < 2; ++k) dst[n][k] = *(const PG8_LAS bf16x8*)(lds + PG8_SB(b, h) + boff + n * 2048 + k * 1024); } while (0)
#define PG8_MMA(ai, bj, At, Bt) do { __builtin_amdgcn_s_setprio(1); _Pragma("unroll") for (int m = 0; m < 4; ++m) _Pragma("unroll") for (int n = 0; n < 2; ++n) _Pragma("unroll") for (int k = 0; k < 2; ++k) \
        acc[ai][bj][m][n] = __builtin_amdgcn_mfma_f32_16x16x32_bf16(Bt[n][k], At[m][k], acc[ai][bj][m][n], 0, 0, 0); __builtin_amdgcn_s_setprio(0); } while (0)
#define PG8_WAIT_V(n) asm volatile("s_waitcnt vmcnt(" #n ")" ::: "memory")
#define PG8_WAIT_L(n) asm volatile("s_waitcnt lgkmcnt(" #n ")" ::: "memory")
#define PG8_BAR __builtin_amdgcn_s_barrier()
#define PG8_SCHED __builtin_amdgcn_sched_barrier(0)
    Unit cur, nxt; int ui = 0;
    if (!S.next(0, cur)) return;
    f32x4 acc[2][2][4][2];
#pragma unroll
    for (int a = 0; a < 2; ++a)
#pragma unroll
        for (int b = 0; b < 2; ++b)
#pragma unroll
            for (int m = 0; m < 4; ++m)
#pragma unroll
                for (int n = 0; n < 2; ++n) acc[a][b][m][n] = (f32x4){0.f, 0.f, 0.f, 0.f};
    bf16x8 At[4][2], B0[2][2], B1[2][2];
    const char* cA = (const char*)g.A + (size_t)cur.pm * tstepA; const char* cB = (const char*)g.Bt + (size_t)cur.pn * tstepB;
    S.a_ready(cur);
    if constexpr (SP2) {
        PG8_STAGE(PG8_SB(0, 0), cB, voffB); PG8_STAGE(PG8_SB(0, 1), cB + hstepB, voffB); PG8_STAGE(PG8_SA(0, 0), cA, voffA); PG8_STAGE(PG8_SA(0, 1), cA + hstepA, voffA);
        if (wr == 1) PG8_BAR;
        PG8_WAIT_V(2); PG8_BAR;
        PG8_STAGE(PG8_SB(1, 0), cB + kstep, voffB); PG8_STAGE(PG8_SA(1, 0), cA + PG8_AOFF(1), voffA); PG8_STAGE(PG8_SB(1, 1), cB + hstepB + kstep, voffB);
        PG8_WAIT_V(6); PG8_BAR;
    } else {
        PG8_STAGE(PG8_SB(0, 0), cB, voffB); PG8_STAGE(PG8_SA(0, 0), cA, voffA); PG8_STAGE(PG8_SB(0, 1), cB + hstepB, voffB); PG8_STAGE(PG8_SA(0, 1), cA + hstepA, voffA);
        if (wr == 1) PG8_BAR;
        PG8_WAIT_V(4); PG8_BAR;
        PG8_STAGE(PG8_SB(1, 0), cB + kstep, voffB); PG8_STAGE(PG8_SA(1, 0), cA + PG8_AOFF(1), voffA); PG8_STAGE(PG8_SB(1, 1), cB + hstepB + kstep, voffB);
        PG8_WAIT_V(6); PG8_BAR;
    }
    for (;;) {
        const bool has_next = S.next(ui + 1, nxt);
        const char* nA = has_next ? (const char*)g.A + (size_t)nxt.pm * tstepA : cA; const char* nB = has_next ? (const char*)g.Bt + (size_t)nxt.pn * tstepB : cB;
        for (int t = 0; t < nt; t += 2) {
            const bool last = (t == nt - 2);
            const char* a1 = cA + PG8_AOFF(t + 1);
            const char* a2 = last ? nA : cA + PG8_AOFF(t + 2); const char* b2 = last ? nB : cB + (size_t)(t + 2) * kstep;
            const char* a3 = a2 + (size_t)g.a_ks; const char* b3 = b2 + kstep;
            if (last && has_next) S.a_ready(nxt);
            if constexpr (SP2) {
            PG8_LDB(B0, 0, 0); PG8_LDB(B1, 0, 1); PG8_SCHED; PG8_LDA(At, 0, 0); PG8_STAGE(PG8_SA(1, 1), a1 + hstepA, voffA);
            PG8_WAIT_V(8); PG8_WAIT_L(0); PG8_BAR; PG8_MMA(0, 0, At, B0); PG8_MMA(0, 1, At, B1); PG8_BAR; PG8_SCHED;
            PG8_LDA(At, 0, 1); PG8_STAGE(PG8_SB(0, 0), b2, voffB); PG8_STAGE(PG8_SB(0, 1), b2 + hstepB, voffB); PG8_STAGE(PG8_SA(0, 0), a2, voffA);
            PG8_WAIT_V(8); PG8_WAIT_L(0); PG8_BAR; PG8_MMA(1, 0, At, B0); PG8_MMA(1, 1, At, B1); PG8_BAR; PG8_SCHED;
            PG8_LDB(B0, 1, 0); PG8_LDB(B1, 1, 1); PG8_SCHED; PG8_LDA(At, 1, 0); PG8_STAGE(PG8_SA(0, 1), a2 + hstepA, voffA);
            PG8_WAIT_V(8); PG8_WAIT_L(0); PG8_BAR; PG8_MMA(0, 0, At, B0); PG8_MMA(0, 1, At, B1); PG8_BAR; PG8_SCHED;
            PG8_LDA(At, 1, 1); PG8_STAGE(PG8_SB(1, 0), b3, voffB); PG8_STAGE(PG8_SB(1, 1), b3 + hstepB, voffB); PG8_STAGE(PG8_SA(1, 0), a3, voffA);
            PG8_WAIT_V(8); PG8_WAIT_L(0); PG8_BAR; PG8_MMA(1, 0, At, B0); PG8_MMA(1, 1, At, B1); PG8_BAR; PG8_SCHED;
            } else {
            PG8_LDB(B0, 0, 0); PG8_SCHED; PG8_LDA(At, 0, 0); PG8_STAGE(PG8_SA(1, 1), a1 + hstepA, voffA);
            PG8_WAIT_L(8); PG8_BAR; PG8_WAIT_L(0); PG8_MMA(0, 0, At, B0); PG8_BAR; PG8_SCHED;
            PG8_LDB(B1, 0, 1); PG8_STAGE(PG8_SB(0, 0), b2, voffB);
            PG8_BAR; PG8_WAIT_L(0); PG8_MMA(0, 1, At, B1); PG8_BAR;
            PG8_LDA(At, 0, 1); PG8_STAGE(PG8_SA(0, 0), a2, voffA);
            PG8_BAR; PG8_WAIT_L(0); PG8_MMA(1, 0, At, B0); PG8_BAR; PG8_SCHED;
            PG8_STAGE(PG8_SB(0, 1), b2 + hstepB, voffB);
            PG8_WAIT_V(6); PG8_BAR; PG8_MMA(1, 1, At, B1); PG8_BAR;
            PG8_LDB(B0, 1, 0); PG8_SCHED; PG8_LDA(At, 1, 0); PG8_STAGE(PG8_SA(0, 1), a2 + hstepA, voffA);
            PG8_WAIT_L(8); PG8_BAR; PG8_WAIT_L(0); PG8_MMA(0, 0, At, B0); PG8_BAR; PG8_SCHED;
            PG8_LDB(B1, 1, 1); PG8_STAGE(PG8_SB(1, 0), b3, voffB);
            PG8_BAR; PG8_WAIT_L(0); PG8_MMA(0, 1, At, B1); PG8_BAR;
            PG8_LDA(At, 1, 1); PG8_STAGE(PG8_SA(1, 0), a3, voffA);
            PG8_BAR; PG8_WAIT_L(0); PG8_MMA(1, 0, At, B0); PG8_BAR; PG8_SCHED;
            PG8_STAGE(PG8_SB(1, 1), b3 + hstepB, voffB);
            PG8_WAIT_V(6); PG8_BAR; PG8_MMA(1, 1, At, B1); PG8_BAR;
            }
        }
        if constexpr (ALIGN_EPI) { if (wr == 0) PG8_BAR; }
        if constexpr (!Epi::AFTER_DRAIN) { E(acc, cur, wr, wc, fr, fq); S.done(cur); }
        if (!has_next) break;
#pragma unroll
        for (int a = 0; a < 2; ++a)
#pragma unroll
            for (int b = 0; b < 2; ++b)
#pragma unroll
                for (int m = 0; m < 4; ++m)
#pragma unroll
                    for (int n = 0; n < 2; ++n) acc[a][b][m][n] = (f32x4){0.f, 0.f, 0.f, 0.f};
        cur = nxt; cA = nA; cB = nB; ++ui;
        if constexpr (ALIGN_EPI) { if (wr == 1) PG8_BAR; }
    }
    PG8_WAIT_V(0);
    if constexpr (!ALIGN_EPI) { if (wr == 0) PG8_BAR; }
    PG8_BAR;
    if constexpr (Epi::AFTER_DRAIN) { E.fused(acc, cur, wr, wc, fr, fq, lds, wid, lane); S.done(cur); }
#undef PG8_AOFF
#undef PG8_SA
#undef PG8_SB
#undef PG8_STAGE
#undef PG8_LDA
#undef PG8_LDB
#undef PG8_MMA
#undef PG8_WAIT_V
#undef PG8_WAIT_L
#undef PG8_BAR
#undef PG8_SCHED
}
}
namespace attn_body {
using bf16=__hip_bfloat16;
using bf16x8=__attribute__((ext_vector_type(8)))short;
using s16x4=__attribute__((ext_vector_type(4)))short;
using f32x16=__attribute__((ext_vector_type(16)))float;
using u32x4=__attribute__((ext_vector_type(4)))unsigned;
using f32x4_t=__attribute__((ext_vector_type(4)))float;
constexpr int BATCH=2,NHEAD=16,SEQ=8192,D=64,DM=NHEAD*D;
constexpr int NW=8,QBLK=32,QB=QBLK*NW,KVBLK=64,NQB=SEQ/QB;
constexpr int ATTN_PITCH=DM, ATTN_UNIT_ROWS=QB;
__device__ __forceinline__ int crow(int r,int hi){return (r&3)+8*(r>>2)+4*hi;}
#define SBAR() __builtin_amdgcn_sched_barrier(0)
__device__ __forceinline__ void cmask(f32x16&p0,f32x16&p1,int jb,int qrel,int hi){
  const float NEG=-INFINITY; int kb=64*jb+4*hi;
  #pragma unroll
  for(int r=0;r<16;++r){int kv=kb+(r&3)+8*(r>>2); if(kv>qrel)p0[r]=NEG; if(kv+32>qrel)p1[r]=NEG;}
}

constexpr int NSLOT=3, SLOTB=8192;
constexpr int LDS_K=0, LDS_V=NSLOT*SLOTB, LDS_WS=2*NSLOT*SLOTB, LDS_OST=LDS_WS+NW*64*4, LDS_GT=LDS_OST+NW*4096, LDS_QM=LDS_GT+SEQ*4, LDS_CF=LDS_QM+64, LDS_ORD=LDS_CF+512, LDS_BYTES=LDS_ORD+256;
constexpr float C2=0.125f*1.4426950408889634f;
__device__ __forceinline__ void glds16(const void*gsrc,unsigned lds_dst){unsigned keep;
  asm volatile("s_mov_b32 %0, m0\n\ts_mov_b32 m0, %2\n\ts_nop 0\n\tglobal_load_lds_dwordx4 %1, off\n\ts_mov_b32 m0, %0":"=&s"(keep):"v"(gsrc),"s"(lds_dst):"memory");}
__device__ __forceinline__ float max3f(float a,float b,float c){float r;asm("v_max3_f32 %0, %1, %2, %3":"=v"(r):"v"(a),"v"(b),"v"(c));return r;}
__device__ __forceinline__ float max2f(float a,float b){float r;asm("v_max_f32_e32 %0, %1, %2":"=v"(r):"v"(a),"v"(b));return r;}
__device__ __forceinline__ float fadd_s(float a,float b){float r;asm("v_add_f32_e32 %0, %1, %2":"=v"(r):"v"(a),"v"(b));return r;}
__device__ __forceinline__ float fsub_s(float a,float b){float r;asm("v_sub_f32_e32 %0, %1, %2":"=v"(r):"v"(a),"v"(b));return r;}
typedef float f32x2_t __attribute__((ext_vector_type(2))); typedef __bf16 bf16x2_t __attribute__((ext_vector_type(2)));
__device__ __forceinline__ unsigned cvtpk_s(float lo,float hi){f32x2_t v={lo,hi};bf16x2_t b=__builtin_convertvector(v,bf16x2_t);return __builtin_bit_cast(unsigned,b);}
#define WAIT_BAR(N) asm volatile("s_waitcnt vmcnt(" #N ") lgkmcnt(0)\n\ts_barrier":::"memory")

__device__ __forceinline__ void qkt(f32x16&p0,f32x16&p1,const char*Kslot,const bf16x8*qr,int r32,int hi){
  const char*kb=Kslot+hi*1024+r32*16;
  #pragma unroll
  for(int d0=0;d0<4;++d0){
    const bf16x8 b0=*reinterpret_cast<const bf16x8*>(kb+d0*2048);
    const bf16x8 b1=*reinterpret_cast<const bf16x8*>(kb+d0*2048+512);
    {p0=__builtin_amdgcn_mfma_f32_32x32x16_bf16(b0,qr[d0],p0,0,0,0);p1=__builtin_amdgcn_mfma_f32_32x32x16_bf16(b1,qr[d0],p1,0,0,0);}}
}
typedef __attribute__((address_space(3))) const char* lds_cptr;
typedef short v4i16_t __attribute__((ext_vector_type(4)));
__device__ __forceinline__ void kload8(bf16x8*kf,lds_cptr kp){
  kf[0]=*(const __attribute__((address_space(3))) bf16x8*)(kp);      kf[1]=*(const __attribute__((address_space(3))) bf16x8*)(kp+512);
  kf[2]=*(const __attribute__((address_space(3))) bf16x8*)(kp+2048); kf[3]=*(const __attribute__((address_space(3))) bf16x8*)(kp+2560);
  kf[4]=*(const __attribute__((address_space(3))) bf16x8*)(kp+4096); kf[5]=*(const __attribute__((address_space(3))) bf16x8*)(kp+4608);
  kf[6]=*(const __attribute__((address_space(3))) bf16x8*)(kp+6144); kf[7]=*(const __attribute__((address_space(3))) bf16x8*)(kp+6656);
}
__device__ __forceinline__ void kload2(bf16x8*kf,lds_cptr kp,int j){ kf[2*j]=*(const __attribute__((address_space(3))) bf16x8*)(kp+j*2048); kf[2*j+1]=*(const __attribute__((address_space(3))) bf16x8*)(kp+j*2048+512); }
__device__ __forceinline__ s16x4 vtr(lds_cptr p){ return __builtin_bit_cast(s16x4,__builtin_amdgcn_ds_read_tr16_b64_v4i16((__attribute__((address_space(3))) v4i16_t*)p)); }
__device__ __forceinline__ float rowmax(const f32x16&p0,const f32x16&p1){
  float a=max3f(p0[0],p0[1],p1[0]),b=max3f(p0[2],p0[3],p1[1]);a=max3f(a,p1[2],p1[3]);
  #pragma unroll
  for(int r=4;r<16;r+=4){a=max3f(a,p0[r],p0[r+1]);b=max3f(b,p0[r+2],p0[r+3]);a=max3f(a,p1[r],p1[r+1]);b=max3f(b,p1[r+2],p1[r+3]);}
  const float m=max2f(a,b);
  auto rr=__builtin_amdgcn_permlane32_swap(__float_as_uint(m),__float_as_uint(m),false,false);
  return max2f(__uint_as_float(rr[0]),__uint_as_float(rr[1]));
}
__device__ __forceinline__ void pv(f32x16*o,int vb,bf16x8 pa0,bf16x8 pa1,bf16x8 pa2,bf16x8 pa3){
  #pragma unroll
  for(int d0=0;d0<2;++d0){s16x4 lo[4],hi[4];
    #pragma unroll
    for(int ks=0;ks<4;++ks){
      asm volatile("ds_read_b64_tr_b16 %0,%1 offset:%c2":"=&v"(lo[ks]):"v"(vb),"i"(d0*4096+ks*1024):"memory");
      asm volatile("ds_read_b64_tr_b16 %0,%1 offset:%c2":"=&v"(hi[ks]):"v"(vb),"i"(d0*4096+ks*1024+512):"memory");}
    asm volatile("s_waitcnt lgkmcnt(0)":::"memory");SBAR();
    #define PK(k) (bf16x8){lo[k][0],lo[k][1],lo[k][2],lo[k][3],hi[k][0],hi[k][1],hi[k][2],hi[k][3]}
    o[d0]=__builtin_amdgcn_mfma_f32_32x32x16_bf16(pa0,PK(0),o[d0],0,0,0);
    o[d0]=__builtin_amdgcn_mfma_f32_32x32x16_bf16(pa1,PK(1),o[d0],0,0,0);
    o[d0]=__builtin_amdgcn_mfma_f32_32x32x16_bf16(pa2,PK(2),o[d0],0,0,0);
    o[d0]=__builtin_amdgcn_mfma_f32_32x32x16_bf16(pa3,PK(3),o[d0],0,0,0);
    #undef PK
  }
}

#ifndef ATTN_STORE16
#define ATTN_STORE16(p,v) (*(u32x4*)(p)=(v))
#endif
template<int THRL> __device__ __forceinline__ void attn_unit(int b,int h,int qb,const bf16*Q,const bf16*__restrict__ K,const bf16*__restrict__ V,bf16*O,const float*__restrict__ Gg,float kmax,char*shm){
  const int tid=ltid(),lane=tid&63,r32=lane&31,hi=lane>>5; const int wid=__builtin_amdgcn_readfirstlane(tid>>6);
  const long rowbase=(long)b*SEQ; const int q0=qb*QB;
  const bf16*Qw=Q+(rowbase+q0+wid*QBLK)*DM+h*D;
  const lds_cptr shm3=(lds_cptr)shm;
  bf16x8 qr[4];
  #pragma unroll
  for(int d0=0;d0<4;++d0)qr[d0]=*reinterpret_cast<const bf16x8*>(&Qw[(long)r32*DM+d0*16+hi*8]);
  { const int nk=q0+QB; const float gb=q0?Gg[q0-1]:0.f;
    f32x4_t g4_[4]; float ge_[4];
    #pragma unroll
    for(int k_=0;k_<4;++k_){ const int i=tid*4+k_*2048; if(i<nk){ g4_[k_]=*(const f32x4_t*)(Gg+i); ge_[k_]=(i>=q0)?gb:Gg[i|63]; } }
    #pragma unroll
    for(int k_=0;k_<4;++k_){ const int i=tid*4+k_*2048; if(i<nk){ const float ge=ge_[k_]; const f32x4_t g4=g4_[k_]; *(__attribute__((address_space(3))) f32x4_t*)(shm3+LDS_GT+i*4)=(f32x4_t){g4[0]-ge,g4[1]-ge,g4[2]-ge,g4[3]-ge}; } }
    if(tid<(nk>>6)){ const float c_=(tid==0||64*tid>=q0)?1.f:__builtin_amdgcn_exp2f(Gg[64*tid-1]-Gg[64*tid+63]); *(__attribute__((address_space(3))) float*)(shm3+LDS_CF+tid*4)=c_; } }
  { float qs=0.f;
    #pragma unroll
    for(int d0=0;d0<4;++d0){
      #pragma unroll
      for(int e=0;e<8;++e){const float f=__uint_as_float(((unsigned)(unsigned short)qr[d0][e])<<16);qs+=f*f;}}
    {auto rr=__builtin_amdgcn_permlane32_swap(__float_as_uint(qs),__float_as_uint(qs),false,false);qs=__uint_as_float(rr[0])+__uint_as_float(rr[1]);}
    #pragma unroll
    for(int o_=1;o_<32;o_<<=1)qs=fmaxf(qs,__shfl_xor(qs,o_));
    if(lane==0)*(__attribute__((address_space(3))) float*)(shm3+LDS_QM+wid*4)=qs; }
  asm volatile("s_waitcnt vmcnt(0) lgkmcnt(0)\n\ts_barrier":::"memory");
  int j0;
  { float qm=0.f;
    #pragma unroll
    for(int w=0;w<8;++w)qm=fmaxf(qm,*(const __attribute__((address_space(3))) float*)(shm3+LDS_QM+w*4));
    const float lim=Gg[q0]-(2.f*sqrtf(qm)*kmax*1.01f+150.f);
    const int nt0=4*qb; int ln_=lane; asm volatile("":"+v"(ln_)); const bool c0=(ln_<nt0)&&(Gg[64*ln_+63]<lim); const bool c1=(ln_+64<nt0)&&(Gg[64*ln_+4096+63]<lim);
    j0=(__popcll(__ballot(c0))+__popcll(__ballot(c1)))&~1; j0=__builtin_amdgcn_readfirstlane(j0); }
  const bf16*Kh=K+(rowbase+(long)j0*KVBLK)*DM+h*D,*Vh=V+(rowbase+(long)j0*KVBLK)*DM+h*D;
  const lds_cptr cf0=shm3+LDS_CF+j0*4;
  const lds_cptr gp0=shm3+LDS_GT+j0*256+hi*16;
  const unsigned lds0=(unsigned)(uintptr_t)shm;
  float*wsf=(float*)(shm+LDS_WS)+wid*64;
  const bf16*ksrc=Kh+(long)lane*DM+wid*8;
  const bf16*vsrc=Vh+(long)(16*(wid&3)+(lane>>2))*DM+(wid>>2)*32+(lane&3)*8;
  const unsigned kdst=lds0+LDS_K+wid*1024, vdst=lds0+LDS_V+wid*1024;
  #define DMA_K(t,slot) glds16(ksrc+(long)(t)*KVBLK*DM,(unsigned)__builtin_amdgcn_readfirstlane(kdst+(slot)))
  #define DMA_V(t,slot) glds16(vsrc+(long)(t)*KVBLK*DM,(unsigned)__builtin_amdgcn_readfirstlane(vdst+(slot)))
  const char*Kbase=shm+LDS_K; bf16x8 kf[8];
  const lds_cptr kp0=shm3+LDS_K+hi*1024+r32*16; const lds_cptr vp0=shm3+LDS_V+((lane>>4)&1)*32+(lane&3)*8+(4*hi+((lane&15)>>2))*64;
  const int NT=(q0+QB)/KVBLK-j0;
  DMA_K(0,0);DMA_V(0,0);DMA_K(1,SLOTB);
  float mhat=0.f,l_reg=0.f;f32x16 o[2];o[0]=f32x16{};o[1]=f32x16{};
  const int qrel=wid*QBLK+r32;
  #define CMASK(P0,P1,t) do{int jb_=(t)-(NT-4); if(jb_>=0)cmask(P0,P1,jb_,qrel,hi);}while(0)
  #define BIASINIT(P0,P1,t) do{ const lds_cptr gp_=gp0+(t)*256; \
    _Pragma("unroll") for(int i_=0;i_<4;++i_){ const f32x4_t ga_=*(const __attribute__((address_space(3))) f32x4_t*)(gp_+i_*32), gb_=*(const __attribute__((address_space(3))) f32x4_t*)(gp_+128+i_*32); \
      P0[4*i_]=ga_[0]-mhat;P0[4*i_+1]=ga_[1]-mhat;P0[4*i_+2]=ga_[2]-mhat;P0[4*i_+3]=ga_[3]-mhat; P1[4*i_]=gb_[0]-mhat;P1[4*i_+1]=gb_[1]-mhat;P1[4*i_+2]=gb_[2]-mhat;P1[4*i_+3]=gb_[3]-mhat; } }while(0)
  bool resc=false;
  #define START(P0,P1) do{ const float rm=rowmax(P0,P1); resc=false; \
    { const float dl=rm; mhat=fadd_s(mhat,dl); \
      _Pragma("unroll") for(int r=0;r<16;++r){P0[r]=fsub_s(P0[r],dl);P1[r]=fsub_s(P1[r],dl);} \
      } \
    _Pragma("unroll") for(int r=0;r<16;++r)P0[r]=__builtin_amdgcn_exp2f(P0[r]); }while(0)
  #define RESC(t) do{ const float cf_=*(const __attribute__((address_space(3))) float*)(cf0+(t)*4); l_reg*=cf_; \
      if(resc){ asm volatile("s_waitcnt lgkmcnt(0)":::"memory"); \
        _Pragma("unroll") for(int d_=0;d_<2;++d_) _Pragma("unroll") for(int r=0;r<16;++r)o[d_][r]*=cf_*wsf[crow(r,hi)]; } \
      else { _Pragma("unroll") for(int d_=0;d_<2;++d_) _Pragma("unroll") for(int r=0;r<16;++r)o[d_][r]*=cf_; } }while(0)
  f32x16 pA0,pA1,pB0,pB1;
  int sl_prev=0,sl_cur=0,sl_next=SLOTB;
  #define ROT() do{sl_prev=sl_cur;sl_cur=sl_next;sl_next=(sl_next==(NSLOT-1)*SLOTB)?0:sl_next+SLOTB;}while(0)
  DMA_K(2,2*SLOTB);
  WAIT_BAR(3);
  BIASINIT(pA0,pA1,0);qkt(pA0,pA1,Kbase,qr,r32,hi);asm volatile("s_nop 15\n\ts_nop 7":"+v"(pA0),"+v"(pA1));CMASK(pA0,pA1,0);
  START(pA0,pA1);
  _Pragma("unroll") for(int r=0;r<16;++r)pA1[r]=__builtin_amdgcn_exp2f(pA1[r]);
  WAIT_BAR(0);
  DMA_K(3,0);DMA_V(1,SLOTB);
  ROT();
  kload8(kf,kp0+sl_cur);
  WAIT_BAR(2);
  s16x4 vlo[8],vhi[8]; u32x4 pw0,pw1,pw2,pw3;
  #define PKW(P,B) cvtpk_s(P[B],P[B+1])
  #define PAF(k) __builtin_bit_cast(bf16x8,pw##k)
  #define VFR(i) (bf16x8){vlo[i][0],vlo[i][1],vlo[i][2],vlo[i][3],vhi[i][0],vhi[i][1],vhi[i][2],vhi[i][3]}
  #define PIN(x) asm volatile("":"+v"(x))
  #define MX3(a,b,c) __builtin_fmaxf(__builtin_fmaxf((a),(b)),(c))
  #define GAPA(MF,A0,A1,A2,A3,W0,W1,PW) do{ MF; sacc+=A0; sacc+=A1; sacc+=A2; sacc+=A3; PIN(sacc); W0; W1; PIN(PW); SBAR(); }while(0)
  #define EX(v) __builtin_amdgcn_exp2f(v)
  #define GAPB(MF,X,B) do{ MF; X[B]=EX(X[B]); X[B+1]=EX(X[B+1]); X[B+2]=EX(X[B+2]); X[B+3]=EX(X[B+3]); PIN(X); SBAR(); }while(0)
  #define VRD(i) do{ vlo[i]=vtr(vp_+(((i)>>2)*4096+((i)&3)*1024)); vhi[i]=vtr(vp_+(((i)>>2)*4096+((i)&3)*1024+512)); }while(0)
  #define KRD(G,j) do{ if(G){ kload2(kf,kp0+sl_next,j); SBAR(); } }while(0)
  #define STEP(C0,C1,P0,P1,t,GK,GV,GL) do{ SBAR(); BIASINIT(C0,C1,t); SBAR(); \
    const lds_cptr vp_=vp0+sl_prev; \
    VRD(0); SBAR(); float sacc=(P0[0]+P0[1]); \
    GAPA(C0=__builtin_amdgcn_mfma_f32_32x32x16_bf16(kf[0],qr[0],C0,0,0,0), P0[2],P0[3],P0[4],P0[5],     pw0[0]=PKW(P0,0), pw0[1]=PKW(P0,2), pw0); \
    VRD(4); SBAR(); GAPA(C1=__builtin_amdgcn_mfma_f32_32x32x16_bf16(kf[1],qr[0],C1,0,0,0), P0[6],P0[7],P0[8],P0[9],     pw0[2]=PKW(P0,4), pw0[3]=PKW(P0,6), pw0); \
    VRD(1); SBAR(); GAPA(C0=__builtin_amdgcn_mfma_f32_32x32x16_bf16(kf[2],qr[1],C0,0,0,0),   P0[10],P0[11],P0[12],P0[13], pw1[0]=PKW(P0,8), pw1[1]=PKW(P0,10), pw1); \
    VRD(5); SBAR(); GAPA(C1=__builtin_amdgcn_mfma_f32_32x32x16_bf16(kf[3],qr[1],C1,0,0,0),   P0[14],P0[15],P1[0],P1[1],   pw1[2]=PKW(P0,12),pw1[3]=PKW(P0,14), pw1); \
    VRD(2); SBAR(); GAPA(C0=__builtin_amdgcn_mfma_f32_32x32x16_bf16(kf[4],qr[2],C0,0,0,0),   P1[2],P1[3],P1[4],P1[5],     pw2[0]=PKW(P1,0), pw2[1]=PKW(P1,2), pw2); \
    VRD(6); SBAR(); GAPA(C1=__builtin_amdgcn_mfma_f32_32x32x16_bf16(kf[5],qr[2],C1,0,0,0),   P1[6],P1[7],P1[8],P1[9],     pw2[2]=PKW(P1,4), pw2[3]=PKW(P1,6), pw2); \
    VRD(3); SBAR(); GAPA(C0=__builtin_amdgcn_mfma_f32_32x32x16_bf16(kf[6],qr[3],C0,0,0,0),   P1[10],P1[11],P1[12],P1[13], pw3[0]=PKW(P1,8), pw3[1]=PKW(P1,10), pw3); \
    VRD(7); SBAR(); GAPA(C1=__builtin_amdgcn_mfma_f32_32x32x16_bf16(kf[7],qr[3],C1,0,0,0),   P1[14],P1[15],0.f,0.f,       pw3[2]=PKW(P1,12),pw3[3]=PKW(P1,14), pw3); \
    l_reg+=sacc; \
    if(GK){DMA_K((t)+3,sl_cur);} if(GV){DMA_V((t)+1,sl_next);} \
    CMASK(C0,C1,t); \
    { float a=MX3(C0[0],C0[1],C1[0]),b=MX3(C0[2],C0[3],C1[1]); a=MX3(a,C1[2],C1[3]); \
      _Pragma("unroll") for(int r=4;r<16;r+=4){a=MX3(a,C0[r],C0[r+1]);b=MX3(b,C0[r+2],C0[r+3]);a=MX3(a,C1[r],C1[r+1]);b=MX3(b,C1[r+2],C1[r+3]);} \
      float rm=__builtin_fmaxf(a,b); { auto rr=__builtin_amdgcn_permlane32_swap(__float_as_uint(rm),__float_as_uint(rm),false,false); rm=__builtin_fmaxf(__uint_as_float(rr[0]),__uint_as_float(rr[1])); } \
      resc=false; \
      if(__builtin_expect(__any(rm>(float)THRL),0)){ const float dl=__builtin_fmaxf(rm,0.f); mhat+=dl; \
        _Pragma("unroll") for(int r=0;r<16;++r){C0[r]-=dl;C1[r]-=dl;} \
        const float f=__builtin_amdgcn_exp2f(-dl); l_reg*=f; if(hi==0)wsf[r32]=f; resc=true; } } \
    SBAR(); \
    GAPB(o[0]=__builtin_amdgcn_mfma_f32_32x32x16_bf16(PAF(0),VFR(0),o[0],0,0,0), C0,0); \
    GAPB(o[1]=__builtin_amdgcn_mfma_f32_32x32x16_bf16(PAF(0),VFR(4),o[1],0,0,0), C0,4); \
    KRD(GL,0); GAPB(o[0]=__builtin_amdgcn_mfma_f32_32x32x16_bf16(PAF(1),VFR(1),o[0],0,0,0), C0,8); \
    KRD(GL,1); GAPB(o[1]=__builtin_amdgcn_mfma_f32_32x32x16_bf16(PAF(1),VFR(5),o[1],0,0,0), C0,12); \
    KRD(GL,2); GAPB(o[0]=__builtin_amdgcn_mfma_f32_32x32x16_bf16(PAF(2),VFR(2),o[0],0,0,0), C1,0); \
    KRD(GL,3); GAPB(o[1]=__builtin_amdgcn_mfma_f32_32x32x16_bf16(PAF(2),VFR(6),o[1],0,0,0), C1,4); \
    GAPB(o[0]=__builtin_amdgcn_mfma_f32_32x32x16_bf16(PAF(3),VFR(3),o[0],0,0,0), C1,8); \
    GAPB(o[1]=__builtin_amdgcn_mfma_f32_32x32x16_bf16(PAF(3),VFR(7),o[1],0,0,0), C1,12); \
    }while(0)
  int t=1;
  #undef CMASK
  #define CMASK(P0,P1,t) do{}while(0)
  for(;t+5<NT;t+=2){
    STEP(pB0,pB1,pA0,pA1,t,true,true,true);     WAIT_BAR(2); RESC(t); ROT();
    STEP(pA0,pA1,pB0,pB1,t+1,true,true,true);   WAIT_BAR(2); RESC(t+1); ROT();
  }
  #undef CMASK
  #define CMASK(P0,P1,t) do{int jb_=(t)-(NT-4); if(jb_>=0)cmask(P0,P1,jb_,qrel,hi);}while(0)
  #define ENDW(tt) do{ if((tt)+3<NT){WAIT_BAR(2);} else if((tt)+2<NT){WAIT_BAR(1);} else {WAIT_BAR(0);} }while(0)
  for(;t+1<NT;t+=2){
    STEP(pB0,pB1,pA0,pA1,t,(t+3<NT),(t+1<NT),(t+1<NT));       ENDW(t);   RESC(t); ROT();
    STEP(pA0,pA1,pB0,pB1,t+1,(t+4<NT),(t+2<NT),(t+2<NT));     ENDW(t+1); RESC(t+1); ROT();
  }
  STEP(pB0,pB1,pA0,pA1,NT-1,false,false,false); RESC(NT-1);
  { float sacc=pB0[0]+pB0[1]; _Pragma("unroll") for(int r=2;r<16;++r)sacc+=pB0[r]; _Pragma("unroll") for(int r=0;r<16;++r)sacc+=pB1[r]; l_reg+=sacc;
    pw0=(u32x4){PKW(pB0,0),PKW(pB0,2),PKW(pB0,4),PKW(pB0,6)};pw1=(u32x4){PKW(pB0,8),PKW(pB0,10),PKW(pB0,12),PKW(pB0,14)};pw2=(u32x4){PKW(pB1,0),PKW(pB1,2),PKW(pB1,4),PKW(pB1,6)};pw3=(u32x4){PKW(pB1,8),PKW(pB1,10),PKW(pB1,12),PKW(pB1,14)};
    SBAR(); pv(o,(int)(lds0+LDS_V)+((lane>>4)&1)*32+(lane&3)*8+(4*hi+((lane&15)>>2))*64+sl_cur,PAF(0),PAF(1),PAF(2),PAF(3)); }
  #undef PKW
  #undef PAF
  #undef VFR
  #undef PIN
  #undef MX3
  #undef GAPA
  #undef GAPB
  #undef EX
  #undef VRD
  #undef KRD
  #undef STEP
  #undef ENDW
  {auto rr=__builtin_amdgcn_permlane32_swap(__float_as_uint(l_reg),__float_as_uint(l_reg),false,false);l_reg=__uint_as_float(rr[0])+__uint_as_float(rr[1]);}
  if(hi==0)wsf[32+r32]=l_reg;asm volatile("s_waitcnt lgkmcnt(0)":::"memory");
  float rli[16];
  #pragma unroll
  for(int r=0;r<16;++r)rli[r]=__builtin_amdgcn_rcpf(wsf[32+crow(r,hi)]);
  bf16*Ow=O+(rowbase+q0+wid*QBLK)*DM+h*D;
  { bf16*stg=(bf16*)(shm+LDS_OST)+wid*2048;
    #pragma unroll
    for(int r=0;r<16;++r){const int orow=crow(r,hi);
      #pragma unroll
      for(int d0=0;d0<2;++d0)stg[orow*64+d0*32+r32]=__float2bfloat16(o[d0][r]*rli[r]);}
    asm volatile("s_waitcnt lgkmcnt(0)":::"memory");
    #pragma unroll
    for(int i=0;i<4;++i){const int row=i*8+(lane>>3),ch=lane&7; const u32x4 v=*(const u32x4*)(stg+row*64+ch*8); ATTN_STORE16(Ow+(long)row*DM+ch*8,v);} }
  asm volatile("s_waitcnt lgkmcnt(0)\n\ts_barrier":::"memory");
  #undef DMA_K
  #undef DMA_V
  #undef CMASK
  #undef BIASINIT
  #undef START
  #undef RESC
  #undef ROT
}
constexpr int ATTN_LDS_BYTES=LDS_BYTES;
struct AttnTensors { const bf16* Q; const bf16* K; const bf16* V; bf16* O; const float* G; const float* kmax; };
template<int THRL=8> __device__ __forceinline__ void attn_phase(char*lds,const AttnTensors&T,unsigned*counter){
  const lds_cptr shm3=(lds_cptr)lds;
  { const int t_=threadIdx.x;
    if(t_<32)*(__attribute__((address_space(3))) float*)(shm3+LDS_ORD+t_*4)=T.G[(size_t)t_*SEQ+SEQ-1];
    asm volatile("s_waitcnt vmcnt(0) lgkmcnt(0)\n\ts_barrier":::"memory");
    if(t_<32){ const float g_=*(const __attribute__((address_space(3))) float*)(shm3+LDS_ORD+t_*4); int r_=0;
      for(int j=0;j<32;++j){ const float o_=*(const __attribute__((address_space(3))) float*)(shm3+LDS_ORD+j*4); r_+=(o_<g_||(o_==g_&&j<t_))?1:0; }
      *(__attribute__((address_space(3))) int*)(shm3+LDS_ORD+128+r_*4)=t_; }
    asm volatile("s_waitcnt lgkmcnt(0)\n\ts_barrier":::"memory"); }
  for(;;){
    if(threadIdx.x==0){ const unsigned v=atomicAdd(counter,1u); *(__attribute__((address_space(3))) unsigned*)(shm3+LDS_QM+32)=v; }
    asm volatile("s_waitcnt vmcnt(0) lgkmcnt(0)\n\ts_barrier":::"memory");
    const unsigned idx=*(const __attribute__((address_space(3))) unsigned*)(shm3+LDS_QM+32);
    if(idx>=(unsigned)(BATCH*NHEAD*NQB))break;
    const int bh=*(const __attribute__((address_space(3))) int*)(shm3+LDS_ORD+128+(idx>>5)*4), qb=NQB-1-(int)(idx&31u);
    attn_unit<THRL>(bh/NHEAD,bh%NHEAD,qb,T.Q,T.K,T.V,T.O,T.G+(size_t)bh*SEQ,T.kmax[bh],lds);
  }
}
#undef SBAR
#undef WAIT_BAR
}

#define LAS __attribute__((address_space(3)))
typedef unsigned short bf16;
typedef unsigned v4u __attribute__((ext_vector_type(4)));
typedef float f32x4 __attribute__((ext_vector_type(4)));
typedef short bf16x8 __attribute__((ext_vector_type(8)));
typedef float f2v __attribute__((ext_vector_type(2)));
__device__ __forceinline__ f2v mk2(float a, float b) { f2v r; r.x = a; r.y = b; return r; }

constexpr int M = 16384, D = 1024, FF = 4096, SEQ = 8192, NPH = 25;
constexpr int TCH = 32, NCHUNK = M / TCH  , KUX = 640  ;
constexpr size_t MiB = 1u << 20;
constexpr size_t OFF_CTL = 0, OFF_BAR = 4096, ZERO_BYTES = 32768;
constexpr int LDS_MISC = 147456 - 64;
constexpr size_t OFF_LOGF = 1 * MiB, OFF_G = 2 * MiB, OFF_KMAX = 3 * MiB, OFF_WF = 3 * MiB + 4096;
constexpr size_t OFF_LAMPOW = 4 * MiB, OFF_BBAR = 4 * MiB + 1310720, OFF_KTAB = 6 * MiB;
constexpr size_t OFF_SS = OFF_KTAB;
constexpr size_t OFF_W1 = 8 * MiB, OFF_W2 = 16 * MiB, OFF_MIX = 24 * MiB, OFF_HB = 32 * MiB;
constexpr size_t OFF_K = 64 * MiB, OFF_V = 96 * MiB;
constexpr size_t OFF_A2 = 64 * MiB, OFF_WEND = 104 * MiB;
constexpr size_t OFF_A = 128 * MiB;
constexpr size_t OFF_UX = 128 * MiB, OFF_SL = 168 * MiB, OFF_Z = 192 * MiB, OFF_QO = 128 * MiB;
constexpr size_t WS_END = 256 * MiB;
constexpr int LDS_BYTES = 147456;

struct Params { const float* in[20]; float* out; unsigned char* ws; int ph_lo, ph_hi; };
enum { I_X = 0, I_MIXN, I_MLPN, I_W1, I_W2, I_LOGDT, I_ARE, I_AIM, I_BRE, I_BIM, I_CRE, I_CIM, I_DSK, I_WGLU, I_KVN, I_WKVF, I_BF, I_WQ, I_WO, I_FINN };

struct Frame { LAS unsigned char* lds; int tid, lane, wave, G; };
typedef const float* cfp_t;
__device__ __forceinline__ cfp_t kin(int i) { asm volatile("" : "+s"(i)); const __attribute__((address_space(4))) cfp_t* k = (const __attribute__((address_space(4))) cfp_t*)__builtin_amdgcn_kernarg_segment_ptr(); return k[i]; }
static_assert(offsetof(Params, in) == 0, "kin() reads Params::in at kernarg offset 0");

__device__ __forceinline__ float wave_sum(float v) {
#pragma unroll
    for (int o = 1; o < 64; o <<= 1) v += __shfl_xor(v, o);
    return v;
}
__device__ __forceinline__ unsigned pk2(float lo, float hi) { return pg8::cvt_pk_bf16(lo, hi); }
__device__ __forceinline__ float bf2f(unsigned short b) { return __uint_as_float(((unsigned)b) << 16); }

template <int MODE> __device__ __forceinline__ void conv_w(const Frame& F, const float* W, int K, int srcN, int n0, int ncols, bf16* WT, const float* gk, int b0 = 0) {
    constexpr int SP = 33;
    LAS float* scr = (LAS float*)(F.lds + F.wave * (64 * SP * 4));
    if (b0 > 0 && (int)blockIdx.x < b0) return;
    const int gw = ((int)blockIdx.x - b0) * 8 + F.wave, NGW = (F.G - b0) * 8, lane = F.lane;
    const int nblk = ncols / 32, nitems = (K / 64) * nblk;
    for (int it = gw; it < nitems; it += NGW) {
        const int kb = it / nblk, nb = it % nblk, k0 = 64 * kb, nn0 = 32 * nb;
        const float* src = W + (size_t)(k0 + (lane >> 3)) * srcN + n0 + nn0 + (lane & 7) * 4;
        f32x4 w[8];
#pragma unroll
        for (int i = 0; i < 8; ++i) w[i] = *(const f32x4*)(src + (size_t)(8 * i) * srcN);
#pragma unroll
        for (int i = 0; i < 8; ++i) { const int kk = 8 * i + (lane >> 3); const float g = gk ? gk[k0 + kk] : 1.f; LAS float* d = scr + kk * SP + (lane & 7) * 4;
            d[0] = w[i][0] * g; d[1] = w[i][1] * g; d[2] = w[i][2] * g; d[3] = w[i][3] * g; }
        asm volatile("s_waitcnt lgkmcnt(0)" ::: "memory");
        const int c = lane & 7;
#pragma unroll
        for (int j = 0; j < 4; ++j) { const int n = (lane >> 3) + 8 * j; const LAS float* s = scr + (8 * c) * SP + n;
            v4u o; o.x = pk2(s[0 * SP], s[1 * SP]); o.y = pk2(s[2 * SP], s[3 * SP]); o.z = pk2(s[4 * SP], s[5 * SP]); o.w = pk2(s[6 * SP], s[7 * SP]);
            const int nn = nn0 + n; const int row = (MODE == 1) ? (((nn & 1023) >> 7) * 256 + ((nn >> 10) & 1) * 128 + (nn & 127)) : nn;
            *(v4u*)(WT + (size_t)row * K + k0 + 8 * c) = o; }
        asm volatile("s_waitcnt lgkmcnt(0)" ::: "memory");
    }
}
__device__ __forceinline__ void conv_wf(const Frame& F, const float* wkvf, const float* kvn, bf16* WF) {
    for (int e = blockIdx.x * 512 + F.tid; e < 16 * 1024; e += F.G * 512) { const int j = e >> 10, k = e & 1023; const float w = wkvf[(size_t)k * 2064 + 2048 + j] * kvn[k];
        unsigned u = __float_as_uint(w); u = (u + 0x7fffu + ((u >> 16) & 1u)) >> 16; WF[e] = (bf16)u; }
}

__device__ __forceinline__ double dconst(double c) { asm volatile("" : "+s"(c)); return c; }
__device__ __forceinline__ double exp_d(double x) {
    const double n = rint(x * dconst(1.4426950408889634074)); const double r = (x - n * dconst(6.93147180369123816490e-01)) - n * dconst(1.90821492927058770002e-10);
    double s = 1.0, t = 1.0;
#pragma unroll 1
    for (int k = 1; k <= 16; ++k) { t *= r / (double)k; s += t; }
    const long long bits = ((long long)((int)n + 1023)) << 52; return s * __longlong_as_double(bits);
}
__device__ __forceinline__ void sincos_d(double x, double& s, double& c) {
    const double q = rint(x * dconst(0.63661977236758134308)); const int qi = (int)q;
    double r = x - q * dconst(1.57079632679489655800e+00); r -= q * dconst(6.12323399573676603587e-17);
    const double r2 = r * r;
    double sr = r, cr = 1.0, ts = r, tc = 1.0;
#pragma unroll 1
    for (int n = 1; n <= 10; ++n) { ts *= -r2 / (double)((2 * n) * (2 * n + 1)); sr += ts; tc *= -r2 / (double)((2 * n - 1) * (2 * n)); cr += tc; }
    switch (qi & 3) { case 0: s = sr; c = cr; break; case 1: s = cr; c = -sr; break; case 2: s = -sr; c = -cr; break; default: s = -cr; c = sr; break; }
}
__device__ __forceinline__ void s5_tables(const Frame& F, const Params& P, int L) {
    f2v* lampow = (f2v*)(P.ws + OFF_LAMPOW); f2v* Bbar = (f2v*)(P.ws + OFF_BBAR); float* Ktab = (float*)(P.ws + OFF_KTAB);
    LAS f2v* lp = (LAS f2v*)(F.lds);
    LAS f2v* bb = lp + 64 * 33;
    LAS f2v* cc = bb + 64 * 16;
    LAS f2v* cf = cc + 16 * 64;
    for (int item = blockIdx.x; item < 256; item += F.G) { const int g = item >> 2, qt = item & 3;
        if (F.tid < 64) { const int p = F.tid; const double dt = exp_d((double)kin(I_LOGDT)[L * 64 + g]);
            const double ar = (double)kin(I_ARE)[(L * 64 + g) * 64 + p], ai = (double)kin(I_AIM)[(L * 64 + g) * 64 + p];
            const double mag = exp_d(ar * dt); double sn, cs; sincos_d(ai * dt, sn, cs); const double lr = mag * cs, li = mag * sn;
            double pr = 1.0, pi = 0.0;
            for (int tau = 0; tau <= 32; ++tau) { const f2v v = mk2((float)pr, (float)pi); lp[p * 33 + tau] = v; if (qt == 0) lampow[(size_t)(g * 64 + p) * 33 + tau] = v; const double nr = pr * lr - pi * li, ni = pr * li + pi * lr; pr = nr; pi = ni; }
            const double nr = lr - 1.0, ni = li, den = ar * ar + ai * ai; cf[p] = mk2((float)((nr * ar + ni * ai) / den), (float)((ni * ar - nr * ai) / den)); }
        __syncthreads();
        { const float* bre_ = kin(I_BRE) + (size_t)((L * 64 + g) * 64) * 16; const float* bim_ = kin(I_BIM) + (size_t)((L * 64 + g) * 64) * 16; const float* cre_ = kin(I_CRE) + (size_t)(L * 64 + g) * 1024; const float* cim_ = kin(I_CIM) + (size_t)(L * 64 + g) * 1024;
          for (int e = F.tid; e < 1024; e += 512) { const int p = e >> 4; const float br = bre_[e], bi = bim_[e]; const f2v c = cf[p];
            const f2v v = mk2(c.x * br - c.y * bi, c.x * bi + c.y * br); bb[e] = v; if (qt == 0) Bbar[(size_t)g * 1024 + e] = v;
            cc[e] = mk2(cre_[e], cim_[e]); } }
        __syncthreads();
        { const float* dsk_ = kin(I_DSK) + L * 1024 + 16 * g;
          for (int e = qt * 2048 + F.tid; e < (qt + 1) * 2048; e += 512) { const int tau = e >> 8, cp = (e >> 4) & 15, c = e & 15; float acc = 0.f;
            for (int p = 0; p < 64; ++p) { const f2v C = cc[cp * 64 + p], l = lp[p * 33 + tau], B = bb[p * 16 + c]; const float tr = C.x * l.x - C.y * l.y, ti = C.x * l.y + C.y * l.x; acc += tr * B.x - ti * B.y; }
            if (tau == 0 && cp == c) acc += dsk_[c];
            Ktab[(size_t)g * 8192 + e] = acc; } }
        __syncthreads();
    }
}
__device__ __forceinline__ void s5_expand(const Frame& F, const Params& P, int L) {
    const f2v* lampow = (const f2v*)(P.ws + OFF_LAMPOW); const f2v* Bbar = (const f2v*)(P.ws + OFF_BBAR); const float* Ktab = (const float*)(P.ws + OFF_KTAB);
    bf16* A2 = (bf16*)(P.ws + OFF_A2); bf16* Wend = (bf16*)(P.ws + OFF_WEND);
    const int gt = blockIdx.x * 512 + F.tid, GT = F.G * 512;
    const float* cre_ = kin(I_CRE) + (size_t)L * 65536; const float* cim_ = kin(I_CIM) + (size_t)L * 65536;
#pragma unroll 4
    for (int ch = gt; ch < 32768 * 64; ch += GT) { const int row = ch >> 6, c8 = (ch & 63) * 8, g = row >> 9, tc = row & 511, t = tc >> 4, cp = tc & 15, s = c8 >> 4, c0 = c8 & 15;
        const int lag = (t - s) < 0 ? 0 : (t - s); const float* kp = Ktab + ((size_t)(g * 32 + lag) * 256 + cp * 16 + c0); f32x4 a = *(const f32x4*)kp, b = *(const f32x4*)(kp + 4);
        if (s > t) { a = (f32x4){0.f, 0.f, 0.f, 0.f}; b = a; }
        v4u o; o.x = pk2(a[0], a[1]); o.y = pk2(a[2], a[3]); o.z = pk2(b[0], b[1]); o.w = pk2(b[2], b[3]);
        *(v4u*)(A2 + (size_t)row * KUX + c8) = o; }
#pragma unroll 2
    for (int ch = gt; ch < 32768 * 16; ch += GT) { const int row = ch >> 4, j = (ch & 15) * 8, g = row >> 9, tc = row & 511, t = tc >> 4, cp = tc & 15, im = j >> 6, p0 = j & 63; float v[8];
        const size_t ci = (size_t)(g * 16 + cp) * 64 + p0; const f32x4 cr0 = *(const f32x4*)(cre_ + ci), cr1 = *(const f32x4*)(cre_ + ci + 4), ci0 = *(const f32x4*)(cim_ + ci), ci1 = *(const f32x4*)(cim_ + ci + 4);
#pragma unroll
        for (int e = 0; e < 8; ++e) { const float cr = e < 4 ? cr0[e & 3] : cr1[e & 3], cim = e < 4 ? ci0[e & 3] : ci1[e & 3]; const f2v l = lampow[(size_t)(g * 64 + p0 + e) * 33 + t + 1];
            v[e] = im ? -(cr * l.y + cim * l.x) : (cr * l.x - cim * l.y); }
        v4u o; o.x = pk2(v[0], v[1]); o.y = pk2(v[2], v[3]); o.z = pk2(v[4], v[5]); o.w = pk2(v[6], v[7]);
        *(v4u*)(A2 + (size_t)row * KUX + 512 + j) = o; }
#pragma unroll 2
    for (int ch = gt; ch < 16384 * 64; ch += GT) { const int row = ch >> 6, c8 = (ch & 63) * 8, g = row >> 8, rho = row & 255, s = c8 >> 4, c0 = c8 & 15, p = rho & 63, im = (rho >> 6) & 1; float v[8];
        const f2v l = lampow[(size_t)(g * 64 + p) * 33 + 31 - s]; const f2v* Bp = Bbar + (size_t)(g * 64 + p) * 16 + c0;
#pragma unroll
        for (int e = 0; e < 8; ++e) { const f2v B = Bp[e]; const float x = im ? (l.x * B.y + l.y * B.x) : (l.x * B.x - l.y * B.y); v[e] = (rho < 128) ? x : 0.f; }
        v4u o; o.x = pk2(v[0], v[1]); o.y = pk2(v[2], v[3]); o.z = pk2(v[4], v[5]); o.w = pk2(v[6], v[7]);
        *(v4u*)(Wend + (size_t)row * 512 + c8) = o; }
}
template <bool BF> __device__ __forceinline__ void phase_normu(const Frame& F, const void* hin, const float* gw, bf16* UX) {
    constexpr int PITCH = 1032;
    LAS bf16* tile = (LAS bf16*)F.lds;
    for (int n = blockIdx.x; n < NCHUNK; n += F.G) {
        f32x4 v[4][4]; float ss[4];
#pragma unroll
        for (int q = 0; q < 4; ++q) { const size_t ro = (size_t)(TCH * n + F.wave * 4 + q) * D;
            if (BF) { const v4u* xr = (const v4u*)((const bf16*)hin + ro) + 2 * F.lane; const v4u a = xr[0], b = xr[1];
                v[q][0] = (f32x4){pg8::bflo(a.x), pg8::bfhi(a.x), pg8::bflo(a.y), pg8::bfhi(a.y)}; v[q][1] = (f32x4){pg8::bflo(a.z), pg8::bfhi(a.z), pg8::bflo(a.w), pg8::bfhi(a.w)};
                v[q][2] = (f32x4){pg8::bflo(b.x), pg8::bfhi(b.x), pg8::bflo(b.y), pg8::bfhi(b.y)}; v[q][3] = (f32x4){pg8::bflo(b.z), pg8::bfhi(b.z), pg8::bflo(b.w), pg8::bfhi(b.w)}; }
            else { const f32x4* xr = (const f32x4*)((const float*)hin + ro) + F.lane;
#pragma unroll
                for (int j = 0; j < 4; ++j) v[q][j] = xr[64 * j]; } }
#pragma unroll
        for (int q = 0; q < 4; ++q) { float s = 0.f;
#pragma unroll
            for (int j = 0; j < 4; ++j) s += (v[q][j][0] * v[q][j][0] + v[q][j][1] * v[q][j][1]) + (v[q][j][2] * v[q][j][2] + v[q][j][3] * v[q][j][3]);
            ss[q] = pg8::rstd_of(wave_sum(s)); }
#pragma unroll
        for (int j = 0; j < 4; ++j) { const int e0 = BF ? (16 * F.lane + 4 * j) : (4 * (F.lane + 64 * j)); const f32x4 g4 = *(const f32x4*)(gw + e0);
#pragma unroll
            for (int q = 0; q < 4; ++q) { const f32x4 u = v[q][j] * ss[q] * g4; LAS unsigned* dst = (LAS unsigned*)(tile + (F.wave * 4 + q) * PITCH + e0); dst[0] = pk2(u[0], u[1]); dst[1] = pk2(u[2], u[3]); } }
        __syncthreads();
#pragma unroll 1
        for (int pass = 0; pass < 8; ++pass) { const int g = pass * 8 + (F.tid >> 6), s = (F.tid & 63) >> 1, half = F.tid & 1;
            const v4u val = *(const LAS v4u*)(tile + s * PITCH + 16 * g + 8 * half);
            *(v4u*)(UX + (size_t)(g * NCHUNK + n) * KUX + s * 16 + 8 * half) = val; }
        __syncthreads();
    }
}
__device__ __forceinline__ void phase_scan(const Frame& F, const Params& P) {
    const f2v* lampow = (const f2v*)(P.ws + OFF_LAMPOW); const float* Sl = (const float*)(P.ws + OFF_SL); bf16* UX = (bf16*)(P.ws + OFF_UX);
    for (int bg = F.wave * F.G + blockIdx.x; bg < 128; bg += 8 * F.G) { const int b = bg >> 6, g = bg & 63, p = F.lane;
        const f2v lt = lampow[(size_t)(g * 64 + p) * 33 + 32]; float xr = 0.f, xi = 0.f;
        const float* sl = Sl + (size_t)(g * NCHUNK + b * 256) * 128 + p; bf16* ux = UX + (size_t)(g * NCHUNK + b * 256) * KUX + 512 + p;
#pragma unroll 1
        for (int k0 = 0; k0 < 256; k0 += 8) { float sr[8], si[8];
#pragma unroll
            for (int j = 0; j < 8; ++j) { sr[j] = sl[(size_t)(k0 + j) * 128]; si[j] = sl[(size_t)(k0 + j) * 128 + 64]; }
#pragma unroll
            for (int j = 0; j < 8; ++j) { const unsigned w = pk2(xr, xi); ux[(size_t)(k0 + j) * KUX] = (bf16)(w & 0xffffu); ux[(size_t)(k0 + j) * KUX + 64] = (bf16)(w >> 16);
                const float nr = lt.x * xr - lt.y * xi + sr[j], ni = lt.x * xi + lt.y * xr + si[j]; xr = nr; xi = ni; } }
    }
}
__device__ __forceinline__ void phase_flogit(const Frame& F, const Params& P, const float* ss) {
    const bf16* hb = (const bf16*)(P.ws + OFF_HB); const bf16* WF = (const bf16*)(P.ws + OFF_WF); float* logf = (float*)(P.ws + OFF_LOGF);
    const int r = F.lane & 15, kq = F.lane >> 4; const float* bf_ = kin(I_BF);
    for (int task = blockIdx.x * 8 + F.wave; task < M / 16; task += F.G * 8) { const int row = task * 16 + r; f32x4 acc = {0.f, 0.f, 0.f, 0.f};
        const bf16* ap = hb + (size_t)row * D + kq * 8; const bf16* bp = WF + (size_t)r * D + kq * 8;
#pragma unroll 8
        for (int ks = 0; ks < 32; ++ks) { const bf16x8 a = *(const bf16x8*)(ap + ks * 32), b = *(const bf16x8*)(bp + ks * 32); acc = __builtin_amdgcn_mfma_f32_16x16x32_bf16(b, a, acc, 0, 0, 0); }
        const float rs = pg8::rstd_slots(ss, row, 16, kq); f32x4 o;
#pragma unroll
        for (int i = 0; i < 4; ++i) { const float x = acc[i] * rs + bf_[4 * kq + i]; o[i] = fminf(x, 0.f) - 0.6931471805599453f * __builtin_amdgcn_logf(1.0f + __builtin_amdgcn_exp2f(-1.4426950408889634f * fabsf(x))); }
        *(f32x4*)(logf + (size_t)row * 16 + 4 * kq) = o; }
}
__device__ __forceinline__ void phase_fscan(const Frame& F, const Params& P) {
    const float* logf = (const float*)(P.ws + OFF_LOGF); float* Gt = (float*)(P.ws + OFF_G); float* kmax = (float*)(P.ws + OFF_KMAX); const bf16* Kb = (const bf16*)(P.ws + OFF_K);
    LAS float* wsum = (LAS float*)F.lds; LAS float* wmax = wsum + 8;
    for (int bh = blockIdx.x; bh < 32; bh += F.G) { const int b = bh >> 4, h = bh & 15, t0 = F.tid * 16; float v[16]; float s = 0.f;
#pragma unroll
        for (int i = 0; i < 16; ++i) { v[i] = -1.4426950408889634f * logf[(size_t)(b * SEQ + t0 + i) * 16 + h]; s += v[i]; }
        float incl = s;
#pragma unroll
        for (int o = 1; o < 64; o <<= 1) { const float t = __shfl_up(incl, o); if (F.lane >= o) incl += t; }
        float km = 0.f;
#pragma unroll 4
        for (int i = 0; i < 16; ++i) { const bf16* kp = Kb + (size_t)(b * SEQ + t0 + i) * D + 64 * h; float q = 0.f;
#pragma unroll
            for (int c = 0; c < 8; ++c) { const bf16x8 kv = *(const bf16x8*)(kp + 8 * c);
#pragma unroll
                for (int e = 0; e < 8; ++e) { const float f = bf2f((unsigned short)kv[e]); q += f * f; } }
            km = fmaxf(km, q); }
#pragma unroll
        for (int o = 1; o < 64; o <<= 1) km = fmaxf(km, __shfl_xor(km, o));
        if (F.lane == 63) wsum[F.wave] = incl;
        if (F.lane == 0) wmax[F.wave] = km;
        __syncthreads();
        float base = 0.f, kmx = 0.f;
#pragma unroll
        for (int w = 0; w < 8; ++w) { if (w < F.wave) base += wsum[w]; kmx = fmaxf(kmx, wmax[w]); }
        float run = base + incl - s;
#pragma unroll
        for (int i = 0; i < 16; ++i) { run += v[i]; v[i] = run; }
#pragma unroll
        for (int i = 0; i < 4; ++i) *(f32x4*)(Gt + (size_t)bh * SEQ + t0 + 4 * i) = (f32x4){v[4 * i], v[4 * i + 1], v[4 * i + 2], v[4 * i + 3]};
        if (F.tid == 0) kmax[bh] = sqrtf(kmx);
        __syncthreads();
    }
}
__device__ __forceinline__ void phase_final(const Frame& F, const bf16* hb, float* out, const float* gw) {
    f32x4 g4[4];
#pragma unroll
    for (int j = 0; j < 4; ++j) g4[j] = *(const f32x4*)(gw + 16 * F.lane + 4 * j);
    const int stride = F.G * 8;
    for (int m0 = blockIdx.x * 8 + F.wave; m0 < M; m0 += 2 * stride) { v4u a[2], b[2];
#pragma unroll
        for (int r = 0; r < 2; ++r) { const int m = (m0 + r * stride < M) ? m0 + r * stride : m0; const v4u* xr = (const v4u*)(hb + (size_t)m * D) + 2 * F.lane; a[r] = xr[0]; b[r] = xr[1]; }
#pragma unroll
        for (int r = 0; r < 2; ++r) { const int m = m0 + r * stride; if (m >= M) break; f32x4 v[4];
            v[0] = (f32x4){pg8::bflo(a[r].x), pg8::bfhi(a[r].x), pg8::bflo(a[r].y), pg8::bfhi(a[r].y)}; v[1] = (f32x4){pg8::bflo(a[r].z), pg8::bfhi(a[r].z), pg8::bflo(a[r].w), pg8::bfhi(a[r].w)};
            v[2] = (f32x4){pg8::bflo(b[r].x), pg8::bfhi(b[r].x), pg8::bflo(b[r].y), pg8::bfhi(b[r].y)}; v[3] = (f32x4){pg8::bflo(b[r].z), pg8::bfhi(b[r].z), pg8::bflo(b[r].w), pg8::bfhi(b[r].w)};
            float ss = 0.f;
#pragma unroll
            for (int j = 0; j < 4; ++j) ss += (v[j][0] * v[j][0] + v[j][1] * v[j][1]) + (v[j][2] * v[j][2] + v[j][3] * v[j][3]);
            const float rstd = pg8::rstd_of(wave_sum(ss)); f32x4* o = (f32x4*)(out + (size_t)m * D + 16 * F.lane);
#pragma unroll
            for (int j = 0; j < 4; ++j) o[j] = v[j] * rstd * g4[j]; } }
}

__device__ __forceinline__ void conv_w1(const Frame& F, const Params& P, int L, int b0 = 0) { conv_w<0>(F, kin(I_W1) + (size_t)L * D * FF, D, FF, 0, FF, (bf16*)(P.ws + OFF_W1), kin(I_MLPN) + L * D, b0); }
__device__ __forceinline__ void conv_w2(const Frame& F, const Params& P, int L, int b0 = 0) { conv_w<0>(F, kin(I_W2) + (size_t)L * FF * D, FF, D, 0, D, (bf16*)(P.ws + OFF_W2), nullptr, b0); }
__device__ __forceinline__ void conv_glu(const Frame& F, const Params& P, int L) { conv_w<1>(F, kin(I_WGLU) + (size_t)L * D * 2 * D, D, 2 * D, 0, 2 * D, (bf16*)(P.ws + OFF_MIX), nullptr); }
__device__ __forceinline__ void conv_attn(const Frame& F, const Params& P, int j, bool with_kv) {
    bf16* mix = (bf16*)(P.ws + OFF_MIX);
    conv_w<0>(F, kin(I_WQ) + (size_t)j * D * D, D, D, 0, D, mix, kin(I_MIXN) + (2 + j) * D);
    conv_w<0>(F, kin(I_WO) + (size_t)j * D * D, D, D, 0, D, mix + (size_t)3 * D * D, nullptr);
    if (with_kv) { conv_w<0>(F, kin(I_WKVF), D, 2064, 0, 2 * D, mix + (size_t)D * D, kin(I_KVN)); conv_wf(F, kin(I_WKVF), kin(I_KVN), (bf16*)(P.ws + OFF_WF)); }
}
__device__ __forceinline__ bool side_jobs(const Frame& F, const Params& P, int ph) {
    switch (ph) {
    case 0:  s5_tables(F, P, 0); conv_glu(F, P, 0); return true;
    case 2:  { const int b0 = (F.G > 128) ? 128 : 0; conv_w1(F, P, 0, b0); conv_w2(F, P, 0, b0); } return true;
    case 5:  conv_glu(F, P, 1); return true;
    case 6:  s5_tables(F, P, 1); return true;
    case 8:  { const int b0 = (F.G > 128) ? 128 : 0; conv_w1(F, P, 1, b0); conv_w2(F, P, 1, b0); } return true;
    case 11: conv_attn(F, P, 0, true); return true;
    case 14: { const int b0 = (F.G > 32) ? 32 : 0; conv_w1(F, P, 2, b0); conv_w2(F, P, 2, b0); } return true;
    case 17: conv_attn(F, P, 1, false); return true;
    case 18: conv_w1(F, P, 3); return true;
    case 19: conv_w2(F, P, 3); return true;
    default: return false;
    }
}

#define XB_TMO      128
#define XB_XCNT(j)  (256  + 64 * (j))
#define XB_XSUB(j)  (1280 + 64 * (j))
#define XB_XGEN(j)  (2304 + 64 * (j))
#define XB_TOP      3328
#define XB_TOPGEN   3392
#define XCD_BAR_WORDS 3456
#define XB_SPIN_CAP (1u << 18)

__device__ __forceinline__ unsigned xb_ld(unsigned* p)              { return __hip_atomic_load(p, __ATOMIC_RELAXED, __HIP_MEMORY_SCOPE_AGENT); }
__device__ __forceinline__ unsigned xb_add(unsigned* p, unsigned v) { return __hip_atomic_fetch_add(p, v, __ATOMIC_RELAXED, __HIP_MEMORY_SCOPE_AGENT); }
__device__ __forceinline__ unsigned xb_xcc_id() { return (unsigned)__builtin_amdgcn_s_getreg((3 << 11) | 20) & 0xFu; }
#define XB_SPIN(cond, bar) do { unsigned _sp = 0; while (cond) { __builtin_amdgcn_s_sleep(1); \
    if ((++_sp & 255u) == 0u) { if (xb_ld(&(bar)[XB_TMO])) break; if (_sp > XB_SPIN_CAP) { atomicAdd(&(bar)[XB_TMO], 1u); break; } } } } while (0)

struct XcdBarrier {
    unsigned* bar; unsigned x;
    volatile LAS unsigned* st;
};

__device__ __forceinline__ XcdBarrier xcd_barrier_post(unsigned* bar, volatile LAS unsigned* st) {
    XcdBarrier b; b.bar = bar; b.x = xb_xcc_id(); b.st = st;
    if (threadIdx.x == 0) (void)xb_add(&bar[XB_XCNT(b.x)], 1u);
    return b;
}
__device__ __forceinline__ void xcd_barrier_complete(unsigned* bar, unsigned x, unsigned& nloc, unsigned& nx) {
    const unsigned G = gridDim.x * gridDim.y * gridDim.z;
    unsigned sum, cnt, mine, sp = 0u;
    for (;;) {
        sum = 0u; cnt = 0u; mine = 0u;
#pragma unroll
        for (unsigned j = 0; j < 16; ++j) { const unsigned c = xb_ld(&bar[XB_XCNT(j)]); sum += c; cnt += (c > 0u) ? 1u : 0u; mine = (j == x) ? c : mine; }
        if (sum == G) break;
        __builtin_amdgcn_s_sleep(1);
        if ((++sp & 255u) == 0u) { if (xb_ld(&bar[XB_TMO])) break; if (sp > XB_SPIN_CAP) { atomicAdd(&bar[XB_TMO], 1u); break; } }
    }
    nloc = mine > 0u ? mine : 1u; nx = cnt > 0u ? cnt : 1u;
}

__device__ __forceinline__ void xcd_barrier(const XcdBarrier& b) {
    asm volatile("s_waitcnt vmcnt(0)" ::: "memory");
    __syncthreads();
    if (ltid() == 0) {
        unsigned* bar = b.bar;
        __builtin_amdgcn_s_waitcnt(0);
        unsigned nloc = b.st[0], nx = b.st[1];
        if (nloc == 0u) { xcd_barrier_complete(bar, b.x, nloc, nx); b.st[0] = nloc; b.st[1] = nx; }
        const unsigned old = xb_add(&bar[XB_XSUB(b.x)], 1u);
        const unsigned gen = old / nloc;
        if (old + 1u == (gen + 1u) * nloc) {
            __builtin_amdgcn_fence(__ATOMIC_RELEASE, "agent");
            asm volatile("s_waitcnt vmcnt(0)" ::: "memory");
            const unsigned og = xb_add(&bar[XB_TOP], 1u);
            const unsigned tg = og / nx;
            if (og + 1u == (tg + 1u) * nx) xb_add(&bar[XB_TOPGEN], 1u);
            else XB_SPIN(xb_ld(&bar[XB_TOPGEN]) == tg, bar);
            __builtin_amdgcn_fence(__ATOMIC_ACQUIRE, "agent");
            xb_add(&bar[XB_XGEN(b.x)], 1u);
            asm volatile("s_waitcnt vmcnt(0)" ::: "memory");
        } else {
            XB_SPIN(xb_ld(&bar[XB_XGEN(b.x)]) == gen, bar);
            __builtin_amdgcn_fence(__ATOMIC_ACQUIRE, "agent");
            asm volatile("s_waitcnt vmcnt(0)" ::: "memory");
        }
    }
    __syncthreads();
}

constexpr int LDS_RSTD = 131072 + 1024;
template <class Sched> __device__ __forceinline__ void precompute_rstd(const Frame& F, const Sched& S, const float* ss, int ns) {
    LAS float* rb = (LAS float*)(F.lds + LDS_RSTD); pg8::Unit u;
    for (int i = 0; i < 8 && S.next(i, u); ++i) { const int row = F.tid >> 1, half = F.tid & 1; const f32x4* p = (const f32x4*)(ss + (size_t)(u.pm * 256 + row) * ns + half * (ns >> 1));
        f32x4 v = p[0]; float s = (v[0] + v[1]) + (v[2] + v[3]); v = p[1]; s += (v[0] + v[1]) + (v[2] + v[3]);
        if (ns == 32) { v = p[2]; s += (v[0] + v[1]) + (v[2] + v[3]); v = p[3]; s += (v[0] + v[1]) + (v[2] + v[3]); }
        s += __shfl_xor(s, 1); if (!half) rb[i * 256 + row] = pg8::rstd_of(s); }
    __syncthreads();
}

__global__ void __launch_bounds__(512, 2) trunk_fwd(Params P) {
    extern __shared__ __attribute__((aligned(16))) unsigned char lds[];
    Frame F; F.lds = (LAS unsigned char*)lds; F.G = gridDim.x;
    volatile LAS unsigned* bst = (volatile LAS unsigned*)((LAS unsigned char*)lds + LDS_MISC);
    if (threadIdx.x < 2) bst[threadIdx.x] = 0u;
    __syncthreads();
    const bool one_launch = (P.ph_hi - P.ph_lo) > 1;
    XcdBarrier bar; bar.bar = (unsigned*)(P.ws + OFF_BAR); bar.x = 0; bar.st = bst;
    if (one_launch) bar = xcd_barrier_post((unsigned*)(P.ws + OFF_BAR), bst);
    unsigned char* ws = P.ws;
    float* ssp = (float*)(ws + OFF_SS);
    bf16* HB = (bf16*)(ws + OFF_HB);
    bool dup_done = false;
    for (int ph = P.ph_lo; ph < P.ph_hi; ++ph) {
        F.tid = ltid(); F.lane = F.tid & 63; F.wave = __builtin_amdgcn_readfirstlane(F.tid >> 6); { int g_ = (int)gridDim.x; asm volatile("" : "+s"(g_)); F.G = g_; }
        int kind, L;
        if (ph == 0) { kind = 0; L = 0; }
        else if (ph <= 12) { L = (ph - 1) / 6; const int k = (ph - 1) % 6; kind = (k < 2) ? 1 + k : 2 + k; }
        else if (ph <= 18) { L = 2; const int k = ph - 13; kind = (k < 4) ? 8 + k : 2 + k; }
        else if (ph <= 23) { L = 3; const int k = ph - 19; kind = (k == 0) ? 8 : (k <= 2 ? 9 + k : 3 + k); }
        else { kind = 12; L = 3; }
        if (DBG_SIDE_REPS > 1 && !dup_done) { side_jobs(F, P, ph); asm volatile("s_waitcnt vmcnt(0) lgkmcnt(0)" ::: "memory"); __syncthreads(); }
        if (((DBG_KM >> 0) & 1) && !dup_done && side_jobs(F, P, ph)) { asm volatile("s_waitcnt vmcnt(0) lgkmcnt(0)" ::: "memory"); __syncthreads(); }
        switch (kind) {
        case 1: if constexpr ((DBG_KM >> 1) & 1) { s5_expand(F, P, L); if (L == 0) phase_normu<false>(F, kin(I_X), kin(I_MIXN), (bf16*)(ws + OFF_UX)); else phase_normu<true>(F, HB, kin(I_MIXN) + L * D, (bf16*)(ws + OFF_UX)); } break;
        case 2: if constexpr ((DBG_KM >> 2) & 1) { pg8::Gemm g{(const bf16*)(ws + OFF_UX), (const bf16*)(ws + OFF_WEND), KUX, 512, 512}; pg8::OrderSloc S{F.G, (int)blockIdx.x};
                  pg8::EpiSlocScan E{(const pg8::f2v_t*)(ws + OFF_LAMPOW), (bf16*)(ws + OFF_UX)};
                  pg8::gemm_phase<pg8::EpiSlocScan, pg8::OrderSloc, true, true>(F.lds, g, S, E); } break;
        case 4: if constexpr ((DBG_KM >> 4) & 1) { pg8::Gemm g{(const bf16*)(ws + OFF_UX), (const bf16*)(ws + OFF_A2), KUX, KUX, KUX}; pg8::OrderY S{F.G, (int)blockIdx.x}; pg8::EpiY E{(bf16*)(ws + OFF_Z)};
                  pg8::gemm_phase<pg8::EpiY, pg8::OrderY, true, true>(F.lds, g, S, E); } break;
        case 5: if constexpr ((DBG_KM >> 5) & 1) { pg8::Gemm g{(const bf16*)(ws + OFF_Z), (const bf16*)(ws + OFF_MIX), 16, D, D, M * 32, 4 * M * 32, 16 * M * 32};      pg8::StaticOrder S; S.init(M, 2 * D, F.G, (int)blockIdx.x);
                  pg8::EpiRes<true> E{(L == 0) ? kin(I_X) : (const float*)nullptr, HB, ssp};
                  pg8::gemm_phase<pg8::EpiRes<true>, pg8::StaticOrder, true, true>(F.lds, g, S, E); } break;
        case 6: if constexpr ((DBG_KM >> 6) & 1) { const int ns = (L < 2) ? 32 : 16;
                  pg8::Gemm g{HB, (const bf16*)(ws + OFF_W1), D, D, D}; pg8::StaticOrder S; S.init(M, FF, F.G, (int)blockIdx.x); precompute_rstd(F, S, ssp, ns); pg8::EpiMLP1 E{(bf16*)(ws + OFF_A), (const LAS float*)(F.lds + LDS_RSTD)};
                  pg8::gemm_phase<pg8::EpiMLP1, pg8::StaticOrder, true, true>(F.lds, g, S, E); } break;
        case 7: case 11: if constexpr ((DBG_KM >> 7) & 1) { const bool mlp = (kind == 7); const bool need_ss = !(mlp && (L == 0 || L == 3));
                  pg8::Gemm g{mlp ? (const bf16*)(ws + OFF_A) : (const bf16*)(ws + OFF_Z), mlp ? (const bf16*)(ws + OFF_W2) : (const bf16*)(ws + OFF_MIX) + (size_t)3 * D * D, mlp ? 256 : D, mlp ? FF : D, mlp ? FF : D, 32, 128, mlp ? M * 512 : 512};
                  pg8::StaticOrder S; S.init(M, D, F.G, (int)blockIdx.x); pg8::EpiRes<false> E{(const float*)nullptr, HB, need_ss ? ssp : (float*)nullptr};
                  pg8::gemm_phase<pg8::EpiRes<false>, pg8::StaticOrder, true, true>(F.lds, g, S, E); } break;
        case 8: if constexpr ((DBG_KM >> 8) & 1) { const float* ss = ssp;
                  if (L == 2) phase_flogit(F, P, ss);
                  pg8::Gemm g{HB, (const bf16*)(ws + OFF_MIX), D, D, D}; pg8::StaticOrder S; S.init(M, (L == 2) ? 3 * D : D, F.G, (int)blockIdx.x);
                  static_assert(OFF_V == OFF_K + 32 * MiB && OFF_QO == OFF_K + 64 * MiB, "EpiQKV slot map"); precompute_rstd(F, S, ss, 16); pg8::EpiQKV E{(bf16*)(ws + OFF_K), (const LAS float*)(F.lds + LDS_RSTD), attn_body::C2};
                  pg8::gemm_phase<pg8::EpiQKV, pg8::StaticOrder, true, true>(F.lds, g, S, E); } break;
        case 9: if constexpr ((DBG_KM >> 9) & 1) { phase_fscan(F, P); } break;
        case 10: if constexpr ((DBG_KM >> 10) & 1) { const attn_body::AttnTensors AT{(const attn_body::bf16*)(ws + OFF_QO), (const attn_body::bf16*)(ws + OFF_K), (const attn_body::bf16*)(ws + OFF_V), (attn_body::bf16*)(ws + OFF_Z), (const float*)(ws + OFF_G), (const float*)(ws + OFF_KMAX)};
                  attn_body::attn_phase<32>((char*)lds, AT, (unsigned*)(ws + OFF_CTL) + 64 * (L - 2) + (dup_done ? 128 : 0)); } break;
        case 12: if constexpr ((DBG_KM >> 12) & 1) { phase_final(F, HB, P.out, kin(I_FINN)); } break;
        default: break;
        }
        if (DBG_DUP != 0u) { if (((DBG_DUP >> kind) & 1u) && !dup_done) { dup_done = true; --ph; xcd_barrier(bar); continue; } dup_done = false; }
        if (ph + 1 < P.ph_hi) {
            for (int r_ = 0; r_ < DBG_SYNC_REPS; ++r_) xcd_barrier(bar);
        }
        if (P.ph_hi < 0) cg::this_grid().sync();
    }
}

extern "C" void kernel_launch(void* const* d_in, const int* in_sizes, int n_in, void* d_out, int out_size, void* d_ws, size_t ws_size, hipStream_t stream) {
    static int grid = 0;
    if (grid == 0) {
        if (n_in != 20 || in_sizes[0] != M * D || out_size != M * D || ws_size < WS_END) { fprintf(stderr, "kernel_launch: unexpected shapes (n_in %d, in0 %d, out %d, ws %zu); nothing launched\n", n_in, n_in > 0 ? in_sizes[0] : -1, out_size, ws_size); grid = -1; return; }
        int dev = 0, cus = 0, per_cu = 0;
        if (hipGetDevice(&dev) != hipSuccess || hipDeviceGetAttribute(&cus, hipDeviceAttributeMultiprocessorCount, dev) != hipSuccess) { grid = -1; return; }
        if (hipFuncSetAttribute((const void*)trunk_fwd, hipFuncAttributeMaxDynamicSharedMemorySize, LDS_BYTES) != hipSuccess) { fprintf(stderr, "kernel_launch: hipFuncSetAttribute failed\n"); grid = -1; return; }
        if (hipOccupancyMaxActiveBlocksPerMultiprocessor(&per_cu, (const void*)trunk_fwd, 512, LDS_BYTES) != hipSuccess || per_cu < 1) { fprintf(stderr, "kernel_launch: occupancy query says %d\n", per_cu); per_cu = 1; }
        (void)hipGetLastError();
        grid = cus * per_cu;
    }
    if (grid < 0) return;
    (void)hipMemsetAsync((char*)d_ws + OFF_CTL, 0, ZERO_BYTES, stream);
    Params p{};
    for (int i = 0; i < 20; ++i) p.in[i] = (const float*)d_in[i];
    p.out = (float*)d_out; p.ws = (unsigned char*)d_ws;
#if MK_MULTI_LAUNCH
    for (int ph = 0; ph < NPH; ++ph) { p.ph_lo = ph; p.ph_hi = ph + 1; hipLaunchKernelGGL(trunk_fwd, dim3(grid), dim3(512), LDS_BYTES, stream, p); }
#else
    p.ph_lo = 0; p.ph_hi = NPH;
    void* args[] = {&p};
    const hipError_t e = hipLaunchCooperativeKernel((const void*)trunk_fwd, dim3(grid), dim3(512), args, LDS_BYTES, stream);
    if (e != hipSuccess) fprintf(stderr, "kernel_launch: cooperative launch failed: %s (grid %d)\n", hipGetErrorString(e), grid);
#endif
}
```

```cpp
#include <hip/hip_runtime.h>
#include <hip/hip_cooperative_groups.h>
#include <hip/hip_bf16.h>
#include <cstdio>
#include <cstdint>
#include <cmath>
namespace cg = cooperative_groups;
#ifndef MK_MULTI_LAUNCH
#define MK_MULTI_LAUNCH 0
#endif
__device__ __forceinline__ int ltid() { int t = (int)threadIdx.x; asm volatile("" : "+v"(t)); return t; }
#ifndef DBG_KM
#define DBG_KM 0xffffu
#endif
#ifndef DBG_SYNC_REPS
#define DBG_SYNC_REPS 1
#endif
#ifndef DBG_DUP
#define DBG_DUP 0u
#endif
#ifndef DBG_SIDE_REPS
#define DBG_SIDE_REPS 1
#endif
#ifndef DBG_PROBE
#define DBG_PROBE 0
#endif
namespace pg8 {
#define PG8_LAS __attribute__((address_space(3)))
typedef unsigned short bf16_t;
typedef short bf16x8 __attribute__((ext_vector_type(8)));
typedef float f32x4 __attribute__((ext_vector_type(4)));
typedef unsigned u32x4 __attribute__((ext_vector_type(4)));
constexpr int BM = 256, BK = 64, HALF = 128, HTB = HALF * BK * 2  , STAGE_BYTES = 8 * HTB, NXCD = 8, WGM = 8;

__host__ __device__ __forceinline__ int lds_byte(int r, int c) { const int st = (r >> 4) * 2 + (c >> 5), rr = r & 15, cc = c & 31, ob = rr * 64 + cc * 2; return st * 1024 + (ob ^ (((ob >> 9) & 1) << 5)); }
__host__ __device__ __forceinline__ void stage_rc(int b, int& R, int& C) { const int st = b / 1024, sb = b % 1024, swz = sb ^ (((sb >> 9) & 1) << 5); R = (st >> 1) * 16 + swz / 64; C = (st & 1) * 32 + (swz % 64) / 2; }
__host__ __device__ __forceinline__ int perm32(int rho) { const int n = rho >> 4, i = rho & 15; return 8 * (i >> 2) + 4 * n + (i & 3); }

struct Unit { int pm, pn; };
struct Gemm { const bf16_t* A; const bf16_t* Bt; int lda, ldb, K; int a_gs = 32, a_ks = 128, a_ts = 512; };

struct StaticOrder {
    int nM, nN, nwg, G, c;
    __host__ __device__ void init(int M, int N, int G_, int c_) { nM = M / BM; nN = N / BM; nwg = nM * nN; G = G_; c = c_; }
    __host__ __device__ bool next(int i, Unit& u) const {
        const long L = (long)i * G + c; if (L >= nwg) return false;
        int wgid = (int)L; { const int q = nwg / NXCD, r = nwg % NXCD, xcd = wgid % NXCD, off = wgid / NXCD; wgid = (xcd < r ? xcd * (q + 1) : r * (q + 1) + (xcd - r) * q) + off; }
        const int nig = WGM * nN, gid = wgid / nig, fm = gid * WGM, gsz = (nM - fm) < WGM ? (nM - fm) : WGM;
        u.pm = fm + ((wgid % nig) % gsz); u.pn = (wgid % nig) / gsz; return true;
    }
    __device__ __forceinline__ void a_ready(const Unit&) const {}
    __device__ __forceinline__ void done(const Unit&) const {}
};

typedef float cvt_f32x2_t __attribute__((ext_vector_type(2))); typedef __bf16 cvt_bf16x2_t __attribute__((ext_vector_type(2)));
__device__ __forceinline__ unsigned cvt_pk_bf16(float lo, float hi) { const cvt_f32x2_t v = {lo, hi}; const cvt_bf16x2_t b = __builtin_convertvector(v, cvt_bf16x2_t); return __builtin_bit_cast(unsigned, b); }
typedef float f32x2 __attribute__((ext_vector_type(2)));
__device__ __forceinline__ f32x2 gelu_pk(f32x2 v) {
    const f32x2 av = __builtin_elementwise_abs(v), d = av * 0.2316418882f + 1.0f;
    f32x2 t; t.x = __builtin_amdgcn_rcpf(d.x); t.y = __builtin_amdgcn_rcpf(d.y);
    f32x2 q = t * 0.5307027145f + (-0.7265760135f); q = q * t + 0.7107068705f; q = q * t + (-0.142248368f); q = q * t + 0.127414796f; q = q * t;
    const f32x2 s = (v * v) * (-0.72134752044f);
    f32x2 e; e.x = __builtin_amdgcn_exp2f(s.x); e.y = __builtin_amdgcn_exp2f(s.y);
    const f32x2 m = v * (q * e), r = v - m;
    f32x2 o; o.x = v.x < 0.f ? m.x : r.x; o.y = v.y < 0.f ? m.y : r.y; return o;
}

template <int ACT  > struct EpiBf16 {
    static constexpr bool PERM = true, AFTER_DRAIN = false; static_assert(ACT == 0 || ACT == 1, "EpiBf16: ACT is 0 (none) or 1 (gelu_pk)");
    bf16_t* O; int ldc; const float* bias; int split_cols; size_t split_stride; float scale0;
    __device__ __forceinline__ void operator()(const f32x4 (&acc)[2][2][4][2], const Unit& u, int wr, int wc, int fr, int fq) const {
        const int row0 = u.pm * BM + wr * 64 + fr; int colt = u.pn * BM; bf16_t* base = O;
        float sc = 1.f; if (split_cols) { const int t = colt / split_cols; base += (size_t)t * split_stride; colt -= t * split_cols; if (t == 0) sc = scale0; }
        const int col0 = colt + wc * 32 + 8 * fq, bcol0 = u.pn * BM + wc * 32 + 8 * fq;
        f32x4 bv[2][2];
#pragma unroll
        for (int bj = 0; bj < 2; ++bj)
#pragma unroll
            for (int n = 0; n < 2; ++n) bv[bj][n] = bias ? *(const f32x4*)(bias + bcol0 + bj * HALF + 4 * n) : (f32x4){0.f, 0.f, 0.f, 0.f};
#pragma unroll
        for (int ai = 0; ai < 2; ++ai)
#pragma unroll
            for (int m = 0; m < 4; ++m) { bf16_t* rowp = base + (size_t)(row0 + ai * HALF + m * 16) * ldc + col0;
#pragma unroll
                for (int bj = 0; bj < 2; ++bj) { f32x4 v0 = acc[ai][bj][m][0] + bv[bj][0], v1 = acc[ai][bj][m][1] + bv[bj][1];
                    if (ACT == 1) { f32x2 a = gelu_pk((f32x2){v0[0], v0[1]}), b = gelu_pk((f32x2){v0[2], v0[3]}), c = gelu_pk((f32x2){v1[0], v1[1]}), d = gelu_pk((f32x2){v1[2], v1[3]});
                        v0 = (f32x4){a.x, a.y, b.x, b.y}; v1 = (f32x4){c.x, c.y, d.x, d.y}; }
                    v0 = v0 * sc; v1 = v1 * sc; u32x4 w; w.x = cvt_pk_bf16(v0[0], v0[1]); w.y = cvt_pk_bf16(v0[2], v0[3]); w.z = cvt_pk_bf16(v1[0], v1[1]); w.w = cvt_pk_bf16(v1[2], v1[3]);
                    *(u32x4*)(rowp + bj * HALF) = w; } }
    }
};


constexpr float RMS_EPS_F = 1e-6f;
__device__ __forceinline__ float rstd_of(float ss) { return 1.0f / sqrtf(ss * (1.0f / 1024.0f) + RMS_EPS_F); }
__device__ __forceinline__ float rstd_slots(const float* ss, int row, int ns, int fq) {
    const f32x4* p = (const f32x4*)(ss + (size_t)row * ns + fq * (ns >> 2)); f32x4 v = p[0]; float s = (v[0] + v[1]) + (v[2] + v[3]);
    if (ns == 32) { v = p[1]; s += (v[0] + v[1]) + (v[2] + v[3]); }
    s += __shfl_xor(s, 16); s += __shfl_xor(s, 32); return rstd_of(s); }
__device__ __forceinline__ u32x4 pack8(f32x4 v0, f32x4 v1) { u32x4 w; w.x = cvt_pk_bf16(v0[0], v0[1]); w.y = cvt_pk_bf16(v0[2], v0[3]); w.z = cvt_pk_bf16(v1[0], v1[1]); w.w = cvt_pk_bf16(v1[2], v1[3]); return w; }
__device__ __forceinline__ float fast_sigmoid(float x) { return __builtin_amdgcn_rcpf(1.0f + __builtin_amdgcn_exp2f(-1.4426950408889634f * x)); }
__device__ __forceinline__ f32x2 gelu_tanh2(f32x2 y) {
    const f32x2 t = y * y, u = y * (t * (-0.10294324f) + (-2.3022082f));
    f32x2 e; e.x = __builtin_amdgcn_exp2f(u.x); e.y = __builtin_amdgcn_exp2f(u.y);
    const f32x2 d = e + 1.0f; f32x2 r; r.x = __builtin_amdgcn_rcpf(d.x); r.y = __builtin_amdgcn_rcpf(d.y);
    return y * r;
}

struct EpiQKV {
    static constexpr bool PERM = true, AFTER_DRAIN = false;
    bf16_t* Kb; const PG8_LAS float* rb; float scale0; mutable int ui = 0;
    __device__ __forceinline__ void operator()(const f32x4 (&acc)[2][2][4][2], const Unit& u, int wr, int wc, int fr, int fq) const {
        int colt = u.pn * BM; const int t = colt >> 10; colt &= 1023; const int slot = (t == 0) ? 2 : (t - 1); bf16_t* base = Kb + (size_t)slot * (16u << 20); const float sc = (t == 0) ? scale0 : 1.f;
        const int col0 = colt + wc * 32 + 8 * fq, row0 = u.pm * BM + wr * 64 + fr;
        const PG8_LAS float* rq = rb + ui * 256; ++ui;
#pragma unroll
        for (int ai = 0; ai < 2; ++ai)
#pragma unroll
            for (int m = 0; m < 4; ++m) { const int row = row0 + ai * HALF + m * 16; const float rs = rq[wr * 64 + fr + ai * HALF + m * 16] * sc; bf16_t* rowp = base + (size_t)row * 1024 + col0;
#pragma unroll
                for (int bj = 0; bj < 2; ++bj) *(u32x4*)(rowp + bj * HALF) = pack8(acc[ai][bj][m][0] * rs, acc[ai][bj][m][1] * rs); }
    }
};
struct EpiMLP1 {
    static constexpr bool PERM = true, AFTER_DRAIN = false;
    bf16_t* O; const PG8_LAS float* rb; mutable int ui = 0;
    __device__ __forceinline__ void operator()(const f32x4 (&acc)[2][2][4][2], const Unit& u, int wr, int wc, int fr, int fq) const {
        const int row0 = u.pm * BM + wr * 64 + fr; const PG8_LAS float* rq = rb + ui * 256; ++ui;
#pragma unroll
        for (int ai = 0; ai < 2; ++ai)
#pragma unroll
            for (int m = 0; m < 4; ++m) { const int row = row0 + ai * HALF + m * 16; const float rs = rq[wr * 64 + fr + ai * HALF + m * 16]; bf16_t* rowp = O + ((size_t)u.pn * 16384 + row) * 256 + wc * 32 + 8 * fq;
#pragma unroll
                for (int bj = 0; bj < 2; ++bj) { f32x4 v0 = acc[ai][bj][m][0] * rs, v1 = acc[ai][bj][m][1] * rs;
#pragma unroll
                    for (int e = 0; e < 4; ++e) { const float a = fmaxf(v0[e], 0.f), b = fmaxf(v1[e], 0.f); v0[e] = a * a; v1[e] = b * b; }
                    *(u32x4*)(rowp + bj * HALF) = pack8(v0, v1); } }
    }
};
__device__ __forceinline__ float bflo(unsigned w) { return __uint_as_float(w << 16); }
__device__ __forceinline__ float bfhi(unsigned w) { return __uint_as_float(w & 0xffff0000u); }
template <bool GLU> struct EpiRes {
    static constexpr bool PERM = true, AFTER_DRAIN = false;
    const float* hin32; bf16_t* hb; float* ss;
    __device__ __forceinline__ void operator()(const f32x4 (&acc)[2][2][4][2], const Unit& u, int wr, int wc, int fr, int fq) const {
        constexpr int NB = GLU ? 1 : 2;
        const int row0 = u.pm * BM + wr * 64 + fr, colb = GLU ? (u.pn * HALF + wc * 32 + 8 * fq) : (u.pn * BM + wc * 32 + 8 * fq);
#pragma unroll
        for (int ai = 0; ai < 2; ++ai) {
            f32x4 r0[4][NB], r1[4][NB];
            if (hin32) {
#pragma unroll
                for (int m = 0; m < 4; ++m)
#pragma unroll
                    for (int bj = 0; bj < NB; ++bj) { const size_t off = (size_t)(row0 + ai * HALF + m * 16) * 1024 + colb + bj * HALF; r0[m][bj] = *(const f32x4*)(hin32 + off); r1[m][bj] = *(const f32x4*)(hin32 + off + 4); }
            } else { u32x4 w[4][NB];
#pragma unroll
                for (int m = 0; m < 4; ++m)
#pragma unroll
                    for (int bj = 0; bj < NB; ++bj) w[m][bj] = *(const u32x4*)(hb + (size_t)(row0 + ai * HALF + m * 16) * 1024 + colb + bj * HALF);
#pragma unroll
                for (int m = 0; m < 4; ++m)
#pragma unroll
                    for (int bj = 0; bj < NB; ++bj) { const u32x4 x = w[m][bj]; r0[m][bj] = (f32x4){bflo(x.x), bfhi(x.x), bflo(x.y), bfhi(x.y)}; r1[m][bj] = (f32x4){bflo(x.z), bfhi(x.z), bflo(x.w), bfhi(x.w)}; } }
#pragma unroll
            for (int m = 0; m < 4; ++m) { const int row = row0 + ai * HALF + m * 16; float s = 0.f;
#pragma unroll
                for (int bj = 0; bj < NB; ++bj) { const size_t off = (size_t)row * 1024 + colb + bj * HALF; f32x4 o[2] = {r0[m][bj], r1[m][bj]};
#pragma unroll
                    for (int n = 0; n < 2; ++n) { f32x4 v = acc[ai][bj][m][n];
                        if (GLU) { const f32x4 gt = acc[ai][1][m][n];
#pragma unroll
                            for (int e = 0; e < 4; ++e) v[e] = v[e] * fast_sigmoid(gt[e]); }
                        o[n] = o[n] + v;
                        s += (o[n][0] * o[n][0] + o[n][1] * o[n][1]) + (o[n][2] * o[n][2] + o[n][3] * o[n][3]); }
                    *(u32x4*)(hb + off) = pack8(o[0], o[1]); }
                s += __shfl_xor(s, 16); s += __shfl_xor(s, 32);
                if (ss && fq == 0) ss[(size_t)row * (GLU ? 32 : 16) + u.pn * 4 + wc] = s; } }
    }
};
typedef float f2v_t __attribute__((ext_vector_type(2)));
struct EpiSlocScan {
    static constexpr bool PERM = true, AFTER_DRAIN = true;
    const f2v_t* lampow; bf16_t* UX;
    __device__ __forceinline__ void fused(f32x4 (&acc)[2][2][4][2], const Unit& u, int wr, int wc, int fr, int fq, PG8_LAS unsigned char* lds, int wid, int lane) const {
        constexpr int TP = 132;
        PG8_LAS float* T = (PG8_LAS float*)lds; const int col = wc * 32 + 8 * fq;
#pragma unroll
        for (int ai = 0; ai < 2; ++ai)
#pragma unroll
            for (int m = 0; m < 4; ++m) { const int n = ai * HALF + wr * 64 + m * 16 + fr; PG8_LAS float* p = T + n * TP + col;
                *(PG8_LAS f32x4*)(p) = acc[ai][0][m][0]; *(PG8_LAS f32x4*)(p + 4) = acc[ai][0][m][1]; }
        asm volatile("s_waitcnt lgkmcnt(0)" ::: "memory"); __builtin_amdgcn_s_barrier(); asm volatile("" ::: "memory");
        { const int g = u.pn, p = lane; const f2v_t lt = lampow[(size_t)(g * 64 + p) * 33 + 32]; float xr = 0.f, xi = 0.f;
          PG8_LAS float* Tw = T + (wid * 32) * TP + p; PG8_LAS float* E = T + 256 * TP;
#pragma unroll 4
          for (int k = 0; k < 32; ++k) { const float sr = Tw[k * TP], si = Tw[k * TP + 64]; const float nr = lt.x * xr - lt.y * xi + sr, ni = lt.x * xi + lt.y * xr + si; xr = nr; xi = ni; }
          E[wid * 128 + p] = xr; E[wid * 128 + 64 + p] = xi;
          f2v_t l32 = lt;
#pragma unroll
          for (int q = 0; q < 5; ++q) { const float a = l32.x * l32.x - l32.y * l32.y, b = 2.f * l32.x * l32.y; l32.x = a; l32.y = b; }
          asm volatile("s_waitcnt lgkmcnt(0)" ::: "memory"); __builtin_amdgcn_s_barrier(); asm volatile("" ::: "memory");
          xr = 0.f; xi = 0.f;
          for (int v = 0; v < wid; ++v) { const float er = E[v * 128 + p], ei = E[v * 128 + 64 + p]; const float nr = l32.x * xr - l32.y * xi + er, ni = l32.x * xi + l32.y * xr + ei; xr = nr; xi = ni; }
          bf16_t* ux = UX + (size_t)(u.pm * 256 + wid * 32) * 640 + 512 + p;
#pragma unroll 4
          for (int k = 0; k < 32; ++k) { const float sr = Tw[k * TP], si = Tw[k * TP + 64]; const unsigned w = cvt_pk_bf16(xr, xi);
              ux[(size_t)k * 640] = (bf16_t)(w & 0xffffu); ux[(size_t)k * 640 + 64] = (bf16_t)(w >> 16);
              const float nr = lt.x * xr - lt.y * xi + sr, ni = lt.x * xi + lt.y * xr + si; xr = nr; xi = ni; } }
    }
};
struct EpiY {
    static constexpr bool PERM = true, AFTER_DRAIN = false;
    bf16_t* Z;
    __device__ __forceinline__ void operator()(const f32x4 (&acc)[2][2][4][2], const Unit& u, int wr, int wc, int fr, int fq) const {
        const int g = u.pm >> 1, i = u.pm & 1, j = u.pn & 1;
#pragma unroll
        for (int ai = 0; ai < 2; ++ai)
#pragma unroll
            for (int m = 0; m < 4; ++m) { const int n = 256 * i + ai * HALF + wr * 64 + m * 16 + fr;
#pragma unroll
                for (int bj = 0; bj < 2; ++bj) { const int cc = 256 * j + 128 * bj + 32 * wc + 8 * fq, t = cc >> 4, c0 = cc & 15;
                    f32x4 v0 = acc[ai][bj][m][0], v1 = acc[ai][bj][m][1];
                    { const f32x2 a = gelu_tanh2((f32x2){v0[0], v0[1]}), b = gelu_tanh2((f32x2){v0[2], v0[3]}), c = gelu_tanh2((f32x2){v1[0], v1[1]}), d = gelu_tanh2((f32x2){v1[2], v1[3]});
                      v0 = (f32x4){a.x, a.y, b.x, b.y}; v1 = (f32x4){c.x, c.y, d.x, d.y}; }
                    *(u32x4*)(Z + ((size_t)g * 16384 + (32 * n + t)) * 16 + c0) = pack8(v0, v1); } }
    }
};
struct OrderSloc {
    int G, c;
    __device__ __forceinline__ bool next(int i, Unit& u) const { const int L = i * G + c; if (L >= 128) return false;
        int g, h; if (G >= 128 && (G & 7) == 0) { const int x = L & 7, sl = L >> 3; g = x * 8 + (sl >> 1); h = sl & 1; } else { g = L >> 1; h = L & 1; }
        u.pm = 2 * g + h; u.pn = g; return true; }
    __device__ __forceinline__ void a_ready(const Unit&) const {}
    __device__ __forceinline__ void done(const Unit&) const {}
};
struct OrderY {
    int G, c;
    __device__ __forceinline__ bool next(int i, Unit& u) const { const int L = i * G + c; if (L >= 256) return false;
        int g, q; if (G == 256) { const int x = L & 7, sl = L >> 3; g = x * 8 + (sl >> 2); q = sl & 3; } else { g = L >> 2; q = L & 3; }
        u.pm = 2 * g + (q >> 1); u.pn = 2 * g + (q & 1); return true; }
    __device__ __forceinline__ void a_ready(const Unit&) const {}
    __device__ __forceinline__ void done(const Unit&) const {}
};

template <class Epi, class Sched, bool ALIGN_EPI = false, bool SP2 = false>
__device__ __forceinline__ void gemm_phase(PG8_LAS unsigned char* lds, const Gemm g, const Sched& S, const Epi& E) {
    const int tid = ltid(), wid = __builtin_amdgcn_readfirstlane(tid >> 6), lane = tid & 63, wr = wid >> 2, wc = wid & 3, fr = lane & 15, fq = lane >> 4;
    const int K = g.K, nt = K / BK;
    unsigned voffA[2], voffB[2];
#pragma unroll
    for (int i = 0; i < 2; ++i) { int R, C; stage_rc(tid * 16 + i * 8192, R, C); const int Rb = Epi::PERM ? ((R & ~31) + perm32(R & 31)) : R;
        voffA[i] = (unsigned)(R * g.lda * 2 + (C >> 4) * g.a_gs + (C & 15) * 2); voffB[i] = (unsigned)(Rb * g.ldb + C) * 2u; }
    const size_t kstep = (size_t)(BK * 2);
#define PG8_AOFF(x) ((size_t)((x) >> 2) * (size_t)g.a_ts + (size_t)((x) & 3) * (size_t)g.a_ks)
    const size_t hstepA = (size_t)HALF * g.lda * 2, hstepB = (size_t)HALF * g.ldb * 2;
    const size_t tstepA = 2 * hstepA, tstepB = 2 * hstepB;
    const unsigned ldsw = (unsigned)wid * 1024u;
    const int aoff = lds_byte(wr * 64 + fr, fq * 8), boff = lds_byte(wc * 32 + fr, fq * 8);
#define PG8_SA(b, h) (((b) * 2 + (h)) * HTB)
#define PG8_SB(b, h) ((4 + (b) * 2 + (h)) * HTB)
#define PG8_STAGE(bufoff, gbase, voff) do { _Pragma("unroll") for (int _i = 0; _i < 2; ++_i) \
        __builtin_amdgcn_global_load_lds((const unsigned*)((const char*)(gbase) + (voff)[_i]), (PG8_LAS unsigned*)(lds + (bufoff) + ldsw + _i * 8192), 16, 0, 0); } while (0)
#define PG8_LDA(dst, b, h) do { _Pragma("unroll") for (int m = 0; m < 4; ++m) _Pragma("unroll") for (int k = 0; k < 2; ++k) dst[m][k] = *(const PG8_LAS bf16x8*)(lds + PG8_SA(b, h) + aoff + m * 2048 + k * 1024); } while (0)
#define PG8_LDB(dst, b, h) do { _Pragma("unroll") for (int n = 0; n < 2; ++n) _Pragma("unroll") for (int k = 0; k < 2; ++k) dst[n][k] = *(const PG8_LAS bf16x8*)(lds + PG8_SB(b, h) + boff + n * 2048 + k * 1024); } while (0)
#define PG8_MMA(ai, bj, At, Bt) do { __builtin_amdgcn_s_setprio(1); _Pragma("unroll") for (int m = 0; m < 4; ++m) _Pragma("unroll") for (int n = 0; n < 2; ++n) _Pragma("unroll") for (int k = 0; k < 2; ++k) \
        acc[ai][bj][m][n] = __builtin_amdgcn_mfma_f32_16x16x32_bf16(Bt[n][k], At[m][k], acc[ai][bj][m][n], 0, 0, 0); __builtin_amdgcn_s_setprio(0); } while (0)
#define PG8_WAIT_V(n) asm volatile("s_waitcnt vmcnt(" #n ")" ::: "memory")
#define PG8_WAIT_L(n) asm volatile("s_waitcnt lgkmcnt(" #n ")" ::: "memory")
#define PG8_BAR __builtin_amdgcn_s_barrier()
#define PG8_SCHED __builtin_amdgcn_sched_barrier(0)
    Unit cur, nxt; int ui = 0;
    if (!S.next(0, cur)) return;
    f32x4 acc[2][2][4][2];
#pragma unroll
    for (int a = 0; a < 2; ++a)
#pragma unroll
        for (int b = 0; b < 2; ++b)
#pragma unroll
            for (int m = 0; m < 4; ++m)
#pragma unroll
                for (int n = 0; n < 2; ++n) acc[a][b][m][n] = (f32x4){0.f, 0.f, 0.f, 0.f};
    bf16x8 At[4][2], B0[2][2], B1[2][2];
    const char* cA = (const char*)g.A + (size_t)cur.pm * tstepA; const char* cB = (const char*)g.Bt + (size_t)cur.pn * tstepB;
    S.a_ready(cur);
    if constexpr (SP2) {
        PG8_STAGE(PG8_SB(0, 0), cB, voffB); PG8_STAGE(PG8_SB(0, 1), cB + hstepB, voffB); PG8_STAGE(PG8_SA(0, 0), cA, voffA); PG8_STAGE(PG8_SA(0, 1), cA + hstepA, voffA);
        if (wr == 1) PG8_BAR;
        PG8_WAIT_V(2); PG8_BAR;
        PG8_STAGE(PG8_SB(1, 0), cB + kstep, voffB); PG8_STAGE(PG8_SA(1, 0), cA + PG8_AOFF(1), voffA); PG8_STAGE(PG8_SB(1, 1), cB + hstepB + kstep, voffB);
        PG8_WAIT_V(6); PG8_BAR;
    } else {
        PG8_STAGE(PG8_SB(0, 0), cB, voffB); PG8_STAGE(PG8_SA(0, 0), cA, voffA); PG8_STAGE(PG8_SB(0, 1), cB + hstepB, voffB); PG8_STAGE(PG8_SA(0, 1), cA + hstepA, voffA);
        if (wr == 1) PG8_BAR;
        PG8_WAIT_V(4); PG8_BAR;
        PG8_STAGE(PG8_SB(1, 0), cB + kstep, voffB); PG8_STAGE(PG8_SA(1, 0), cA + PG8_AOFF(1), voffA); PG8_STAGE(PG8_SB(1, 1), cB + hstepB + kstep, voffB);
        PG8_WAIT_V(6); PG8_BAR;
    }
    for (;;) {
        const bool has_next = S.next(ui + 1, nxt);
        const char* nA = has_next ? (const char*)g.A + (size_t)nxt.pm * tstepA : cA; const char* nB = has_next ? (const char*)g.Bt + (size_t)nxt.pn * tstepB : cB;
        for (int t = 0; t < nt; t += 2) {
            const bool last = (t == nt - 2);
            const char* a1 = cA + PG8_AOFF(t + 1);
            const char* a2 = last ? nA : cA + PG8_AOFF(t + 2); const char* b2 = last ? nB : cB + (size_t)(t + 2) * kstep;
            const char* a3 = a2 + (size_t)g.a_ks; const char* b3 = b2 + kstep;
            if (last && has_next) S.a_ready(nxt);
            if constexpr (SP2) {
            PG8_LDB(B0, 0, 0); PG8_LDB(B1, 0, 1); PG8_SCHED; PG8_LDA(At, 0, 0); PG8_STAGE(PG8_SA(1, 1), a1 + hstepA, voffA);
            PG8_WAIT_V(8); PG8_WAIT_L(0); PG8_BAR; PG8_MMA(0, 0, At, B0); PG8_MMA(0, 1, At, B1); PG8_BAR; PG8_SCHED;
            PG8_LDA(At, 0, 1); PG8_STAGE(PG8_SB(0, 0), b2, voffB); PG8_STAGE(PG8_SB(0, 1), b2 + hstepB, voffB); PG8_STAGE(PG8_SA(0, 0), a2, voffA);
            PG8_WAIT_V(8); PG8_WAIT_L(0); PG8_BAR; PG8_MMA(1, 0, At, B0); PG8_MMA(1, 1, At, B1); PG8_BAR; PG8_SCHED;
            PG8_LDB(B0, 1, 0); PG8_LDB(B1, 1, 1); PG8_SCHED; PG8_LDA(At, 1, 0); PG8_STAGE(PG8_SA(0, 1), a2 + hstepA, voffA);
            PG8_WAIT_V(8); PG8_WAIT_L(0); PG8_BAR; PG8_MMA(0, 0, At, B0); PG8_MMA(0, 1, At, B1); PG8_BAR; PG8_SCHED;
            PG8_LDA(At, 1, 1); PG8_STAGE(PG8_SB(1, 0), b3, voffB); PG8_STAGE(PG8_SB(1, 1), b3 + hstepB, voffB); PG8_STAGE(PG8_SA(1, 0), a3, voffA);
            PG8_WAIT_V(8); PG8_WAIT_L(0); PG8_BAR; PG8_MMA(1, 0, At, B0); PG8_MMA(1, 1, At, B1); PG8_BAR; PG8_SCHED;
            } else {
            PG8_LDB(B0, 0, 0); PG8_SCHED; PG8_LDA(At, 0, 0); PG8_STAGE(PG8_SA(1, 1), a1 + hstepA, voffA);
            PG8_WAIT_L(8); PG8_BAR; PG8_WAIT_L(0); PG8_MMA(0, 0, At, B0); PG8_BAR; PG8_SCHED;
            PG8_LDB(B1, 0, 1); PG8_STAGE(PG8_SB(0, 0), b2, voffB);
            PG8_BAR; PG8_WAIT_L(0); PG8_MMA(0, 1, At, B1); PG8_BAR;
            PG8_LDA(At, 0, 1); PG8_STAGE(PG8_SA(0, 0), a2, voffA);
            PG8_BAR; PG8_WAIT_L(0); PG8_MMA(1, 0, At, B0); PG8_BAR; PG8_SCHED;
            PG8_STAGE(PG8_SB(0, 1), b2 + hstepB, voffB);
            PG8_WAIT_V(6); PG8_BAR; PG8_MMA(1, 1, At, B1); PG8_BAR;
            PG8_LDB(B0, 1, 0); PG8_SCHED; PG8_LDA(At, 1, 0); PG8_STAGE(PG8_SA(0, 1), a2 + hstepA, voffA);
            PG8_WAIT_L(8); PG8_BAR; PG8_WAIT_L(0); PG8_MMA(0, 0, At, B0); PG8_BAR; PG8_SCHED;
            PG8_LDB(B1, 1, 1); PG8_STAGE(PG8_SB(1, 0), b3, voffB);
            PG8_BAR; PG8_WAIT_L(0); PG8_MMA(0, 1, At, B1); PG8_BAR;
            PG8_LDA(At, 1, 1); PG8_STAGE(PG8_SA(1, 0), a3, voffA);
            PG8_BAR; PG8_WAIT_L(0); PG8_MMA(1, 0, At, B0); PG8_BAR; PG8_SCHED;
            PG8_STAGE(PG8_SB(1, 1), b3 + hstepB, voffB);
            PG8_WAIT_V(6); PG8_BAR; PG8_MMA(1, 1, At, B1); PG8_BAR;
            }
        }
        if constexpr (ALIGN_EPI) { if (wr == 0) PG8_BAR; }
        if constexpr (!Epi::AFTER_DRAIN) { E(acc, cur, wr, wc, fr, fq); S.done(cur); }
        if (!has_next) break;
#pragma unroll
        for (int a = 0; a < 2; ++a)
#pragma unroll
            for (int b = 0; b < 2; ++b)
#pragma unroll
                for (int m = 0; m < 4; ++m)
#pragma unroll
                    for (int n = 0; n < 2; ++n) acc[a][b][m][n] = (f32x4){0.f, 0.f, 0.f, 0.f};
        cur = nxt; cA = nA; cB = nB; ++ui;
        if constexpr (ALIGN_EPI) { if (wr == 1) PG8_BAR; }
    }
    PG8_WAIT_V(0);
    if constexpr (!ALIGN_EPI) { if (wr == 0) PG8_BAR; }
    PG8_BAR;
    if constexpr (Epi::AFTER_DRAIN) { E.fused(acc, cur, wr, wc, fr, fq, lds, wid, lane); S.done(cur); }
#undef PG8_AOFF
#undef PG8_SA
#undef PG8_SB
#undef PG8_STAGE
#undef PG8_LDA
#undef PG8_LDB
#undef PG8_MMA
#undef PG8_WAIT_V
#undef PG8_WAIT_L
#undef PG8_BAR
#undef PG8_SCHED
}
}
namespace attn_body {
using bf16=__hip_bfloat16;
using bf16x8=__attribute__((ext_vector_type(8)))short;
using s16x4=__attribute__((ext_vector_type(4)))short;
using f32x16=__attribute__((ext_vector_type(16)))float;
using u32x4=__attribute__((ext_vector_type(4)))unsigned;
using f32x4_t=__attribute__((ext_vector_type(4)))float;
constexpr int BATCH=2,NHEAD=16,SEQ=8192,D=64,DM=NHEAD*D;
constexpr int NW=8,QBLK=32,QB=QBLK*NW,KVBLK=64,NQB=SEQ/QB;
constexpr int ATTN_PITCH=DM, ATTN_UNIT_ROWS=QB;
__device__ __forceinline__ int crow(int r,int hi){return (r&3)+8*(r>>2)+4*hi;}
#define SBAR() __builtin_amdgcn_sched_barrier(0)
__device__ __forceinline__ void cmask(f32x16&p0,f32x16&p1,int jb,int qrel,int hi){
  const float NEG=-INFINITY; int kb=64*jb+4*hi;
  #pragma unroll
  for(int r=0;r<16;++r){int kv=kb+(r&3)+8*(r>>2); if(kv>qrel)p0[r]=NEG; if(kv+32>qrel)p1[r]=NEG;}
}

constexpr int NSLOT=3, SLOTB=8192;
constexpr int LDS_K=0, LDS_V=NSLOT*SLOTB, LDS_WS=2*NSLOT*SLOTB, LDS_OST=LDS_WS+NW*64*4, LDS_GT=LDS_OST+NW*4096, LDS_QM=LDS_GT+SEQ*4, LDS_CF=LDS_QM+64, LDS_ORD=LDS_CF+512, LDS_BYTES=LDS_ORD+256;
constexpr float C2=0.125f*1.4426950408889634f;
__device__ __forceinline__ void glds16(const void*gsrc,unsigned lds_dst){unsigned keep;
  asm volatile("s_mov_b32 %0, m0\n\ts_mov_b32 m0, %2\n\ts_nop 0\n\tglobal_load_lds_dwordx4 %1, off\n\ts_mov_b32 m0, %0":"=&s"(keep):"v"(gsrc),"s"(lds_dst):"memory");}
__device__ __forceinline__ float max3f(float a,float b,float c){float r;asm("v_max3_f32 %0, %1, %2, %3":"=v"(r):"v"(a),"v"(b),"v"(c));return r;}
__device__ __forceinline__ float max2f(float a,float b){float r;asm("v_max_f32_e32 %0, %1, %2":"=v"(r):"v"(a),"v"(b));return r;}
__device__ __forceinline__ float fadd_s(float a,float b){float r;asm("v_add_f32_e32 %0, %1, %2":"=v"(r):"v"(a),"v"(b));return r;}
__device__ __forceinline__ float fsub_s(float a,float b){float r;asm("v_sub_f32_e32 %0, %1, %2":"=v"(r):"v"(a),"v"(b));return r;}
typedef float f32x2_t __attribute__((ext_vector_type(2))); typedef __bf16 bf16x2_t __attribute__((ext_vector_type(2)));
__device__ __forceinline__ unsigned cvtpk_s(float lo,float hi){f32x2_t v={lo,hi};bf16x2_t b=__builtin_convertvector(v,bf16x2_t);return __builtin_bit_cast(unsigned,b);}
#define WAIT_BAR(N) asm volatile("s_waitcnt vmcnt(" #N ") lgkmcnt(0)\n\ts_barrier":::"memory")

__device__ __forceinline__ void qkt(f32x16&p0,f32x16&p1,const char*Kslot,const bf16x8*qr,int r32,int hi){
  const char*kb=Kslot+hi*1024+r32*16;
  #pragma unroll
  for(int d0=0;d0<4;++d0){
    const bf16x8 b0=*reinterpret_cast<const bf16x8*>(kb+d0*2048);
    const bf16x8 b1=*reinterpret_cast<const bf16x8*>(kb+d0*2048+512);
    {p0=__builtin_amdgcn_mfma_f32_32x32x16_bf16(b0,qr[d0],p0,0,0,0);p1=__builtin_amdgcn_mfma_f32_32x32x16_bf16(b1,qr[d0],p1,0,0,0);}}
}
typedef __attribute__((address_space(3))) const char* lds_cptr;
typedef short v4i16_t __attribute__((ext_vector_type(4)));
__device__ __forceinline__ void kload8(bf16x8*kf,lds_cptr kp){
  kf[0]=*(const __attribute__((address_space(3))) bf16x8*)(kp);      kf[1]=*(const __attribute__((address_space(3))) bf16x8*)(kp+512);
  kf[2]=*(const __attribute__((address_space(3))) bf16x8*)(kp+2048); kf[3]=*(const __attribute__((address_space(3))) bf16x8*)(kp+2560);
  kf[4]=*(const __attribute__((address_space(3))) bf16x8*)(kp+4096); kf[5]=*(const __attribute__((address_space(3))) bf16x8*)(kp+4608);
  kf[6]=*(const __attribute__((address_space(3))) bf16x8*)(kp+6144); kf[7]=*(const __attribute__((address_space(3))) bf16x8*)(kp+6656);
}
__device__ __forceinline__ void kload2(bf16x8*kf,lds_cptr kp,int j){ kf[2*j]=*(const __attribute__((address_space(3))) bf16x8*)(kp+j*2048); kf[2*j+1]=*(const __attribute__((address_space(3))) bf16x8*)(kp+j*2048+512); }
__device__ __forceinline__ s16x4 vtr(lds_cptr p){ return __builtin_bit_cast(s16x4,__builtin_amdgcn_ds_read_tr16_b64_v4i16((__attribute__((address_space(3))) v4i16_t*)p)); }
__device__ __forceinline__ float rowmax(const f32x16&p0,const f32x16&p1){
  float a=max3f(p0[0],p0[1],p1[0]),b=max3f(p0[2],p0[3],p1[1]);a=max3f(a,p1[2],p1[3]);
  #pragma unroll
  for(int r=4;r<16;r+=4){a=max3f(a,p0[r],p0[r+1]);b=max3f(b,p0[r+2],p0[r+3]);a=max3f(a,p1[r],p1[r+1]);b=max3f(b,p1[r+2],p1[r+3]);}
  const float m=max2f(a,b);
  auto rr=__builtin_amdgcn_permlane32_swap(__float_as_uint(m),__float_as_uint(m),false,false);
  return max2f(__uint_as_float(rr[0]),__uint_as_float(rr[1]));
}
__device__ __forceinline__ void pv(f32x16*o,int vb,bf16x8 pa0,bf16x8 pa1,bf16x8 pa2,bf16x8 pa3){
  #pragma unroll
  for(int d0=0;d0<2;++d0){s16x4 lo[4],hi[4];
    #pragma unroll
    for(int ks=0;ks<4;++ks){
      asm volatile("ds_read_b64_tr_b16 %0,%1 offset:%c2":"=&v"(lo[ks]):"v"(vb),"i"(d0*4096+ks*1024):"memory");
      asm volatile("ds_read_b64_tr_b16 %0,%1 offset:%c2":"=&v"(hi[ks]):"v"(vb),"i"(d0*4096+ks*1024+512):"memory");}
    asm volatile("s_waitcnt lgkmcnt(0)":::"memory");SBAR();
    #define PK(k) (bf16x8){lo[k][0],lo[k][1],lo[k][2],lo[k][3],hi[k][0],hi[k][1],hi[k][2],hi[k][3]}
    o[d0]=__builtin_amdgcn_mfma_f32_32x32x16_bf16(pa0,PK(0),o[d0],0,0,0);
    o[d0]=__builtin_amdgcn_mfma_f32_32x32x16_bf16(pa1,PK(1),o[d0],0,0,0);
    o[d0]=__builtin_amdgcn_mfma_f32_32x32x16_bf16(pa2,PK(2),o[d0],0,0,0);
    o[d0]=__builtin_amdgcn_mfma_f32_32x32x16_bf16(pa3,PK(3),o[d0],0,0,0);
    #undef PK
  }
}

#ifndef ATTN_STORE16
#define ATTN_STORE16(p,v) (*(u32x4*)(p)=(v))
#endif
template<int THRL> __device__ __forceinline__ void attn_unit(int b,int h,int qb,const bf16*Q,const bf16*__restrict__ K,const bf16*__restrict__ V,bf16*O,const float*__restrict__ Gg,float kmax,char*shm){
  const int tid=ltid(),lane=tid&63,r32=lane&31,hi=lane>>5; const int wid=__builtin_amdgcn_readfirstlane(tid>>6);
  const long rowbase=(long)b*SEQ; const int q0=qb*QB;
  const bf16*Qw=Q+(rowbase+q0+wid*QBLK)*DM+h*D;
  const lds_cptr shm3=(lds_cptr)shm;
  bf16x8 qr[4];
  #pragma unroll
  for(int d0=0;d0<4;++d0)qr[d0]=*reinterpret_cast<const bf16x8*>(&Qw[(long)r32*DM+d0*16+hi*8]);
  { const int nk=q0+QB; const float gb=q0?Gg[q0-1]:0.f;
    f32x4_t g4_[4]; float ge_[4];
    #pragma unroll
    for(int k_=0;k_<4;++k_){ const int i=tid*4+k_*2048; if(i<nk){ g4_[k_]=*(const f32x4_t*)(Gg+i); ge_[k_]=(i>=q0)?gb:Gg[i|63]; } }
    #pragma unroll
    for(int k_=0;k_<4;++k_){ const int i=tid*4+k_*2048; if(i<nk){ const float ge=ge_[k_]; const f32x4_t g4=g4_[k_]; *(__attribute__((address_space(3))) f32x4_t*)(shm3+LDS_GT+i*4)=(f32x4_t){g4[0]-ge,g4[1]-ge,g4[2]-ge,g4[3]-ge}; } }
    if(tid<(nk>>6)){ const float c_=(tid==0||64*tid>=q0)?1.f:__builtin_amdgcn_exp2f(Gg[64*tid-1]-Gg[64*tid+63]); *(__attribute__((address_space(3))) float*)(shm3+LDS_CF+tid*4)=c_; } }
  { float qs=0.f;
    #pragma unroll
    for(int d0=0;d0<4;++d0){
      #pragma unroll
      for(int e=0;e<8;++e){const float f=__uint_as_float(((unsigned)(unsigned short)qr[d0][e])<<16);qs+=f*f;}}
    {auto rr=__builtin_amdgcn_permlane32_swap(__float_as_uint(qs),__float_as_uint(qs),false,false);qs=__uint_as_float(rr[0])+__uint_as_float(rr[1]);}
    #pragma unroll
    for(int o_=1;o_<32;o_<<=1)qs=fmaxf(qs,__shfl_xor(qs,o_));
    if(lane==0)*(__attribute__((address_space(3))) float*)(shm3+LDS_QM+wid*4)=qs; }
  asm volatile("s_waitcnt vmcnt(0) lgkmcnt(0)\n\ts_barrier":::"memory");
  int j0;
  { float qm=0.f;
    #pragma unroll
    for(int w=0;w<8;++w)qm=fmaxf(qm,*(const __attribute__((address_space(3))) float*)(shm3+LDS_QM+w*4));
    const float lim=Gg[q0]-(2.f*sqrtf(qm)*kmax*1.01f+150.f);
    const int nt0=4*qb; int ln_=lane; asm volatile("":"+v"(ln_)); const bool c0=(ln_<nt0)&&(Gg[64*ln_+63]<lim); const bool c1=(ln_+64<nt0)&&(Gg[64*ln_+4096+63]<lim);
    j0=(__popcll(__ballot(c0))+__popcll(__ballot(c1)))&~1; j0=__builtin_amdgcn_readfirstlane(j0); }
  const bf16*Kh=K+(rowbase+(long)j0*KVBLK)*DM+h*D,*Vh=V+(rowbase+(long)j0*KVBLK)*DM+h*D;
  const lds_cptr cf0=shm3+LDS_CF+j0*4;
  const lds_cptr gp0=shm3+LDS_GT+j0*256+hi*16;
  const unsigned lds0=(unsigned)(uintptr_t)shm;
  float*wsf=(float*)(shm+LDS_WS)+wid*64;
  const bf16*ksrc=Kh+(long)lane*DM+wid*8;
  const bf16*vsrc=Vh+(long)(16*(wid&3)+(lane>>2))*DM+(wid>>2)*32+(lane&3)*8;
  const unsigned kdst=lds0+LDS_K+wid*1024, vdst=lds0+LDS_V+wid*1024;
  #define DMA_K(t,slot) glds16(ksrc+(long)(t)*KVBLK*DM,(unsigned)__builtin_amdgcn_readfirstlane(kdst+(slot)))
  #define DMA_V(t,slot) glds16(vsrc+(long)(t)*KVBLK*DM,(unsigned)__builtin_amdgcn_readfirstlane(vdst+(slot)))
  const char*Kbase=shm+LDS_K; bf16x8 kf[8];
  const lds_cptr kp0=shm3+LDS_K+hi*1024+r32*16; const lds_cptr vp0=shm3+LDS_V+((lane>>4)&1)*32+(lane&3)*8+(4*hi+((lane&15)>>2))*64;
  const int NT=(q0+QB)/KVBLK-j0;
  DMA_K(0,0);DMA_V(0,0);DMA_K(1,SLOTB);
  float mhat=0.f,l_reg=0.f;f32x16 o[2];o[0]=f32x16{};o[1]=f32x16{};
  const int qrel=wid*QBLK+r32;
  #define CMASK(P0,P1,t) do{int jb_=(t)-(NT-4); if(jb_>=0)cmask(P0,P1,jb_,qrel,hi);}while(0)
  #define BIASINIT(P0,P1,t) do{ const lds_cptr gp_=gp0+(t)*256; \
    _Pragma("unroll") for(int i_=0;i_<4;++i_){ const f32x4_t ga_=*(const __attribute__((address_space(3))) f32x4_t*)(gp_+i_*32), gb_=*(const __attribute__((address_space(3))) f32x4_t*)(gp_+128+i_*32); \
      P0[4*i_]=ga_[0]-mhat;P0[4*i_+1]=ga_[1]-mhat;P0[4*i_+2]=ga_[2]-mhat;P0[4*i_+3]=ga_[3]-mhat; P1[4*i_]=gb_[0]-mhat;P1[4*i_+1]=gb_[1]-mhat;P1[4*i_+2]=gb_[2]-mhat;P1[4*i_+3]=gb_[3]-mhat; } }while(0)
  bool resc=false;
  #define START(P0,P1) do{ const float rm=rowmax(P0,P1); resc=false; \
    { const float dl=rm; mhat=fadd_s(mhat,dl); \
      _Pragma("unroll") for(int r=0;r<16;++r){P0[r]=fsub_s(P0[r],dl);P1[r]=fsub_s(P1[r],dl);} \
      } \
    _Pragma("unroll") for(int r=0;r<16;++r)P0[r]=__builtin_amdgcn_exp2f(P0[r]); }while(0)
  #define RESC(t) do{ const float cf_=*(const __attribute__((address_space(3))) float*)(cf0+(t)*4); l_reg*=cf_; \
      if(resc){ asm volatile("s_waitcnt lgkmcnt(0)":::"memory"); \
        _Pragma("unroll") for(int d_=0;d_<2;++d_) _Pragma("unroll") for(int r=0;r<16;++r)o[d_][r]*=cf_*wsf[crow(r,hi)]; } \
      else { _Pragma("unroll") for(int d_=0;d_<2;++d_) _Pragma("unroll") for(int r=0;r<16;++r)o[d_][r]*=cf_; } }while(0)
  f32x16 pA0,pA1,pB0,pB1;
  int sl_prev=0,sl_cur=0,sl_next=SLOTB;
  #define ROT() do{sl_prev=sl_cur;sl_cur=sl_next;sl_next=(sl_next==(NSLOT-1)*SLOTB)?0:sl_next+SLOTB;}while(0)
  DMA_K(2,2*SLOTB);
  WAIT_BAR(3);
  BIASINIT(pA0,pA1,0);qkt(pA0,pA1,Kbase,qr,r32,hi);asm volatile("s_nop 15\n\ts_nop 7":"+v"(pA0),"+v"(pA1));CMASK(pA0,pA1,0);
  START(pA0,pA1);
  _Pragma("unroll") for(int r=0;r<16;++r)pA1[r]=__builtin_amdgcn_exp2f(pA1[r]);
  WAIT_BAR(0);
  DMA_K(3,0);DMA_V(1,SLOTB);
  ROT();
  kload8(kf,kp0+sl_cur);
  WAIT_BAR(2);
  s16x4 vlo[8],vhi[8]; u32x4 pw0,pw1,pw2,pw3;
  #define PKW(P,B) cvtpk_s(P[B],P[B+1])
  #define PAF(k) __builtin_bit_cast(bf16x8,pw##k)
  #define VFR(i) (bf16x8){vlo[i][0],vlo[i][1],vlo[i][2],vlo[i][3],vhi[i][0],vhi[i][1],vhi[i][2],vhi[i][3]}
  #define PIN(x) asm volatile("":"+v"(x))
  #define MX3(a,b,c) __builtin_fmaxf(__builtin_fmaxf((a),(b)),(c))
  #define GAPA(MF,A0,A1,A2,A3,W0,W1,PW) do{ MF; sacc+=A0; sacc+=A1; sacc+=A2; sacc+=A3; PIN(sacc); W0; W1; PIN(PW); SBAR(); }while(0)
  #define EX(v) __builtin_amdgcn_exp2f(v)
  #define GAPB(MF,X,B) do{ MF; X[B]=EX(X[B]); X[B+1]=EX(X[B+1]); X[B+2]=EX(X[B+2]); X[B+3]=EX(X[B+3]); PIN(X); SBAR(); }while(0)
  #define VRD(i) do{ vlo[i]=vtr(vp_+(((i)>>2)*4096+((i)&3)*1024)); vhi[i]=vtr(vp_+(((i)>>2)*4096+((i)&3)*1024+512)); }while(0)
  #define KRD(G,j) do{ if(G){ kload2(kf,kp0+sl_next,j); SBAR(); } }while(0)
  #define STEP(C0,C1,P0,P1,t,GK,GV,GL) do{ SBAR(); BIASINIT(C0,C1,t); SBAR(); \
    const lds_cptr vp_=vp0+sl_prev; \
    VRD(0); SBAR(); float sacc=(P0[0]+P0[1]); \
    GAPA(C0=__builtin_amdgcn_mfma_f32_32x32x16_bf16(kf[0],qr[0],C0,0,0,0), P0[2],P0[3],P0[4],P0[5],     pw0[0]=PKW(P0,0), pw0[1]=PKW(P0,2), pw0); \
    VRD(4); SBAR(); GAPA(C1=__builtin_amdgcn_mfma_f32_32x32x16_bf16(kf[1],qr[0],C1,0,0,0), P0[6],P0[7],P0[8],P0[9],     pw0[2]=PKW(P0,4), pw0[3]=PKW(P0,6), pw0); \
    VRD(1); SBAR(); GAPA(C0=__builtin_amdgcn_mfma_f32_32x32x16_bf16(kf[2],qr[1],C0,0,0,0),   P0[10],P0[11],P0[12],P0[13], pw1[0]=PKW(P0,8), pw1[1]=PKW(P0,10), pw1); \
    VRD(5); SBAR(); GAPA(C1=__builtin_amdgcn_mfma_f32_32x32x16_bf16(kf[3],qr[1],C1,0,0,0),   P0[14],P0[15],P1[0],P1[1],   pw1[2]=PKW(P0,12),pw1[3]=PKW(P0,14), pw1); \
    VRD(2); SBAR(); GAPA(C0=__builtin_amdgcn_mfma_f32_32x32x16_bf16(kf[4],qr[2],C0,0,0,0),   P1[2],P1[3],P1[4],P1[5],     pw2[0]=PKW(P1,0), pw2[1]=PKW(P1,2), pw2); \
    VRD(6); SBAR(); GAPA(C1=__builtin_amdgcn_mfma_f32_32x32x16_bf16(kf[5],qr[2],C1,0,0,0),   P1[6],P1[7],P1[8],P1[9],     pw2[2]=PKW(P1,4), pw2[3]=PKW(P1,6), pw2); \
    VRD(3); SBAR(); GAPA(C0=__builtin_amdgcn_mfma_f32_32x32x16_bf16(kf[6],qr[3],C0,0,0,0),   P1[10],P1[11],P1[12],P1[13], pw3[0]=PKW(P1,8), pw3[1]=PKW(P1,10), pw3); \
    VRD(7); SBAR(); GAPA(C1=__builtin_amdgcn_mfma_f32_32x32x16_bf16(kf[7],qr[3],C1,0,0,0),   P1[14],P1[15],0.f,0.f,       pw3[2]=PKW(P1,12),pw3[3]=PKW(P1,14), pw3); \
    l_reg+=sacc; \
    if(GK){DMA_K((t)+3,sl_cur);} if(GV){DMA_V((t)+1,sl_next);} \
    CMASK(C0,C1,t); \
    { float a=MX3(C0[0],C0[1],C1[0]),b=MX3(C0[2],C0[3],C1[1]); a=MX3(a,C1[2],C1[3]); \
      _Pragma("unroll") for(int r=4;r<16;r+=4){a=MX3(a,C0[r],C0[r+1]);b=MX3(b,C0[r+2],C0[r+3]);a=MX3(a,C1[r],C1[r+1]);b=MX3(b,C1[r+2],C1[r+3]);} \
      float rm=__builtin_fmaxf(a,b); { auto rr=__builtin_amdgcn_permlane32_swap(__float_as_uint(rm),__float_as_uint(rm),false,false); rm=__builtin_fmaxf(__uint_as_float(rr[0]),__uint_as_float(rr[1])); } \
      resc=false; \
      if(__builtin_expect(__any(rm>(float)THRL),0)){ const float dl=__builtin_fmaxf(rm,0.f); mhat+=dl; \
        _Pragma("unroll") for(int r=0;r<16;++r){C0[r]-=dl;C1[r]-=dl;} \
        const float f=__builtin_amdgcn_exp2f(-dl); l_reg*=f; if(hi==0)wsf[r32]=f; resc=true; } } \
    SBAR(); \
    GAPB(o[0]=__builtin_amdgcn_mfma_f32_32x32x16_bf16(PAF(0),VFR(0),o[0],0,0,0), C0,0); \
    GAPB(o[1]=__builtin_amdgcn_mfma_f32_32x32x16_bf16(PAF(0),VFR(4),o[1],0,0,0), C0,4); \
    KRD(GL,0); GAPB(o[0]=__builtin_amdgcn_mfma_f32_32x32x16_bf16(PAF(1),VFR(1),o[0],0,0,0), C0,8); \
    KRD(GL,1); GAPB(o[1]=__builtin_amdgcn_mfma_f32_32x32x16_bf16(PAF(1),VFR(5),o[1],0,0,0), C0,12); \
    KRD(GL,2); GAPB(o[0]=__builtin_amdgcn_mfma_f32_32x32x16_bf16(PAF(2),VFR(2),o[0],0,0,0), C1,0); \
    KRD(GL,3); GAPB(o[1]=__builtin_amdgcn_mfma_f32_32x32x16_bf16(PAF(2),VFR(6),o[1],0,0,0), C1,4); \
    GAPB(o[0]=__builtin_amdgcn_mfma_f32_32x32x16_bf16(PAF(3),VFR(3),o[0],0,0,0), C1,8); \
    GAPB(o[1]=__builtin_amdgcn_mfma_f32_32x32x16_bf16(PAF(3),VFR(7),o[1],0,0,0), C1,12); \
    }while(0)
  int t=1;
  #undef CMASK
  #define CMASK(P0,P1,t) do{}while(0)
  for(;t+5<NT;t+=2){
    STEP(pB0,pB1,pA0,pA1,t,true,true,true);     WAIT_BAR(2); RESC(t); ROT();
    STEP(pA0,pA1,pB0,pB1,t+1,true,true,true);   WAIT_BAR(2); RESC(t+1); ROT();
  }
  #undef CMASK
  #define CMASK(P0,P1,t) do{int jb_=(t)-(NT-4); if(jb_>=0)cmask(P0,P1,jb_,qrel,hi);}while(0)
  #define ENDW(tt) do{ if((tt)+3<NT){WAIT_BAR(2);} else if((tt)+2<NT){WAIT_BAR(1);} else {WAIT_BAR(0);} }while(0)
  for(;t+1<NT;t+=2){
    STEP(pB0,pB1,pA0,pA1,t,(t+3<NT),(t+1<NT),(t+1<NT));       ENDW(t);   RESC(t); ROT();
    STEP(pA0,pA1,pB0,pB1,t+1,(t+4<NT),(t+2<NT),(t+2<NT));     ENDW(t+1); RESC(t+1); ROT();
  }
  STEP(pB0,pB1,pA0,pA1,NT-1,false,false,false); RESC(NT-1);
  { float sacc=pB0[0]+pB0[1]; _Pragma("unroll") for(int r=2;r<16;++r)sacc+=pB0[r]; _Pragma("unroll") for(int r=0;r<16;++r)sacc+=pB1[r]; l_reg+=sacc;
    pw0=(u32x4){PKW(pB0,0),PKW(pB0,2),PKW(pB0,4),PKW(pB0,6)};pw1=(u32x4){PKW(pB0,8),PKW(pB0,10),PKW(pB0,12),PKW(pB0,14)};pw2=(u32x4){PKW(pB1,0),PKW(pB1,2),PKW(pB1,4),PKW(pB1,6)};pw3=(u32x4){PKW(pB1,8),PKW(pB1,10),PKW(pB1,12),PKW(pB1,14)};
    SBAR(); pv(o,(int)(lds0+LDS_V)+((lane>>4)&1)*32+(lane&3)*8+(4*hi+((lane&15)>>2))*64+sl_cur,PAF(0),PAF(1),PAF(2),PAF(3)); }
  #undef PKW
  #undef PAF
  #undef VFR
  #undef PIN
  #undef MX3
  #undef GAPA
  #undef GAPB
  #undef EX
  #undef VRD
  #undef KRD
  #undef STEP
  #undef ENDW
  {auto rr=__builtin_amdgcn_permlane32_swap(__float_as_uint(l_reg),__float_as_uint(l_reg),false,false);l_reg=__uint_as_float(rr[0])+__uint_as_float(rr[1]);}
  if(hi==0)wsf[32+r32]=l_reg;asm volatile("s_waitcnt lgkmcnt(0)":::"memory");
  float rli[16];
  #pragma unroll
  for(int r=0;r<16;++r)rli[r]=__builtin_amdgcn_rcpf(wsf[32+crow(r,hi)]);
  bf16*Ow=O+(rowbase+q0+wid*QBLK)*DM+h*D;
  { bf16*stg=(bf16*)(shm+LDS_OST)+wid*2048;
    #pragma unroll
    for(int r=0;r<16;++r){const int orow=crow(r,hi);
      #pragma unroll
      for(int d0=0;d0<2;++d0)stg[orow*64+d0*32+r32]=__float2bfloat16(o[d0][r]*rli[r]);}
    asm volatile("s_waitcnt lgkmcnt(0)":::"memory");
    #pragma unroll
    for(int i=0;i<4;++i){const int row=i*8+(lane>>3),ch=lane&7; const u32x4 v=*(const u32x4*)(stg+row*64+ch*8); ATTN_STORE16(Ow+(long)row*DM+ch*8,v);} }
  asm volatile("s_waitcnt lgkmcnt(0)\n\ts_barrier":::"memory");
  #undef DMA_K
  #undef DMA_V
  #undef CMASK
  #undef BIASINIT
  #undef START
  #undef RESC
  #undef ROT
}
constexpr int ATTN_LDS_BYTES=LDS_BYTES;
struct AttnTensors { const bf16* Q; const bf16* K; const bf16* V; bf16* O; const float* G; const float* kmax; };
template<int THRL=8> __device__ __forceinline__ void attn_phase(char*lds,const AttnTensors&T,unsigned*counter){
  const lds_cptr shm3=(lds_cptr)lds;
  { const int t_=threadIdx.x;
    if(t_<32)*(__attribute__((address_space(3))) float*)(shm3+LDS_ORD+t_*4)=T.G[(size_t)t_*SEQ+SEQ-1];
    asm volatile("s_waitcnt vmcnt(0) lgkmcnt(0)\n\ts_barrier":::"memory");
    if(t_<32){ const float g_=*(const __attribute__((address_space(3))) float*)(shm3+LDS_ORD+t_*4); int r_=0;
      for(int j=0;j<32;++j){ const float o_=*(const __attribute__((address_space(3))) float*)(shm3+LDS_ORD+j*4); r_+=(o_<g_||(o_==g_&&j<t_))?1:0; }
      *(__attribute__((address_space(3))) int*)(shm3+LDS_ORD+128+r_*4)=t_; }
    asm volatile("s_waitcnt lgkmcnt(0)\n\ts_barrier":::"memory"); }
  for(;;){
    if(threadIdx.x==0){ const unsigned v=atomicAdd(counter,1u); *(__attribute__((address_space(3))) unsigned*)(shm3+LDS_QM+32)=v; }
    asm volatile("s_waitcnt vmcnt(0) lgkmcnt(0)\n\ts_barrier":::"memory");
    const unsigned idx=*(const __attribute__((address_space(3))) unsigned*)(shm3+LDS_QM+32);
    if(idx>=(unsigned)(BATCH*NHEAD*NQB))break;
    const int bh=*(const __attribute__((address_space(3))) int*)(shm3+LDS_ORD+128+(idx>>5)*4), qb=NQB-1-(int)(idx&31u);
    attn_unit<THRL>(bh/NHEAD,bh%NHEAD,qb,T.Q,T.K,T.V,T.O,T.G+(size_t)bh*SEQ,T.kmax[bh],lds);
  }
}
#undef SBAR
#undef WAIT_BAR
}

#define LAS __attribute__((address_space(3)))
typedef unsigned short bf16;
typedef unsigned v4u __attribute__((ext_vector_type(4)));
typedef float f32x4 __attribute__((ext_vector_type(4)));
typedef short bf16x8 __attribute__((ext_vector_type(8)));
typedef float f2v __attribute__((ext_vector_type(2)));
__device__ __forceinline__ f2v mk2(float a, float b) { f2v r; r.x = a; r.y = b; return r; }

constexpr int M = 16384, D = 1024, FF = 4096, SEQ = 8192, NPH = 25;
constexpr int TCH = 32, NCHUNK = M / TCH  , KUX = 640  ;
constexpr size_t MiB = 1u << 20;
constexpr size_t OFF_CTL = 0, OFF_BAR = 4096, ZERO_BYTES = 32768;
constexpr int LDS_MISC = 147456 - 64;
constexpr size_t OFF_LOGF = 1 * MiB, OFF_G = 2 * MiB, OFF_KMAX = 3 * MiB, OFF_WF = 3 * MiB + 4096;
constexpr size_t OFF_LAMPOW = 4 * MiB, OFF_BBAR = 4 * MiB + 1310720, OFF_KTAB = 6 * MiB;
constexpr size_t OFF_SS = OFF_KTAB;
constexpr size_t OFF_W1 = 8 * MiB, OFF_W2 = 16 * MiB, OFF_MIX = 24 * MiB, OFF_HB = 32 * MiB;
constexpr size_t OFF_K = 64 * MiB, OFF_V = 96 * MiB;
constexpr size_t OFF_A2 = 64 * MiB, OFF_WEND = 104 * MiB;
constexpr size_t OFF_A = 128 * MiB;
constexpr size_t OFF_UX = 128 * MiB, OFF_SL = 168 * MiB, OFF_Z = 192 * MiB, OFF_QO = 128 * MiB;
constexpr size_t WS_END = 256 * MiB;
constexpr int LDS_BYTES = 147456;

struct Params { const float* in[20]; float* out; unsigned char* ws; int ph_lo, ph_hi; };
enum { I_X = 0, I_MIXN, I_MLPN, I_W1, I_W2, I_LOGDT, I_ARE, I_AIM, I_BRE, I_BIM, I_CRE, I_CIM, I_DSK, I_WGLU, I_KVN, I_WKVF, I_BF, I_WQ, I_WO, I_FINN };

struct Frame { LAS unsigned char* lds; int tid, lane, wave, G; };
typedef const float* cfp_t;
__device__ __forceinline__ cfp_t kin(int i) { asm volatile("" : "+s"(i)); const __attribute__((address_space(4))) cfp_t* k = (const __attribute__((address_space(4))) cfp_t*)__builtin_amdgcn_kernarg_segment_ptr(); return k[i]; }
static_assert(offsetof(Params, in) == 0, "kin() reads Params::in at kernarg offset 0");

__device__ __forceinline__ float wave_sum(float v) {
#pragma unroll
    for (int o = 1; o < 64; o <<= 1) v += __shfl_xor(v, o);
    return v;
}
__device__ __forceinline__ unsigned pk2(float lo, float hi) { return pg8::cvt_pk_bf16(lo, hi); }
__device__ __forceinline__ float bf2f(unsigned short b) { return __uint_as_float(((unsigned)b) << 16); }

template <int MODE> __device__ __forceinline__ void conv_w(const Frame& F, const float* W, int K, int srcN, int n0, int ncols, bf16* WT, const float* gk, int b0 = 0) {
    constexpr int SP = 33;
    LAS float* scr = (LAS float*)(F.lds + F.wave * (64 * SP * 4));
    if (b0 > 0 && (int)blockIdx.x < b0) return;
    const int gw = ((int)blockIdx.x - b0) * 8 + F.wave, NGW = (F.G - b0) * 8, lane = F.lane;
    const int nblk = ncols / 32, nitems = (K / 64) * nblk;
    for (int it = gw; it < nitems; it += NGW) {
        const int kb = it / nblk, nb = it % nblk, k0 = 64 * kb, nn0 = 32 * nb;
        const float* src = W + (size_t)(k0 + (lane >> 3)) * srcN + n0 + nn0 + (lane & 7) * 4;
        f32x4 w[8];
#pragma unroll
        for (int i = 0; i < 8; ++i) w[i] = *(const f32x4*)(src + (size_t)(8 * i) * srcN);
#pragma unroll
        for (int i = 0; i < 8; ++i) { const int kk = 8 * i + (lane >> 3); const float g = gk ? gk[k0 + kk] : 1.f; LAS float* d = scr + kk * SP + (lane & 7) * 4;
            d[0] = w[i][0] * g; d[1] = w[i][1] * g; d[2] = w[i][2] * g; d[3] = w[i][3] * g; }
        asm volatile("s_waitcnt lgkmcnt(0)" ::: "memory");
        const int c = lane & 7;
#pragma unroll
        for (int j = 0; j < 4; ++j) { const int n = (lane >> 3) + 8 * j; const LAS float* s = scr + (8 * c) * SP + n;
            v4u o; o.x = pk2(s[0 * SP], s[1 * SP]); o.y = pk2(s[2 * SP], s[3 * SP]); o.z = pk2(s[4 * SP], s[5 * SP]); o.w = pk2(s[6 * SP], s[7 * SP]);
            const int nn = nn0 + n; const int row = (MODE == 1) ? (((nn & 1023) >> 7) * 256 + ((nn >> 10) & 1) * 128 + (nn & 127)) : nn;
            *(v4u*)(WT + (size_t)row * K + k0 + 8 * c) = o; }
        asm volatile("s_waitcnt lgkmcnt(0)" ::: "memory");
    }
}
__device__ __forceinline__ void conv_wf(const Frame& F, const float* wkvf, const float* kvn, bf16* WF) {
    for (int e = blockIdx.x * 512 + F.tid; e < 16 * 1024; e += F.G * 512) { const int j = e >> 10, k = e & 1023; const float w = wkvf[(size_t)k * 2064 + 2048 + j] * kvn[k];
        unsigned u = __float_as_uint(w); u = (u + 0x7fffu + ((u >> 16) & 1u)) >> 16; WF[e] = (bf16)u; }
}

__device__ __forceinline__ double dconst(double c) { asm volatile("" : "+s"(c)); return c; }
__device__ __forceinline__ double exp_d(double x) {
    const double n = rint(x * dconst(1.4426950408889634074)); const double r = (x - n * dconst(6.93147180369123816490e-01)) - n * dconst(1.90821492927058770002e-10);
    double s = 1.0, t = 1.0;
#pragma unroll 1
    for (int k = 1; k <= 16; ++k) { t *= r / (double)k; s += t; }
    const long long bits = ((long long)((int)n + 1023)) << 52; return s * __longlong_as_double(bits);
}
__device__ __forceinline__ void sincos_d(double x, double& s, double& c) {
    const double q = rint(x * dconst(0.63661977236758134308)); const int qi = (int)q;
    double r = x - q * dconst(1.57079632679489655800e+00); r -= q * dconst(6.12323399573676603587e-17);
    const double r2 = r * r;
    double sr = r, cr = 1.0, ts = r, tc = 1.0;
#pragma unroll 1
    for (int n = 1; n <= 10; ++n) { ts *= -r2 / (double)((2 * n) * (2 * n + 1)); sr += ts; tc *= -r2 / (double)((2 * n - 1) * (2 * n)); cr += tc; }
    switch (qi & 3) { case 0: s = sr; c = cr; break; case 1: s = cr; c = -sr; break; case 2: s = -sr; c = -cr; break; default: s = -cr; c = sr; break; }
}
__device__ __forceinline__ void s5_tables(const Frame& F, const Params& P, int L) {
    f2v* lampow = (f2v*)(P.ws + OFF_LAMPOW); f2v* Bbar = (f2v*)(P.ws + OFF_BBAR); float* Ktab = (float*)(P.ws + OFF_KTAB);
    LAS f2v* lp = (LAS f2v*)(F.lds);
    LAS f2v* bb = lp + 64 * 33;
    LAS f2v* cc = bb + 64 * 16;
    LAS f2v* cf = cc + 16 * 64;
    for (int item = blockIdx.x; item < 256; item += F.G) { const int g = item >> 2, qt = item & 3;
        if (F.tid < 64) { const int p = F.tid; const double dt = exp_d((double)kin(I_LOGDT)[L * 64 + g]);
            const double ar = (double)kin(I_ARE)[(L * 64 + g) * 64 + p], ai = (double)kin(I_AIM)[(L * 64 + g) * 64 + p];
            const double mag = exp_d(ar * dt); double sn, cs; sincos_d(ai * dt, sn, cs); const double lr = mag * cs, li = mag * sn;
            double pr = 1.0, pi = 0.0;
            for (int tau = 0; tau <= 32; ++tau) { const f2v v = mk2((float)pr, (float)pi); lp[p * 33 + tau] = v; if (qt == 0) lampow[(size_t)(g * 64 + p) * 33 + tau] = v; const double nr = pr * lr - pi * li, ni = pr * li + pi * lr; pr = nr; pi = ni; }
            const double nr = lr - 1.0, ni = li, den = ar * ar + ai * ai; cf[p] = mk2((float)((nr * ar + ni * ai) / den), (float)((ni * ar - nr * ai) / den)); }
        __syncthreads();
        { const float* bre_ = kin(I_BRE) + (size_t)((L * 64 + g) * 64) * 16; const float* bim_ = kin(I_BIM) + (size_t)((L * 64 + g) * 64) * 16; const float* cre_ = kin(I_CRE) + (size_t)(L * 64 + g) * 1024; const float* cim_ = kin(I_CIM) + (size_t)(L * 64 + g) * 1024;
          for (int e = F.tid; e < 1024; e += 512) { const int p = e >> 4; const float br = bre_[e], bi = bim_[e]; const f2v c = cf[p];
            const f2v v = mk2(c.x * br - c.y * bi, c.x * bi + c.y * br); bb[e] = v; if (qt == 0) Bbar[(size_t)g * 1024 + e] = v;
            cc[e] = mk2(cre_[e], cim_[e]); } }
        __syncthreads();
        { const float* dsk_ = kin(I_DSK) + L * 1024 + 16 * g;
          for (int e = qt * 2048 + F.tid; e < (qt + 1) * 2048; e += 512) { const int tau = e >> 8, cp = (e >> 4) & 15, c = e & 15; float acc = 0.f;
            for (int p = 0; p < 64; ++p) { const f2v C = cc[cp * 64 + p], l = lp[p * 33 + tau], B = bb[p * 16 + c]; const float tr = C.x * l.x - C.y * l.y, ti = C.x * l.y + C.y * l.x; acc += tr * B.x - ti * B.y; }
            if (tau == 0 && cp == c) acc += dsk_[c];
            Ktab[(size_t)g * 8192 + e] = acc; } }
        __syncthreads();
    }
}
__device__ __forceinline__ void s5_expand(const Frame& F, const Params& P, int L) {
    const f2v* lampow = (const f2v*)(P.ws + OFF_LAMPOW); const f2v* Bbar = (const f2v*)(P.ws + OFF_BBAR); const float* Ktab = (const float*)(P.ws + OFF_KTAB);
    bf16* A2 = (bf16*)(P.ws + OFF_A2); bf16* Wend = (bf16*)(P.ws + OFF_WEND);
    const int gt = blockIdx.x * 512 + F.tid, GT = F.G * 512;
    const float* cre_ = kin(I_CRE) + (size_t)L * 65536; const float* cim_ = kin(I_CIM) + (size_t)L * 65536;
#pragma unroll 4
    for (int ch = gt; ch < 32768 * 64; ch += GT) { const int row = ch >> 6, c8 = (ch & 63) * 8, g = row >> 9, tc = row & 511, t = tc >> 4, cp = tc & 15, s = c8 >> 4, c0 = c8 & 15;
        const int lag = (t - s) < 0 ? 0 : (t - s); const float* kp = Ktab + ((size_t)(g * 32 + lag) * 256 + cp * 16 + c0); f32x4 a = *(const f32x4*)kp, b = *(const f32x4*)(kp + 4);
        if (s > t) { a = (f32x4){0.f, 0.f, 0.f, 0.f}; b = a; }
        v4u o; o.x = pk2(a[0], a[1]); o.y = pk2(a[2], a[3]); o.z = pk2(b[0], b[1]); o.w = pk2(b[2], b[3]);
        *(v4u*)(A2 + (size_t)row * KUX + c8) = o; }
#pragma unroll 2
    for (int ch = gt; ch < 32768 * 16; ch += GT) { const int row = ch >> 4, j = (ch & 15) * 8, g = row >> 9, tc = row & 511, t = tc >> 4, cp = tc & 15, im = j >> 6, p0 = j & 63; float v[8];
        const size_t ci = (size_t)(g * 16 + cp) * 64 + p0; const f32x4 cr0 = *(const f32x4*)(cre_ + ci), cr1 = *(const f32x4*)(cre_ + ci + 4), ci0 = *(const f32x4*)(cim_ + ci), ci1 = *(const f32x4*)(cim_ + ci + 4);
#pragma unroll
        for (int e = 0; e < 8; ++e) { const float cr = e < 4 ? cr0[e & 3] : cr1[e & 3], cim = e < 4 ? ci0[e & 3] : ci1[e & 3]; const f2v l = lampow[(size_t)(g * 64 + p0 + e) * 33 + t + 1];
            v[e] = im ? -(cr * l.y + cim * l.x) : (cr * l.x - cim * l.y); }
        v4u o; o.x = pk2(v[0], v[1]); o.y = pk2(v[2], v[3]); o.z = pk2(v[4], v[5]); o.w = pk2(v[6], v[7]);
        *(v4u*)(A2 + (size_t)row * KUX + 512 + j) = o; }
#pragma unroll 2
    for (int ch = gt; ch < 16384 * 64; ch += GT) { const int row = ch >> 6, c8 = (ch & 63) * 8, g = row >> 8, rho = row & 255, s = c8 >> 4, c0 = c8 & 15, p = rho & 63, im = (rho >> 6) & 1; float v[8];
        const f2v l = lampow[(size_t)(g * 64 + p) * 33 + 31 - s]; const f2v* Bp = Bbar + (size_t)(g * 64 + p) * 16 + c0;
#pragma unroll
        for (int e = 0; e < 8; ++e) { const f2v B = Bp[e]; const float x = im ? (l.x * B.y + l.y * B.x) : (l.x * B.x - l.y * B.y); v[e] = (rho < 128) ? x : 0.f; }
        v4u o; o.x = pk2(v[0], v[1]); o.y = pk2(v[2], v[3]); o.z = pk2(v[4], v[5]); o.w = pk2(v[6], v[7]);
        *(v4u*)(Wend + (size_t)row * 512 + c8) = o; }
}
template <bool BF> __device__ __forceinline__ void phase_normu(const Frame& F, const void* hin, const float* gw, bf16* UX) {
    constexpr int PITCH = 1032;
    LAS bf16* tile = (LAS bf16*)F.lds;
    for (int n = blockIdx.x; n < NCHUNK; n += F.G) {
        f32x4 v[4][4]; float ss[4];
#pragma unroll
        for (int q = 0; q < 4; ++q) { const size_t ro = (size_t)(TCH * n + F.wave * 4 + q) * D;
            if (BF) { const v4u* xr = (const v4u*)((const bf16*)hin + ro) + 2 * F.lane; const v4u a = xr[0], b = xr[1];
                v[q][0] = (f32x4){pg8::bflo(a.x), pg8::bfhi(a.x), pg8::bflo(a.y), pg8::bfhi(a.y)}; v[q][1] = (f32x4){pg8::bflo(a.z), pg8::bfhi(a.z), pg8::bflo(a.w), pg8::bfhi(a.w)};
                v[q][2] = (f32x4){pg8::bflo(b.x), pg8::bfhi(b.x), pg8::bflo(b.y), pg8::bfhi(b.y)}; v[q][3] = (f32x4){pg8::bflo(b.z), pg8::bfhi(b.z), pg8::bflo(b.w), pg8::bfhi(b.w)}; }
            else { const f32x4* xr = (const f32x4*)((const float*)hin + ro) + F.lane;
#pragma unroll
                for (int j = 0; j < 4; ++j) v[q][j] = xr[64 * j]; } }
#pragma unroll
        for (int q = 0; q < 4; ++q) { float s = 0.f;
#pragma unroll
            for (int j = 0; j < 4; ++j) s += (v[q][j][0] * v[q][j][0] + v[q][j][1] * v[q][j][1]) + (v[q][j][2] * v[q][j][2] + v[q][j][3] * v[q][j][3]);
            ss[q] = pg8::rstd_of(wave_sum(s)); }
#pragma unroll
        for (int j = 0; j < 4; ++j) { const int e0 = BF ? (16 * F.lane + 4 * j) : (4 * (F.lane + 64 * j)); const f32x4 g4 = *(const f32x4*)(gw + e0);
#pragma unroll
            for (int q = 0; q < 4; ++q) { const f32x4 u = v[q][j] * ss[q] * g4; LAS unsigned* dst = (LAS unsigned*)(tile + (F.wave * 4 + q) * PITCH + e0); dst[0] = pk2(u[0], u[1]); dst[1] = pk2(u[2], u[3]); } }
        __syncthreads();
#pragma unroll 1
        for (int pass = 0; pass < 8; ++pass) { const int g = pass * 8 + (F.tid >> 6), s = (F.tid & 63) >> 1, half = F.tid & 1;
            const v4u val = *(const LAS v4u*)(tile + s * PITCH + 16 * g + 8 * half);
            *(v4u*)(UX + (size_t)(g * NCHUNK + n) * KUX + s * 16 + 8 * half) = val; }
        __syncthreads();
    }
}
__device__ __forceinline__ void phase_scan(const Frame& F, const Params& P) {
    const f2v* lampow = (const f2v*)(P.ws + OFF_LAMPOW); const float* Sl = (const float*)(P.ws + OFF_SL); bf16* UX = (bf16*)(P.ws + OFF_UX);
    for (int bg = F.wave * F.G + blockIdx.x; bg < 128; bg += 8 * F.G) { const int b = bg >> 6, g = bg & 63, p = F.lane;
        const f2v lt = lampow[(size_t)(g * 64 + p) * 33 + 32]; float xr = 0.f, xi = 0.f;
        const float* sl = Sl + (size_t)(g * NCHUNK + b * 256) * 128 + p; bf16* ux = UX + (size_t)(g * NCHUNK + b * 256) * KUX + 512 + p;
#pragma unroll 1
        for (int k0 = 0; k0 < 256; k0 += 8) { float sr[8], si[8];
#pragma unroll
            for (int j = 0; j < 8; ++j) { sr[j] = sl[(size_t)(k0 + j) * 128]; si[j] = sl[(size_t)(k0 + j) * 128 + 64]; }
#pragma unroll
            for (int j = 0; j < 8; ++j) { const unsigned w = pk2(xr, xi); ux[(size_t)(k0 + j) * KUX] = (bf16)(w & 0xffffu); ux[(size_t)(k0 + j) * KUX + 64] = (bf16)(w >> 16);
                const float nr = lt.x * xr - lt.y * xi + sr[j], ni = lt.x * xi + lt.y * xr + si[j]; xr = nr; xi = ni; } }
    }
}
__device__ __forceinline__ void phase_flogit(const Frame& F, const Params& P, const float* ss) {
    const bf16* hb = (const bf16*)(P.ws + OFF_HB); const bf16* WF = (const bf16*)(P.ws + OFF_WF); float* logf = (float*)(P.ws + OFF_LOGF);
    const int r = F.lane & 15, kq = F.lane >> 4; const float* bf_ = kin(I_BF);
    for (int task = blockIdx.x * 8 + F.wave; task < M / 16; task += F.G * 8) { const int row = task * 16 + r; f32x4 acc = {0.f, 0.f, 0.f, 0.f};
        const bf16* ap = hb + (size_t)row * D + kq * 8; const bf16* bp = WF + (size_t)r * D + kq * 8;
#pragma unroll 8
        for (int ks = 0; ks < 32; ++ks) { const bf16x8 a = *(const bf16x8*)(ap + ks * 32), b = *(const bf16x8*)(bp + ks * 32); acc = __builtin_amdgcn_mfma_f32_16x16x32_bf16(b, a, acc, 0, 0, 0); }
        const float rs = pg8::rstd_slots(ss, row, 16, kq); f32x4 o;
#pragma unroll
        for (int i = 0; i < 4; ++i) { const float x = acc[i] * rs + bf_[4 * kq + i]; o[i] = fminf(x, 0.f) - 0.6931471805599453f * __builtin_amdgcn_logf(1.0f + __builtin_amdgcn_exp2f(-1.4426950408889634f * fabsf(x))); }
        *(f32x4*)(logf + (size_t)row * 16 + 4 * kq) = o; }
}
__device__ __forceinline__ void phase_fscan(const Frame& F, const Params& P) {
    const float* logf = (const float*)(P.ws + OFF_LOGF); float* Gt = (float*)(P.ws + OFF_G); float* kmax = (float*)(P.ws + OFF_KMAX); const bf16* Kb = (const bf16*)(P.ws + OFF_K);
    LAS float* wsum = (LAS float*)F.lds; LAS float* wmax = wsum + 8;
    for (int bh = blockIdx.x; bh < 32; bh += F.G) { const int b = bh >> 4, h = bh & 15, t0 = F.tid * 16; float v[16]; float s = 0.f;
#pragma unroll
        for (int i = 0; i < 16; ++i) { v[i] = -1.4426950408889634f * logf[(size_t)(b * SEQ + t0 + i) * 16 + h]; s += v[i]; }
        float incl = s;
#pragma unroll
        for (int o = 1; o < 64; o <<= 1) { const float t = __shfl_up(incl, o); if (F.lane >= o) incl += t; }
        float km = 0.f;
#pragma unroll 4
        for (int i = 0; i < 16; ++i) { const bf16* kp = Kb + (size_t)(b * SEQ + t0 + i) * D + 64 * h; float q = 0.f;
#pragma unroll
            for (int c = 0; c < 8; ++c) { const bf16x8 kv = *(const bf16x8*)(kp + 8 * c);
#pragma unroll
                for (int e = 0; e < 8; ++e) { const float f = bf2f((unsigned short)kv[e]); q += f * f; } }
            km = fmaxf(km, q); }
#pragma unroll
        for (int o = 1; o < 64; o <<= 1) km = fmaxf(km, __shfl_xor(km, o));
        if (F.lane == 63) wsum[F.wave] = incl;
        if (F.lane == 0) wmax[F.wave] = km;
        __syncthreads();
        float base = 0.f, kmx = 0.f;
#pragma unroll
        for (int w = 0; w < 8; ++w) { if (w < F.wave) base += wsum[w]; kmx = fmaxf(kmx, wmax[w]); }
        float run = base + incl - s;
#pragma unroll
        for (int i = 0; i < 16; ++i) { run += v[i]; v[i] = run; }
#pragma unroll
        for (int i = 0; i < 4; ++i) *(f32x4*)(Gt + (size_t)bh * SEQ + t0 + 4 * i) = (f32x4){v[4 * i], v[4 * i + 1], v[4 * i + 2], v[4 * i + 3]};
        if (F.tid == 0) kmax[bh] = sqrtf(kmx);
        __syncthreads();
    }
}
__device__ __forceinline__ void phase_final(const Frame& F, const bf16* hb, float* out, const float* gw) {
    f32x4 g4[4];
#pragma unroll
    for (int j = 0; j < 4; ++j) g4[j] = *(const f32x4*)(gw + 16 * F.lane + 4 * j);
    const int stride = F.G * 8;
    for (int m0 = blockIdx.x * 8 + F.wave; m0 < M; m0 += 2 * stride) { v4u a[2], b[2];
#pragma unroll
        for (int r = 0; r < 2; ++r) { const int m = (m0 + r * stride < M) ? m0 + r * stride : m0; const v4u* xr = (const v4u*)(hb + (size_t)m * D) + 2 * F.lane; a[r] = xr[0]; b[r] = xr[1]; }
#pragma unroll
        for (int r = 0; r < 2; ++r) { const int m = m0 + r * stride; if (m >= M) break; f32x4 v[4];
            v[0] = (f32x4){pg8::bflo(a[r].x), pg8::bfhi(a[r].x), pg8::bflo(a[r].y), pg8::bfhi(a[r].y)}; v[1] = (f32x4){pg8::bflo(a[r].z), pg8::bfhi(a[r].z), pg8::bflo(a[r].w), pg8::bfhi(a[r].w)};
            v[2] = (f32x4){pg8::bflo(b[r].x), pg8::bfhi(b[r].x), pg8::bflo(b[r].y), pg8::bfhi(b[r].y)}; v[3] = (f32x4){pg8::bflo(b[r].z), pg8::bfhi(b[r].z), pg8::bflo(b[r].w), pg8::bfhi(b[r].w)};
            float ss = 0.f;
#pragma unroll
            for (int j = 0; j < 4; ++j) ss += (v[j][0] * v[j][0] + v[j][1] * v[j][1]) + (v[j][2] * v[j][2] + v[j][3] * v[j][3]);
            const float rstd = pg8::rstd_of(wave_sum(ss)); f32x4* o = (f32x4*)(out + (size_t)m * D + 16 * F.lane);
#pragma unroll
            for (int j = 0; j < 4; ++j) o[j] = v[j] * rstd * g4[j]; } }
}

__device__ __forceinline__ void conv_w1(const Frame& F, const Params& P, int L, int b0 = 0) { conv_w<0>(F, kin(I_W1) + (size_t)L * D * FF, D, FF, 0, FF, (bf16*)(P.ws + OFF_W1), kin(I_MLPN) + L * D, b0); }
__device__ __forceinline__ void conv_w2(const Frame& F, const Params& P, int L, int b0 = 0) { conv_w<0>(F, kin(I_W2) + (size_t)L * FF * D, FF, D, 0, D, (bf16*)(P.ws + OFF_W2), nullptr, b0); }
__device__ __forceinline__ void conv_glu(const Frame& F, const Params& P, int L) { conv_w<1>(F, kin(I_WGLU) + (size_t)L * D * 2 * D, D, 2 * D, 0, 2 * D, (bf16*)(P.ws + OFF_MIX), nullptr); }
__device__ __forceinline__ void conv_attn(const Frame& F, const Params& P, int j, bool with_kv) {
    bf16* mix = (bf16*)(P.ws + OFF_MIX);
    conv_w<0>(F, kin(I_WQ) + (size_t)j * D * D, D, D, 0, D, mix, kin(I_MIXN) + (2 + j) * D);
    conv_w<0>(F, kin(I_WO) + (size_t)j * D * D, D, D, 0, D, mix + (size_t)3 * D * D, nullptr);
    if (with_kv) { conv_w<0>(F, kin(I_WKVF), D, 2064, 0, 2 * D, mix + (size_t)D * D, kin(I_KVN)); conv_wf(F, kin(I_WKVF), kin(I_KVN), (bf16*)(P.ws + OFF_WF)); }
}
__device__ __forceinline__ bool side_jobs(const Frame& F, const Params& P, int ph) {
    switch (ph) {
    case 0:  s5_tables(F, P, 0); conv_glu(F, P, 0); return true;
    case 2:  { const int b0 = (F.G > 128) ? 128 : 0; conv_w1(F, P, 0, b0); conv_w2(F, P, 0, b0); } return true;
    case 5:  conv_glu(F, P, 1); return true;
    case 6:  s5_tables(F, P, 1); return true;
    case 8:  { const int b0 = (F.G > 128) ? 128 : 0; conv_w1(F, P, 1, b0); conv_w2(F, P, 1, b0); } return true;
    case 11: conv_attn(F, P, 0, true); return true;
    case 14: { const int b0 = (F.G > 32) ? 32 : 0; conv_w1(F, P, 2, b0); conv_w2(F, P, 2, b0); } return true;
    case 17: conv_attn(F, P, 1, false); return true;
    case 18: conv_w1(F, P, 3); return true;
    case 19: conv_w2(F, P, 3); return true;
    default: return false;
    }
}

#define XB_TMO      128
#define XB_XCNT(j)  (256  + 64 * (j))
#define XB_XSUB(j)  (1280 + 64 * (j))
#define XB_XGEN(j)  (2304 + 64 * (j))
#define XB_TOP      3328
#define XB_TOPGEN   3392
#define XCD_BAR_WORDS 3456
#define XB_SPIN_CAP (1u << 18)

__device__ __forceinline__ unsigned xb_ld(unsigned* p)              { return __hip_atomic_load(p, __ATOMIC_RELAXED, __HIP_MEMORY_SCOPE_AGENT); }
__device__ __forceinline__ unsigned xb_add(unsigned* p, unsigned v) { return __hip_atomic_fetch_add(p, v, __ATOMIC_RELAXED, __HIP_MEMORY_SCOPE_AGENT); }
__device__ __forceinline__ unsigned xb_xcc_id() { return (unsigned)__builtin_amdgcn_s_getreg((3 << 11) | 20) & 0xFu; }
#define XB_SPIN(cond, bar) do { unsigned _sp = 0; while (cond) { __builtin_amdgcn_s_sleep(1); \
    if ((++_sp & 255u) == 0u) { if (xb_ld(&(bar)[XB_TMO])) break; if (_sp > XB_SPIN_CAP) { atomicAdd(&(bar)[XB_TMO], 1u); break; } } } } while (0)

struct XcdBarrier {
    unsigned* bar; unsigned x;
    volatile LAS unsigned* st;
};

__device__ __forceinline__ XcdBarrier xcd_barrier_post(unsigned* bar, volatile LAS unsigned* st) {
    XcdBarrier b; b.bar = bar; b.x = xb_xcc_id(); b.st = st;
    if (threadIdx.x == 0) (void)xb_add(&bar[XB_XCNT(b.x)], 1u);
    return b;
}
__device__ __forceinline__ void xcd_barrier_complete(unsigned* bar, unsigned x, unsigned& nloc, unsigned& nx) {
    const unsigned G = gridDim.x * gridDim.y * gridDim.z;
    unsigned sum, cnt, mine, sp = 0u;
    for (;;) {
        sum = 0u; cnt = 0u; mine = 0u;
#pragma unroll
        for (unsigned j = 0; j < 16; ++j) { const unsigned c = xb_ld(&bar[XB_XCNT(j)]); sum += c; cnt += (c > 0u) ? 1u : 0u; mine = (j == x) ? c : mine; }
        if (sum == G) break;
        __builtin_amdgcn_s_sleep(1);
        if ((++sp & 255u) == 0u) { if (xb_ld(&bar[XB_TMO])) break; if (sp > XB_SPIN_CAP) { atomicAdd(&bar[XB_TMO], 1u); break; } }
    }
    nloc = mine > 0u ? mine : 1u; nx = cnt > 0u ? cnt : 1u;
}

__device__ __forceinline__ void xcd_barrier(const XcdBarrier& b) {
    asm volatile("s_waitcnt vmcnt(0)" ::: "memory");
    __syncthreads();
    if (ltid() == 0) {
        unsigned* bar = b.bar;
        __builtin_amdgcn_s_waitcnt(0);
        unsigned nloc = b.st[0], nx = b.st[1];
        if (nloc == 0u) { xcd_barrier_complete(bar, b.x, nloc, nx); b.st[0] = nloc; b.st[1] = nx; }
        const unsigned old = xb_add(&bar[XB_XSUB(b.x)], 1u);
        const unsigned gen = old / nloc;
        if (old + 1u == (gen + 1u) * nloc) {
            __builtin_amdgcn_fence(__ATOMIC_RELEASE, "agent");
            asm volatile("s_waitcnt vmcnt(0)" ::: "memory");
            const unsigned og = xb_add(&bar[XB_TOP], 1u);
            const unsigned tg = og / nx;
            if (og + 1u == (tg + 1u) * nx) xb_add(&bar[XB_TOPGEN], 1u);
            else XB_SPIN(xb_ld(&bar[XB_TOPGEN]) == tg, bar);
            __builtin_amdgcn_fence(__ATOMIC_ACQUIRE, "agent");
            xb_add(&bar[XB_XGEN(b.x)], 1u);
            asm volatile("s_waitcnt vmcnt(0)" ::: "memory");
        } else {
            XB_SPIN(xb_ld(&bar[XB_XGEN(b.x)]) == gen, bar);
            __builtin_amdgcn_fence(__ATOMIC_ACQUIRE, "agent");
            asm volatile("s_waitcnt vmcnt(0)" ::: "memory");
        }
    }
    __syncthreads();
}

constexpr int LDS_RSTD = 131072 + 1024;
template <class Sched> __device__ __forceinline__ void precompute_rstd(const Frame& F, const Sched& S, const float* ss, int ns) {
    LAS float* rb = (LAS float*)(F.lds + LDS_RSTD); pg8::Unit u;
    for (int i = 0; i < 8 && S.next(i, u); ++i) { const int row = F.tid >> 1, half = F.tid & 1; const f32x4* p = (const f32x4*)(ss + (size_t)(u.pm * 256 + row) * ns + half * (ns >> 1));
        f32x4 v = p[0]; float s = (v[0] + v[1]) + (v[2] + v[3]); v = p[1]; s += (v[0] + v[1]) + (v[2] + v[3]);
        if (ns == 32) { v = p[2]; s += (v[0] + v[1]) + (v[2] + v[3]); v = p[3]; s += (v[0] + v[1]) + (v[2] + v[3]); }
        s += __shfl_xor(s, 1); if (!half) rb[i * 256 + row] = pg8::rstd_of(s); }
    __syncthreads();
}

__global__ void __launch_bounds__(512, 2) trunk_fwd(Params P) {
    extern __shared__ __attribute__((aligned(16))) unsigned char lds[];
    Frame F; F.lds = (LAS unsigned char*)lds; F.G = gridDim.x;
    volatile LAS unsigned* bst = (volatile LAS unsigned*)((LAS unsigned char*)lds + LDS_MISC);
    if (threadIdx.x < 2) bst[threadIdx.x] = 0u;
    __syncthreads();
    const bool one_launch = (P.ph_hi - P.ph_lo) > 1;
    XcdBarrier bar; bar.bar = (unsigned*)(P.ws + OFF_BAR); bar.x = 0; bar.st = bst;
    if (one_launch) bar = xcd_barrier_post((unsigned*)(P.ws + OFF_BAR), bst);
    unsigned char* ws = P.ws;
    float* ssp = (float*)(ws + OFF_SS);
    bf16* HB = (bf16*)(ws + OFF_HB);
    bool dup_done = false;
    for (int ph = P.ph_lo; ph < P.ph_hi; ++ph) {
        F.tid = ltid(); F.lane = F.tid & 63; F.wave = __builtin_amdgcn_readfirstlane(F.tid >> 6); { int g_ = (int)gridDim.x; asm volatile("" : "+s"(g_)); F.G = g_; }
        int kind, L;
        if (ph == 0) { kind = 0; L = 0; }
        else if (ph <= 12) { L = (ph - 1) / 6; const int k = (ph - 1) % 6; kind = (k < 2) ? 1 + k : 2 + k; }
        else if (ph <= 18) { L = 2; const int k = ph - 13; kind = (k < 4) ? 8 + k : 2 + k; }
        else if (ph <= 23) { L = 3; const int k = ph - 19; kind = (k == 0) ? 8 : (k <= 2 ? 9 + k : 3 + k); }
        else { kind = 12; L = 3; }
        if (DBG_SIDE_REPS > 1 && !dup_done) { side_jobs(F, P, ph); asm volatile("s_waitcnt vmcnt(0) lgkmcnt(0)" ::: "memory"); __syncthreads(); }
        if (((DBG_KM >> 0) & 1) && !dup_done && side_jobs(F, P, ph)) { asm volatile("s_waitcnt vmcnt(0) lgkmcnt(0)" ::: "memory"); __syncthreads(); }
        switch (kind) {
        case 1: if constexpr ((DBG_KM >> 1) & 1) { s5_expand(F, P, L); if (L == 0) phase_normu<false>(F, kin(I_X), kin(I_MIXN), (bf16*)(ws + OFF_UX)); else phase_normu<true>(F, HB, kin(I_MIXN) + L * D, (bf16*)(ws + OFF_UX)); } break;
        case 2: if constexpr ((DBG_KM >> 2) & 1) { pg8::Gemm g{(const bf16*)(ws + OFF_UX), (const bf16*)(ws + OFF_WEND), KUX, 512, 512}; pg8::OrderSloc S{F.G, (int)blockIdx.x};
                  pg8::EpiSlocScan E{(const pg8::f2v_t*)(ws + OFF_LAMPOW), (bf16*)(ws + OFF_UX)};
                  pg8::gemm_phase<pg8::EpiSlocScan, pg8::OrderSloc, true, true>(F.lds, g, S, E); } break;
        case 4: if constexpr ((DBG_KM >> 4) & 1) { pg8::Gemm g{(const bf16*)(ws + OFF_UX), (const bf16*)(ws + OFF_A2), KUX, KUX, KUX}; pg8::OrderY S{F.G, (int)blockIdx.x}; pg8::EpiY E{(bf16*)(ws + OFF_Z)};
                  pg8::gemm_phase<pg8::EpiY, pg8::OrderY, true, true>(F.lds, g, S, E); } break;
        case 5: if constexpr ((DBG_KM >> 5) & 1) { pg8::Gemm g{(const bf16*)(ws + OFF_Z), (const bf16*)(ws + OFF_MIX), 16, D, D, M * 32, 4 * M * 32, 16 * M * 32};      pg8::StaticOrder S; S.init(M, 2 * D, F.G, (int)blockIdx.x);
                  pg8::EpiRes<true> E{(L == 0) ? kin(I_X) : (const float*)nullptr, HB, ssp};
                  pg8::gemm_phase<pg8::EpiRes<true>, pg8::StaticOrder, true, true>(F.lds, g, S, E); } break;
        case 6: if constexpr ((DBG_KM >> 6) & 1) { const int ns = (L < 2) ? 32 : 16;
                  pg8::Gemm g{HB, (const bf16*)(ws + OFF_W1), D, D, D}; pg8::StaticOrder S; S.init(M, FF, F.G, (int)blockIdx.x); precompute_rstd(F, S, ssp, ns); pg8::EpiMLP1 E{(bf16*)(ws + OFF_A), (const LAS float*)(F.lds + LDS_RSTD)};
                  pg8::gemm_phase<pg8::EpiMLP1, pg8::StaticOrder, true, true>(F.lds, g, S, E); } break;
        case 7: case 11: if constexpr ((DBG_KM >> 7) & 1) { const bool mlp = (kind == 7); const bool need_ss = !(mlp && (L == 0 || L == 3));
                  pg8::Gemm g{mlp ? (const bf16*)(ws + OFF_A) : (const bf16*)(ws + OFF_Z), mlp ? (const bf16*)(ws + OFF_W2) : (const bf16*)(ws + OFF_MIX) + (size_t)3 * D * D, mlp ? 256 : D, mlp ? FF : D, mlp ? FF : D, 32, 128, mlp ? M * 512 : 512};
                  pg8::StaticOrder S; S.init(M, D, F.G, (int)blockIdx.x); pg8::EpiRes<false> E{(const float*)nullptr, HB, need_ss ? ssp : (float*)nullptr};
                  pg8::gemm_phase<pg8::EpiRes<false>, pg8::StaticOrder, true, true>(F.lds, g, S, E); } break;
        case 8: if constexpr ((DBG_KM >> 8) & 1) { const float* ss = ssp;
                  if (L == 2) phase_flogit(F, P, ss);
                  pg8::Gemm g{HB, (const bf16*)(ws + OFF_MIX), D, D, D}; pg8::StaticOrder S; S.init(M, (L == 2) ? 3 * D : D, F.G, (int)blockIdx.x);
                  static_assert(OFF_V == OFF_K + 32 * MiB && OFF_QO == OFF_K + 64 * MiB, "EpiQKV slot map"); precompute_rstd(F, S, ss, 16); pg8::EpiQKV E{(bf16*)(ws + OFF_K), (const LAS float*)(F.lds + LDS_RSTD), attn_body::C2};
                  pg8::gemm_phase<pg8::EpiQKV, pg8::StaticOrder, true, true>(F.lds, g, S, E); } break;
        case 9: if constexpr ((DBG_KM >> 9) & 1) { phase_fscan(F, P); } break;
        case 10: if constexpr ((DBG_KM >> 10) & 1) { const attn_body::AttnTensors AT{(const attn_body::bf16*)(ws + OFF_QO), (const attn_body::bf16*)(ws + OFF_K), (const attn_body::bf16*)(ws + OFF_V), (attn_body::bf16*)(ws + OFF_Z), (const float*)(ws + OFF_G), (const float*)(ws + OFF_KMAX)};
                  attn_body::attn_phase<32>((char*)lds, AT, (unsigned*)(ws + OFF_CTL) + 64 * (L - 2) + (dup_done ? 128 : 0)); } break;
        case 12: if constexpr ((DBG_KM >> 12) & 1) { phase_final(F, HB, P.out, kin(I_FINN)); } break;
        default: break;
        }
        if (DBG_DUP != 0u) { if (((DBG_DUP >> kind) & 1u) && !dup_done) { dup_done = true; --ph; xcd_barrier(bar); continue; } dup_done = false; }
        if (ph + 1 < P.ph_hi) {
            for (int r_ = 0; r_ < DBG_SYNC_REPS; ++r_) xcd_barrier(bar);
        }
        if (P.ph_hi < 0) cg::this_grid().sync();
    }
}

extern "C" void kernel_launch(void* const* d_in, const int* in_sizes, int n_in, void* d_out, int out_size, void* d_ws, size_t ws_size, hipStream_t stream) {
    static int grid = 0;
    if (grid == 0) {
        if (n_in != 20 || in_sizes[0] != M * D || out_size != M * D || ws_size < WS_END) { fprintf(stderr, "kernel_launch: unexpected shapes (n_in %d, in0 %d, out %d, ws %zu); nothing launched\n", n_in, n_in > 0 ? in_sizes[0] : -1, out_size, ws_size); grid = -1; return; }
        int dev = 0, cus = 0, per_cu = 0;
        if (hipGetDevice(&dev) != hipSuccess || hipDeviceGetAttribute(&cus, hipDeviceAttributeMultiprocessorCount, dev) != hipSuccess) { grid = -1; return; }
        if (hipFuncSetAttribute((const void*)trunk_fwd, hipFuncAttributeMaxDynamicSharedMemorySize, LDS_BYTES) != hipSuccess) { fprintf(stderr, "kernel_launch: hipFuncSetAttribute failed\n"); grid = -1; return; }
        if (hipOccupancyMaxActiveBlocksPerMultiprocessor(&per_cu, (const void*)trunk_fwd, 512, LDS_BYTES) != hipSuccess || per_cu < 1) { fprintf(stderr, "kernel_launch: occupancy query says %d\n", per_cu); per_cu = 1; }
        (void)hipGetLastError();
        grid = cus * per_cu;
    }
    if (grid < 0) return;
    (void)hipMemsetAsync((char*)d_ws + OFF_CTL, 0, ZERO_BYTES, stream);
    Params p{};
    for (int i = 0; i < 20; ++i) p.in[i] = (const float*)d_in[i];
    p.out = (float*)d_out; p.ws = (unsigned char*)d_ws;
#if MK_MULTI_LAUNCH
    for (int ph = 0; ph < NPH; ++ph) { p.ph_lo = ph; p.ph_hi = ph + 1; hipLaunchKernelGGL(trunk_fwd, dim3(grid), dim3(512), LDS_BYTES, stream, p); }
#else
    p.ph_lo = 0; p.ph_hi = NPH;
    void* args[] = {&p};
    const hipError_t e = hipLaunchCooperativeKernel((const void*)trunk_fwd, dim3(grid), dim3(512), args, LDS_BYTES, stream);
    if (e != hipSuccess) fprintf(stderr, "kernel_launch: cooperative launch failed: %s (grid %d)\n", hipGetErrorString(e), grid);
#endif
}
```

```cpp
#include <hip/hip_runtime.h>
#include <hip/hip_cooperative_groups.h>
#include <hip/hip_bf16.h>
#include <cstdio>
#include <cstdint>
#include <cmath>
namespace cg = cooperative_groups;
#ifndef MK_MULTI_LAUNCH
#define MK_MULTI_LAUNCH 0
#endif
__device__ __forceinline__ int ltid() { int t = (int)threadIdx.x; asm volatile("" : "+v"(t)); return t; }
#ifndef DBG_KM
#define DBG_KM 0xffffu
#endif
#ifndef DBG_SYNC_REPS
#define DBG_SYNC_REPS 1
#endif
#ifndef DBG_DUP
#define DBG_DUP 0u
#endif
#ifndef DBG_SIDE_REPS
#define DBG_SIDE_REPS 1
#endif
#ifndef DBG_PROBE
#define DBG_PROBE 0
#endif
namespace pg8 {
#define PG8_LAS __attribute__((address_space(3)))
typedef unsigned short bf16_t;
typedef short bf16x8 __attribute__((ext_vector_type(8)));
typedef float f32x4 __attribute__((ext_vector_type(4)));
typedef unsigned u32x4 __attribute__((ext_vector_type(4)));
constexpr int BM = 256, BK = 64, HALF = 128, HTB = HALF * BK * 2  , STAGE_BYTES = 8 * HTB, NXCD = 8, WGM = 8;

__host__ __device__ __forceinline__ int lds_byte(int r, int c) { const int st = (r >> 4) * 2 + (c >> 5), rr = r & 15, cc = c & 31, ob = rr * 64 + cc * 2; return st * 1024 + (ob ^ (((ob >> 9) & 1) << 5)); }
__host__ __device__ __forceinline__ void stage_rc(int b, int& R, int& C) { const int st = b / 1024, sb = b % 1024, swz = sb ^ (((sb >> 9) & 1) << 5); R = (st >> 1) * 16 + swz / 64; C = (st & 1) * 32 + (swz % 64) / 2; }
__host__ __device__ __forceinline__ int perm32(int rho) { const int n = rho >> 4, i = rho & 15; return 8 * (i >> 2) + 4 * n + (i & 3); }

struct Unit { int pm, pn; };
struct Gemm { const bf16_t* A; const bf16_t* Bt; int lda, ldb, K; int a_gs = 32, a_ks = 128, a_ts = 512; };

struct StaticOrder {
    int nM, nN, nwg, G, c;
    __host__ __device__ void init(int M, int N, int G_, int c_) { nM = M / BM; nN = N / BM; nwg = nM * nN; G = G_; c = c_; }
    __host__ __device__ bool next(int i, Unit& u) const {
        const long L = (long)i * G + c; if (L >= nwg) return false;
        int wgid = (int)L; { const int q = nwg / NXCD, r = nwg % NXCD, xcd = wgid % NXCD, off = wgid / NXCD; wgid = (xcd < r ? xcd * (q + 1) : r * (q + 1) + (xcd - r) * q) + off; }
        const int nig = WGM * nN, gid = wgid / nig, fm = gid * WGM, gsz = (nM - fm) < WGM ? (nM - fm) : WGM;
        u.pm = fm + ((wgid % nig) % gsz); u.pn = (wgid % nig) / gsz; return true;
    }
    __device__ __forceinline__ void a_ready(const Unit&) const {}
    __device__ __forceinline__ void done(const Unit&) const {}
};

typedef float cvt_f32x2_t __attribute__((ext_vector_type(2))); typedef __bf16 cvt_bf16x2_t __attribute__((ext_vector_type(2)));
__device__ __forceinline__ unsigned cvt_pk_bf16(float lo, float hi) { const cvt_f32x2_t v = {lo, hi}; const cvt_bf16x2_t b = __builtin_convertvector(v, cvt_bf16x2_t); return __builtin_bit_cast(unsigned, b); }
typedef float f32x2 __attribute__((ext_vector_type(2)));
__device__ __forceinline__ f32x2 gelu_pk(f32x2 v) {
    const f32x2 av = __builtin_elementwise_abs(v), d = av * 0.2316418882f + 1.0f;
    f32x2 t; t.x = __builtin_amdgcn_rcpf(d.x); t.y = __builtin_amdgcn_rcpf(d.y);
    f32x2 q = t * 0.5307027145f + (-0.7265760135f); q = q * t + 0.7107068705f; q = q * t + (-0.142248368f); q = q * t + 0.127414796f; q = q * t;
    const f32x2 s = (v * v) * (-0.72134752044f);
    f32x2 e; e.x = __builtin_amdgcn_exp2f(s.x); e.y = __builtin_amdgcn_exp2f(s.y);
    const f32x2 m = v * (q * e), r = v - m;
    f32x2 o; o.x = v.x < 0.f ? m.x : r.x; o.y = v.y < 0.f ? m.y : r.y; return o;
}

template <int ACT  > struct EpiBf16 {
    static constexpr bool PERM = true, AFTER_DRAIN = false; static_assert(ACT == 0 || ACT == 1, "EpiBf16: ACT is 0 (none) or 1 (gelu_pk)");
    bf16_t* O; int ldc; const float* bias; int split_cols; size_t split_stride; float scale0;
    __device__ __forceinline__ void operator()(const f32x4 (&acc)[2][2][4][2], const Unit& u, int wr, int wc, int fr, int fq) const {
        const int row0 = u.pm * BM + wr * 64 + fr; int colt = u.pn * BM; bf16_t* base = O;
        float sc = 1.f; if (split_cols) { const int t = colt / split_cols; base += (size_t)t * split_stride; colt -= t * split_cols; if (t == 0) sc = scale0; }
        const int col0 = colt + wc * 32 + 8 * fq, bcol0 = u.pn * BM + wc * 32 + 8 * fq;
        f32x4 bv[2][2];
#pragma unroll
        for (int bj = 0; bj < 2; ++bj)
#pragma unroll
            for (int n = 0; n < 2; ++n) bv[bj][n] = bias ? *(const f32x4*)(bias + bcol0 + bj * HALF + 4 * n) : (f32x4){0.f, 0.f, 0.f, 0.f};
#pragma unroll
        for (int ai = 0; ai < 2; ++ai)
#pragma unroll
            for (int m = 0; m < 4; ++m) { bf16_t* rowp = base + (size_t)(row0 + ai * HALF + m * 16) * ldc + col0;
#pragma unroll
                for (int bj = 0; bj < 2; ++bj) { f32x4 v0 = acc[ai][bj][m][0] + bv[bj][0], v1 = acc[ai][bj][m][1] + bv[bj][1];
                    if (ACT == 1) { f32x2 a = gelu_pk((f32x2){v0[0], v0[1]}), b = gelu_pk((f32x2){v0[2], v0[3]}), c = gelu_pk((f32x2){v1[0], v1[1]}), d = gelu_pk((f32x2){v1[2], v1[3]});
                        v0 = (f32x4){a.x, a.y, b.x, b.y}; v1 = (f32x4){c.x, c.y, d.x, d.y}; }
                    v0 = v0 * sc; v1 = v1 * sc; u32x4 w; w.x = cvt_pk_bf16(v0[0], v0[1]); w.y = cvt_pk_bf16(v0[2], v0[3]); w.z = cvt_pk_bf16(v1[0], v1[1]); w.w = cvt_pk_bf16(v1[2], v1[3]);
                    *(u32x4*)(rowp + bj * HALF) = w; } }
    }
};


constexpr float RMS_EPS_F = 1e-6f;
__device__ __forceinline__ float rstd_of(float ss) { return 1.0f / sqrtf(ss * (1.0f / 1024.0f) + RMS_EPS_F); }
__device__ __forceinline__ float rstd_slots(const float* ss, int row, int ns, int fq) {
    const f32x4* p = (const f32x4*)(ss + (size_t)row * ns + fq * (ns >> 2)); f32x4 v = p[0]; float s = (v[0] + v[1]) + (v[2] + v[3]);
    if (ns == 32) { v = p[1]; s += (v[0] + v[1]) + (v[2] + v[3]); }
    s += __shfl_xor(s, 16); s += __shfl_xor(s, 32); return rstd_of(s); }
__device__ __forceinline__ u32x4 pack8(f32x4 v0, f32x4 v1) { u32x4 w; w.x = cvt_pk_bf16(v0[0], v0[1]); w.y = cvt_pk_bf16(v0[2], v0[3]); w.z = cvt_pk_bf16(v1[0], v1[1]); w.w = cvt_pk_bf16(v1[2], v1[3]); return w; }
__device__ __forceinline__ float fast_sigmoid(float x) { return __builtin_amdgcn_rcpf(1.0f + __builtin_amdgcn_exp2f(-1.4426950408889634f * x)); }
__device__ __forceinline__ f32x2 gelu_tanh2(f32x2 y) {
    const f32x2 t = y * y, u = y * (t * (-0.10294324f) + (-2.3022082f));
    f32x2 e; e.x = __builtin_amdgcn_exp2f(u.x); e.y = __builtin_amdgcn_exp2f(u.y);
    const f32x2 d = e + 1.0f; f32x2 r; r.x = __builtin_amdgcn_rcpf(d.x); r.y = __builtin_amdgcn_rcpf(d.y);
    return y * r;
}

struct EpiQKV {
    static constexpr bool PERM = true, AFTER_DRAIN = false;
    bf16_t* Kb; const PG8_LAS float* rb; float scale0; mutable int ui = 0;
    __device__ __forceinline__ void operator()(const f32x4 (&acc)[2][2][4][2], const Unit& u, int wr, int wc, int fr, int fq) const {
        int colt = u.pn * BM; const int t = colt >> 10; colt &= 1023; const int slot = (t == 0) ? 2 : (t - 1); bf16_t* base = Kb + (size_t)slot * (16u << 20); const float sc = (t == 0) ? scale0 : 1.f;
        const int col0 = colt + wc * 32 + 8 * fq, row0 = u.pm * BM + wr * 64 + fr;
        const PG8_LAS float* rq = rb + ui * 256; ++ui;
#pragma unroll
        for (int ai = 0; ai < 2; ++ai)
#pragma unroll
            for (int m = 0; m < 4; ++m) { const int row = row0 + ai * HALF + m * 16; const float rs = rq[wr * 64 + fr + ai * HALF + m * 16] * sc; bf16_t* rowp = base + (size_t)row * 1024 + col0;
#pragma unroll
                for (int bj = 0; bj < 2; ++bj) *(u32x4*)(rowp + bj * HALF) = pack8(acc[ai][bj][m][0] * rs, acc[ai][bj][m][1] * rs); }
    }
};
struct EpiMLP1 {
    static constexpr bool PERM = true, AFTER_DRAIN = false;
    bf16_t* O; const PG8_LAS float* rb; mutable int ui = 0;
    __device__ __forceinline__ void operator()(const f32x4 (&acc)[2][2][4][2], const Unit& u, int wr, int wc, int fr, int fq) const {
        const int row0 = u.pm * BM + wr * 64 + fr; const PG8_LAS float* rq = rb + ui * 256; ++ui;
#pragma unroll
        for (int ai = 0; ai < 2; ++ai)
#pragma unroll
            for (int m = 0; m < 4; ++m) { const int row = row0 + ai * HALF + m * 16; const float rs = rq[wr * 64 + fr + ai * HALF + m * 16]; bf16_t* rowp = O + ((size_t)u.pn * 16384 + row) * 256 + wc * 32 + 8 * fq;
#pragma unroll
                for (int bj = 0; bj < 2; ++bj) { f32x4 v0 = acc[ai][bj][m][0] * rs, v1 = acc[ai][bj][m][1] * rs;
#pragma unroll
                    for (int e = 0; e < 4; ++e) { const float a = fmaxf(v0[e], 0.f), b = fmaxf(v1[e], 0.f); v0[e] = a * a; v1[e] = b * b; }
                    *(u32x4*)(rowp + bj * HALF) = pack8(v0, v1); } }
    }
};
__device__ __forceinline__ float bflo(unsigned w) { return __uint_as_float(w << 16); }
__device__ __forceinline__ float bfhi(unsigned w) { return __uint_as_float(w & 0xffff0000u); }
template <bool GLU> struct EpiRes {
    static constexpr bool PERM = true, AFTER_DRAIN = false;
    const float* hin32; bf16_t* hb; float* ss;
    __device__ __forceinline__ void operator()(const f32x4 (&acc)[2][2][4][2], const Unit& u, int wr, int wc, int fr, int fq) const {
        constexpr int NB = GLU ? 1 : 2;
        const int row0 = u.pm * BM + wr * 64 + fr, colb = GLU ? (u.pn * HALF + wc * 32 + 8 * fq) : (u.pn * BM + wc * 32 + 8 * fq);
#pragma unroll
        for (int ai = 0; ai < 2; ++ai) {
            f32x4 r0[4][NB], r1[4][NB];
            if (hin32) {
#pragma unroll
                for (int m = 0; m < 4; ++m)
#pragma unroll
                    for (int bj = 0; bj < NB; ++bj) { const size_t off = (size_t)(row0 + ai * HALF + m * 16) * 1024 + colb + bj * HALF; r0[m][bj] = *(const f32x4*)(hin32 + off); r1[m][bj] = *(const f32x4*)(hin32 + off + 4); }
            } else { u32x4 w[4][NB];
#pragma unroll
                for (int m = 0; m < 4; ++m)
#pragma unroll
                    for (int bj = 0; bj < NB; ++bj) w[m][bj] = *(const u32x4*)(hb + (size_t)(row0 + ai * HALF + m * 16) * 1024 + colb + bj * HALF);
#pragma unroll
                for (int m = 0; m < 4; ++m)
#pragma unroll
                    for (int bj = 0; bj < NB; ++bj) { const u32x4 x = w[m][bj]; r0[m][bj] = (f32x4){bflo(x.x), bfhi(x.x), bflo(x.y), bfhi(x.y)}; r1[m][bj] = (f32x4){bflo(x.z), bfhi(x.z), bflo(x.w), bfhi(x.w)}; } }
#pragma unroll
            for (int m = 0; m < 4; ++m) { const int row = row0 + ai * HALF + m * 16; float s = 0.f;
#pragma unroll
                for (int bj = 0; bj < NB; ++bj) { const size_t off = (size_t)row * 1024 + colb + bj * HALF; f32x4 o[2] = {r0[m][bj], r1[m][bj]};
#pragma unroll
                    for (int n = 0; n < 2; ++n) { f32x4 v = acc[ai][bj][m][n];
                        if (GLU) { const f32x4 gt = acc[ai][1][m][n];
#pragma unroll
                            for (int e = 0; e < 4; ++e) v[e] = v[e] * fast_sigmoid(gt[e]); }
                        o[n] = o[n] + v;
                        s += (o[n][0] * o[n][0] + o[n][1] * o[n][1]) + (o[n][2] * o[n][2] + o[n][3] * o[n][3]); }
                    *(u32x4*)(hb + off) = pack8(o[0], o[1]); }
                s += __shfl_xor(s, 16); s += __shfl_xor(s, 32);
                if (ss && fq == 0) ss[(size_t)row * (GLU ? 32 : 16) + u.pn * 4 + wc] = s; } }
    }
};
typedef float f2v_t __attribute__((ext_vector_type(2)));
struct EpiSlocScan {
    static constexpr bool PERM = true, AFTER_DRAIN = true;
    const f2v_t* lampow; bf16_t* UX;
    __device__ __forceinline__ void fused(f32x4 (&acc)[2][2][4][2], const Unit& u, int wr, int wc, int fr, int fq, PG8_LAS unsigned char* lds, int wid, int lane) const {
        constexpr int TP = 132;
        PG8_LAS float* T = (PG8_LAS float*)lds; const int col = wc * 32 + 8 * fq;
#pragma unroll
        for (int ai = 0; ai < 2; ++ai)
#pragma unroll
            for (int m = 0; m < 4; ++m) { const int n = ai * HALF + wr * 64 + m * 16 + fr; PG8_LAS float* p = T + n * TP + col;
                *(PG8_LAS f32x4*)(p) = acc[ai][0][m][0]; *(PG8_LAS f32x4*)(p + 4) = acc[ai][0][m][1]; }
        asm volatile("s_waitcnt lgkmcnt(0)" ::: "memory"); __builtin_amdgcn_s_barrier(); asm volatile("" ::: "memory");
        { const int g = u.pn, p = lane; const f2v_t lt = lampow[(size_t)(g * 64 + p) * 33 + 32]; float xr = 0.f, xi = 0.f;
          PG8_LAS float* Tw = T + (wid * 32) * TP + p; PG8_LAS float* E = T + 256 * TP;
#pragma unroll 4
          for (int k = 0; k < 32; ++k) { const float sr = Tw[k * TP], si = Tw[k * TP + 64]; const float nr = lt.x * xr - lt.y * xi + sr, ni = lt.x * xi + lt.y * xr + si; xr = nr; xi = ni; }
          E[wid * 128 + p] = xr; E[wid * 128 + 64 + p] = xi;
          f2v_t l32 = lt;
#pragma unroll
          for (int q = 0; q < 5; ++q) { const float a = l32.x * l32.x - l32.y * l32.y, b = 2.f * l32.x * l32.y; l32.x = a; l32.y = b; }
          asm volatile("s_waitcnt lgkmcnt(0)" ::: "memory"); __builtin_amdgcn_s_barrier(); asm volatile("" ::: "memory");
          xr = 0.f; xi = 0.f;
          for (int v = 0; v < wid; ++v) { const float er = E[v * 128 + p], ei = E[v * 128 + 64 + p]; const float nr = l32.x * xr - l32.y * xi + er, ni = l32.x * xi + l32.y * xr + ei; xr = nr; xi = ni; }
          bf16_t* ux = UX + (size_t)(u.pm * 256 + wid * 32) * 640 + 512 + p;
#pragma unroll 4
          for (int k = 0; k < 32; ++k) { const float sr = Tw[k * TP], si = Tw[k * TP + 64]; const unsigned w = cvt_pk_bf16(xr, xi);
              ux[(size_t)k * 640] = (bf16_t)(w & 0xffffu); ux[(size_t)k * 640 + 64] = (bf16_t)(w >> 16);
              const float nr = lt.x * xr - lt.y * xi + sr, ni = lt.x * xi + lt.y * xr + si; xr = nr; xi = ni; } }
    }
};
struct EpiY {
    static constexpr bool PERM = true, AFTER_DRAIN = false;
    bf16_t* Z;
    __device__ __forceinline__ void operator()(const f32x4 (&acc)[2][2][4][2], const Unit& u, int wr, int wc, int fr, int fq) const {
        const int g = u.pm >> 1, i = u.pm & 1, j = u.pn & 1;
#pragma unroll
        for (int ai = 0; ai < 2; ++ai)
#pragma unroll
            for (int m = 0; m < 4; ++m) { const int n = 256 * i + ai * HALF + wr * 64 + m * 16 + fr;
#pragma unroll
                for (int bj = 0; bj < 2; ++bj) { const int cc = 256 * j + 128 * bj + 32 * wc + 8 * fq, t = cc >> 4, c0 = cc & 15;
                    f32x4 v0 = acc[ai][bj][m][0], v1 = acc[ai][bj][m][1];
                    { const f32x2 a = gelu_tanh2((f32x2){v0[0], v0[1]}), b = gelu_tanh2((f32x2){v0[2], v0[3]}), c = gelu_tanh2((f32x2){v1[0], v1[1]}), d = gelu_tanh2((f32x2){v1[2], v1[3]});
                      v0 = (f32x4){a.x, a.y, b.x, b.y}; v1 = (f32x4){c.x, c.y, d.x, d.y}; }
                    *(u32x4*)(Z + ((size_t)g * 16384 + (32 * n + t)) * 16 + c0) = pack8(v0, v1); } }
    }
};
struct OrderSloc {
    int G, c;
    __device__ __forceinline__ bool next(int i, Unit& u) const { const int L = i * G + c; if (L >= 128) return false;
        int g, h; if (G >= 128 && (G & 7) == 0) { const int x = L & 7, sl = L >> 3; g = x * 8 + (sl >> 1); h = sl & 1; } else { g = L >> 1; h = L & 1; }
        u.pm = 2 * g + h; u.pn = g; return true; }
    __device__ __forceinline__ void a_ready(const Unit&) const {}
    __device__ __forceinline__ void done(const Unit&) const {}
};
struct OrderY {
    int G, c;
    __device__ __forceinline__ bool next(int i, Unit& u) const { const int L = i * G + c; if (L >= 256) return false;
        int g, q; if (G == 256) { const int x = L & 7, sl = L >> 3; g = x * 8 + (sl >> 2); q = sl & 3; } else { g = L >> 2; q = L & 3; }
        u.pm = 2 * g + (q >> 1); u.pn = 2 * g + (q & 1); return true; }
    __device__ __forceinline__ void a_ready(const Unit&) const {}
    __device__ __forceinline__ void done(const Unit&) const {}
};

template <class Epi, class Sched, bool ALIGN_EPI = false, bool SP2 = false>
__device__ __forceinline__ void gemm_phase(PG8_LAS unsigned char* lds, const Gemm g, const Sched& S, const Epi& E) {
    const int tid = ltid(), wid = __builtin_amdgcn_readfirstlane(tid >> 6), lane = tid & 63, wr = wid >> 2, wc = wid & 3, fr = lane & 15, fq = lane >> 4;
    const int K = g.K, nt = K / BK;
    unsigned voffA[2], voffB[2];
#pragma unroll
    for (int i = 0; i < 2; ++i) { int R, C; stage_rc(tid * 16 + i * 8192, R, C); const int Rb = Epi::PERM ? ((R & ~31) + perm32(R & 31)) : R;
        voffA[i] = (unsigned)(R * g.lda * 2 + (C >> 4) * g.a_gs + (C & 15) * 2); voffB[i] = (unsigned)(Rb * g.ldb + C) * 2u; }
    const size_t kstep = (size_t)(BK * 2);
#define PG8_AOFF(x) ((size_t)((x) >> 2) * (size_t)g.a_ts + (size_t)((x) & 3) * (size_t)g.a_ks)
    const size_t hstepA = (size_t)HALF * g.lda * 2, hstepB = (size_t)HALF * g.ldb * 2;
    const size_t tstepA = 2 * hstepA, tstepB = 2 * hstepB;
    const unsigned ldsw = (unsigned)wid * 1024u;
    const int aoff = lds_byte(wr * 64 + fr, fq * 8), boff = lds_byte(wc * 32 + fr, fq * 8);
#define PG8_SA(b, h) (((b) * 2 + (h)) * HTB)
#define PG8_SB(b, h) ((4 + (b) * 2 + (h)) * HTB)
#define PG8_STAGE(bufoff, gbase, voff) do { _Pragma("unroll") for (int _i = 0; _i < 2; ++_i) \
        __builtin_amdgcn_global_load_lds((const unsigned*)((const char*)(gbase) + (voff)[_i]), (PG8_LAS unsigned*)(lds + (bufoff) + ldsw + _i * 8192), 16, 0, 0); } while (0)
#define PG8_LDA(dst, b, h) do { _Pragma("unroll") for (int m = 0; m < 4; ++m) _Pragma("unroll") for (int k = 0; k < 2; ++k) dst[m][k] = *(const PG8_LAS bf16x8*)(lds + PG8_SA(b, h) + aoff + m * 2048 + k * 1024); } while (0)
#define PG8_LDB(dst, b, h) do { _Pragma("unroll") for (int n = 0; n < 2; ++n) _Pragma("unroll") for (int k = 0; k < 2; ++k) dst[n][k] = *(const PG8_LAS bf16x8*)(lds + PG8_SB(b, h) + boff + n * 2048 + k * 1024); } while (0)
#define PG8_MMA(ai, bj, At, Bt) do { __builtin_amdgcn_s_setprio(1); _Pragma("unroll") for (int m = 0; m < 4; ++m) _Pragma("unroll") for (int n = 0; n < 2; ++n) _Pragma("unroll") for (int k = 0; k < 2; ++k) \
        acc[ai][bj][m][n] = __builtin_amdgcn_mfma_f32_16x16x32_bf16(Bt[n][k], At[m][k], acc[ai][bj][m][n], 0, 0, 0); __builtin_amdgcn_s_setprio(0); } while (0)
#define PG8_WAIT_V(n) asm volatile("s_waitcnt vmcnt(" #n ")" ::: "memory")
#define PG8_WAIT_L(n) asm volatile("s_waitcnt lgkmcnt(" #n ")" ::: "memory")
#define PG8_BAR __builtin_amdgcn_s_barrier()
#define PG8_SCHED __builtin_amdgcn_sched_barrier(0)
    Unit cur, nxt; int ui = 0;
    if (!S.next(0, cur)) return;
    f32x4 acc[2][2][4][2];
#pragma unroll
    for (int a = 0; a < 2; ++a)
#pragma unroll
        for (int b = 0; b < 2; ++b)
#pragma unroll
            for (int m = 0; m < 4; ++m)
#pragma unroll
                for (int n = 0; n < 2; ++n) acc[a][b][m][n] = (f32x4){0.f, 0.f, 0.f, 0.f};
    bf16x8 At[4][2], B0[2][2], B1[2][2];
    const char* cA = (const char*)g.A + (size_t)cur.pm * tstepA; const char* cB = (const char*)g.Bt + (size_t)cur.pn * tstepB;
    S.a_ready(cur);
    if constexpr (SP2) {
        PG8_STAGE(PG8_SB(0, 0), cB, voffB); PG8_STAGE(PG8_SB(0, 1), cB + hstepB, voffB); PG8_STAGE(PG8_SA(0, 0), cA, voffA); PG8_STAGE(PG8_SA(0, 1), cA + hstepA, voffA);
        if (wr == 1) PG8_BAR;
        PG8_WAIT_V(2); PG8_BAR;
        PG8_STAGE(PG8_SB(1, 0), cB + kstep, voffB); PG8_STAGE(PG8_SA(1, 0), cA + PG8_AOFF(1), voffA); PG8_STAGE(PG8_SB(1, 1), cB + hstepB + kstep, voffB);
        PG8_WAIT_V(6); PG8_BAR;
    } else {
        PG8_STAGE(PG8_SB(0, 0), cB, voffB); PG8_STAGE(PG8_SA(0, 0), cA, voffA); PG8_STAGE(PG8_SB(0, 1), cB + hstepB, voffB); PG8_STAGE(PG8_SA(0, 1), cA + hstepA, voffA);
        if (wr == 1) PG8_BAR;
        PG8_WAIT_V(4); PG8_BAR;
        PG8_STAGE(PG8_SB(1, 0), cB + kstep, voffB); PG8_STAGE(PG8_SA(1, 0), cA + PG8_AOFF(1), voffA); PG8_STAGE(PG8_SB(1, 1), cB + hstepB + kstep, voffB);
        PG8_WAIT_V(6); PG8_BAR;
    }
    for (;;) {
        const bool has_next = S.next(ui + 1, nxt);
        const char* nA = has_next ? (const char*)g.A + (size_t)nxt.pm * tstepA : cA; const char* nB = has_next ? (const char*)g.Bt + (size_t)nxt.pn * tstepB : cB;
        for (int t = 0; t < nt; t += 2) {
            const bool last = (t == nt - 2);
            const char* a1 = cA + PG8_AOFF(t + 1);
            const char* a2 = last ? nA : cA + PG8_AOFF(t + 2); const char* b2 = last ? nB : cB + (size_t)(t + 2) * kstep;
            const char* a3 = a2 + (size_t)g.a_ks; const char* b3 = b2 + kstep;
            if (last && has_next) S.a_ready(nxt);
            if constexpr (SP2) {
            PG8_LDB(B0, 0, 0); PG8_LDB(B1, 0, 1); PG8_SCHED; PG8_LDA(At, 0, 0); PG8_STAGE(PG8_SA(1, 1), a1 + hstepA, voffA);
            PG8_WAIT_V(8); PG8_WAIT_L(0); PG8_BAR; PG8_MMA(0, 0, At, B0); PG8_MMA(0, 1, At, B1); PG8_BAR; PG8_SCHED;
            PG8_LDA(At, 0, 1); PG8_STAGE(PG8_SB(0, 0), b2, voffB); PG8_STAGE(PG8_SB(0, 1), b2 + hstepB, voffB); PG8_STAGE(PG8_SA(0, 0), a2, voffA);
            PG8_WAIT_V(8); PG8_WAIT_L(0); PG8_BAR; PG8_MMA(1, 0, At, B0); PG8_MMA(1, 1, At, B1); PG8_BAR; PG8_SCHED;
            PG8_LDB(B0, 1, 0); PG8_LDB(B1, 1, 1); PG8_SCHED; PG8_LDA(At, 1, 0); PG8_STAGE(PG8_SA(0, 1), a2 + hstepA, voffA);
            PG8_WAIT_V(8); PG8_WAIT_L(0); PG8_BAR; PG8_MMA(0, 0, At, B0); PG8_MMA(0, 1, At, B1); PG8_BAR; PG8_SCHED;
            PG8_LDA(At, 1, 1); PG8_STAGE(PG8_SB(1, 0), b3, voffB); PG8_STAGE(PG8_SB(1, 1), b3 + hstepB, voffB); PG8_STAGE(PG8_SA(1, 0), a3, voffA);
            PG8_WAIT_V(8); PG8_WAIT_L(0); PG8_BAR; PG8_MMA(1, 0, At, B0); PG8_MMA(1, 1, At, B1); PG8_BAR; PG8_SCHED;
            } else {
            PG8_LDB(B0, 0, 0); PG8_SCHED; PG8_LDA(At, 0, 0); PG8_STAGE(PG8_SA(1, 1), a1 + hstepA, voffA);
            PG8_WAIT_L(8); PG8_BAR; PG8_WAIT_L(0); PG8_MMA(0, 0, At, B0); PG8_BAR; PG8_SCHED;
            PG8_LDB(B1, 0, 1); PG8_STAGE(PG8_SB(0, 0), b2, voffB);
            PG8_BAR; PG8_WAIT_L(0); PG8_MMA(0, 1, At, B1); PG8_BAR;
            PG8_LDA(At, 0, 1); PG8_STAGE(PG8_SA(0, 0), a2, voffA);
            PG8_BAR; PG8_WAIT_L(0); PG8_MMA(1, 0, At, B0); PG8_BAR; PG8_SCHED;
            PG8_STAGE(PG8_SB(0, 1), b2 + hstepB, voffB);
            PG8_WAIT_V(6); PG8_BAR; PG8_MMA(1, 1, At, B1); PG8_BAR;
            PG8_LDB(B0, 1, 0); PG8_SCHED; PG8_LDA(At, 1, 0); PG8_STAGE(PG8_SA(0, 1), a2 + hstepA, voffA);
            PG8_WAIT_L(8); PG8_BAR; PG8_WAIT_L(0); PG8_MMA(0, 0, At, B0); PG8_BAR; PG8_SCHED;
            PG8_LDB(B1, 1, 1); PG8_STAGE(PG8_SB(1, 0), b3, voffB);
            PG8_BAR; PG8_WAIT_L(0); PG8_MMA(0, 1, At, B1); PG8_BAR;
            PG8_LDA(At, 1, 1); PG8_STAGE(PG8_SA(1, 0), a3, voffA);
            PG8_BAR; PG8_WAIT_L(0); PG8_MMA(1, 0, At, B0); PG8_BAR; PG8_SCHED;
            PG8_STAGE(PG8_SB(1, 1), b3 + hstepB, voffB);
            PG8_WAIT_V(6); PG8_BAR; PG8_MMA(1, 1, At, B1); PG8_BAR;
            }
        }
        if constexpr (ALIGN_EPI) { if (wr == 0) PG8_BAR; }
        if constexpr (!Epi::AFTER_DRAIN) { E(acc, cur, wr, wc, fr, fq); S.done(cur); }
        if (!has_next) break;
#pragma unroll
        for (int a = 0; a < 2; ++a)
#pragma unroll
            for (int b = 0; b < 2; ++b)
#pragma unroll
                for (int m = 0; m < 4; ++m)
#pragma unroll
                    for (int n = 0; n < 2; ++n) acc[a][b][m][n] = (f32x4){0.f, 0.f, 0.f, 0.f};
        cur = nxt; cA = nA; cB = nB; ++ui;
        if constexpr (ALIGN_EPI) { if (wr == 1) PG8_BAR; }
    }
    PG8_WAIT_V(0);
    if constexpr (!ALIGN_EPI) { if (wr == 0) PG8_BAR; }
    PG8_BAR;
    if constexpr (Epi::AFTER_DRAIN) { E.fused(acc, cur, wr, wc, fr, fq, lds, wid, lane); S.done(cur); }
#undef PG8_AOFF
#undef PG8_SA
#undef PG8_SB
#undef PG8_STAGE
#undef PG8_LDA
#undef PG8_LDB
#undef PG8_MMA
#undef PG8_WAIT_V
#undef PG8_WAIT_L
#undef PG8_BAR
#undef PG8_SCHED
}
}
namespace attn_body {
using bf16=__hip_bfloat16;
using bf16x8=__attribute__((ext_vector_type(8)))short;
using s16x4=__attribute__((ext_vector_type(4)))short;
using f32x16=__attribute__((ext_vector_type(16)))float;
using u32x4=__attribute__((ext_vector_type(4)))unsigned;
using f32x4_t=__attribute__((ext_vector_type(4)))float;
constexpr int BATCH=2,NHEAD=16,SEQ=8192,D=64,DM=NHEAD*D;
constexpr int NW=8,QBLK=32,QB=QBLK*NW,KVBLK=64,NQB=SEQ/QB;
constexpr int ATTN_PITCH=DM, ATTN_UNIT_ROWS=QB;
__device__ __forceinline__ int crow(int r,int hi){return (r&3)+8*(r>>2)+4*hi;}
#define SBAR() __builtin_amdgcn_sched_barrier(0)
__device__ __forceinline__ void cmask(f32x16&p0,f32x16&p1,int jb,int qrel,int hi){
  const float NEG=-INFINITY; int kb=64*jb+4*hi;
  #pragma unroll
  for(int r=0;r<16;++r){int kv=kb+(r&3)+8*(r>>2); if(kv>qrel)p0[r]=NEG; if(kv+32>qrel)p1[r]=NEG;}
}

constexpr int NSLOT=3, SLOTB=8192;
constexpr int LDS_K=0, LDS_V=NSLOT*SLOTB, LDS_WS=2*NSLOT*SLOTB, LDS_OST=LDS_WS+NW*64*4, LDS_GT=LDS_OST+NW*4096, LDS_QM=LDS_GT+SEQ*4, LDS_CF=LDS_QM+64, LDS_ORD=LDS_CF+512, LDS_BYTES=LDS_ORD+256;
constexpr float C2=0.125f*1.4426950408889634f;
__device__ __forceinline__ void glds16(const void*gsrc,unsigned lds_dst){unsigned keep;
  asm volatile("s_mov_b32 %0, m0\n\ts_mov_b32 m0, %2\n\ts_nop 0\n\tglobal_load_lds_dwordx4 %1, off\n\ts_mov_b32 m0, %0":"=&s"(keep):"v"(gsrc),"s"(lds_dst):"memory");}
__device__ __forceinline__ float max3f(float a,float b,float c){float r;asm("v_max3_f32 %0, %1, %2, %3":"=v"(r):"v"(a),"v"(b),"v"(c));return r;}
__device__ __forceinline__ float max2f(float a,float b){float r;asm("v_max_f32_e32 %0, %1, %2":"=v"(r):"v"(a),"v"(b));return r;}
__device__ __forceinline__ float fadd_s(float a,float b){float r;asm("v_add_f32_e32 %0, %1, %2":"=v"(r):"v"(a),"v"(b));return r;}
__device__ __forceinline__ float fsub_s(float a,float b){float r;asm("v_sub_f32_e32 %0, %1, %2":"=v"(r):"v"(a),"v"(b));return r;}
typedef float f32x2_t __attribute__((ext_vector_type(2))); typedef __bf16 bf16x2_t __attribute__((ext_vector_type(2)));
__device__ __forceinline__ unsigned cvtpk_s(float lo,float hi){f32x2_t v={lo,hi};bf16x2_t b=__builtin_convertvector(v,bf16x2_t);return __builtin_bit_cast(unsigned,b);}
#define WAIT_BAR(N) asm volatile("s_waitcnt vmcnt(" #N ") lgkmcnt(0)\n\ts_barrier":::"memory")

__device__ __forceinline__ void qkt(f32x16&p0,f32x16&p1,const char*Kslot,const bf16x8*qr,int r32,int hi){
  const char*kb=Kslot+hi*1024+r32*16;
  #pragma unroll
  for(int d0=0;d0<4;++d0){
    const bf16x8 b0=*reinterpret_cast<const bf16x8*>(kb+d0*2048);
    const bf16x8 b1=*reinterpret_cast<const bf16x8*>(kb+d0*2048+512);
    {p0=__builtin_amdgcn_mfma_f32_32x32x16_bf16(b0,qr[d0],p0,0,0,0);p1=__builtin_amdgcn_mfma_f32_32x32x16_bf16(b1,qr[d0],p1,0,0,0);}}
}
typedef __attribute__((address_space(3))) const char* lds_cptr;
typedef short v4i16_t __attribute__((ext_vector_type(4)));
__device__ __forceinline__ void kload8(bf16x8*kf,lds_cptr kp){
  kf[0]=*(const __attribute__((address_space(3))) bf16x8*)(kp);      kf[1]=*(const __attribute__((address_space(3))) bf16x8*)(kp+512);
  kf[2]=*(const __attribute__((address_space(3))) bf16x8*)(kp+2048); kf[3]=*(const __attribute__((address_space(3))) bf16x8*)(kp+2560);
  kf[4]=*(const __attribute__((address_space(3))) bf16x8*)(kp+4096); kf[5]=*(const __attribute__((address_space(3))) bf16x8*)(kp+4608);
  kf[6]=*(const __attribute__((address_space(3))) bf16x8*)(kp+6144); kf[7]=*(const __attribute__((address_space(3))) bf16x8*)(kp+6656);
}
__device__ __forceinline__ void kload2(bf16x8*kf,lds_cptr kp,int j){ kf[2*j]=*(const __attribute__((address_space(3))) bf16x8*)(kp+j*2048); kf[2*j+1]=*(const __attribute__((address_space(3))) bf16x8*)(kp+j*2048+512); }
__device__ __forceinline__ s16x4 vtr(lds_cptr p){ return __builtin_bit_cast(s16x4,__builtin_amdgcn_ds_read_tr16_b64_v4i16((__attribute__((address_space(3))) v4i16_t*)p)); }
__device__ __forceinline__ float rowmax(const f32x16&p0,const f32x16&p1){
  float a=max3f(p0[0],p0[1],p1[0]),b=max3f(p0[2],p0[3],p1[1]);a=max3f(a,p1[2],p1[3]);
  #pragma unroll
  for(int r=4;r<16;r+=4){a=max3f(a,p0[r],p0[r+1]);b=max3f(b,p0[r+2],p0[r+3]);a=max3f(a,p1[r],p1[r+1]);b=max3f(b,p1[r+2],p1[r+3]);}
  const float m=max2f(a,b);
  auto rr=__builtin_amdgcn_permlane32_swap(__float_as_uint(m),__float_as_uint(m),false,false);
  return max2f(__uint_as_float(rr[0]),__uint_as_float(rr[1]));
}
__device__ __forceinline__ void pv(f32x16*o,int vb,bf16x8 pa0,bf16x8 pa1,bf16x8 pa2,bf16x8 pa3){
  #pragma unroll
  for(int d0=0;d0<2;++d0){s16x4 lo[4],hi[4];
    #pragma unroll
    for(int ks=0;ks<4;++ks){
      asm volatile("ds_read_b64_tr_b16 %0,%1 offset:%c2":"=&v"(lo[ks]):"v"(vb),"i"(d0*4096+ks*1024):"memory");
      asm volatile("ds_read_b64_tr_b16 %0,%1 offset:%c2":"=&v"(hi[ks]):"v"(vb),"i"(d0*4096+ks*1024+512):"memory");}
    asm volatile("s_waitcnt lgkmcnt(0)":::"memory");SBAR();
    #define PK(k) (bf16x8){lo[k][0],lo[k][1],lo[k][2],lo[k][3],hi[k][0],hi[k][1],hi[k][2],hi[k][3]}
    o[d0]=__builtin_amdgcn_mfma_f32_32x32x16_bf16(pa0,PK(0),o[d0],0,0,0);
    o[d0]=__builtin_amdgcn_mfma_f32_32x32x16_bf16(pa1,PK(1),o[d0],0,0,0);
    o[d0]=__builtin_amdgcn_mfma_f32_32x32x16_bf16(pa2,PK(2),o[d0],0,0,0);
    o[d0]=__builtin_amdgcn_mfma_f32_32x32x16_bf16(pa3,PK(3),o[d0],0,0,0);
    #undef PK
  }
}

#ifndef ATTN_STORE16
#define ATTN_STORE16(p,v) (*(u32x4*)(p)=(v))
#endif
template<int THRL> __device__ __forceinline__ void attn_unit(int b,int h,int qb,const bf16*Q,const bf16*__restrict__ K,const bf16*__restrict__ V,bf16*O,const float*__restrict__ Gg,float kmax,char*shm){
  const int tid=ltid(),lane=tid&63,r32=lane&31,hi=lane>>5; const int wid=__builtin_amdgcn_readfirstlane(tid>>6);
  const long rowbase=(long)b*SEQ; const int q0=qb*QB;
  const bf16*Qw=Q+(rowbase+q0+wid*QBLK)*DM+h*D;
  const lds_cptr shm3=(lds_cptr)shm;
  bf16x8 qr[4];
  #pragma unroll
  for(int d0=0;d0<4;++d0)qr[d0]=*reinterpret_cast<const bf16x8*>(&Qw[(long)r32*DM+d0*16+hi*8]);
  { const int nk=q0+QB; const float gb=q0?Gg[q0-1]:0.f;
    f32x4_t g4_[4]; float ge_[4];
    #pragma unroll
    for(int k_=0;k_<4;++k_){ const int i=tid*4+k_*2048; if(i<nk){ g4_[k_]=*(const f32x4_t*)(Gg+i); ge_[k_]=(i>=q0)?gb:Gg[i|63]; } }
    #pragma unroll
    for(int k_=0;k_<4;++k_){ const int i=tid*4+k_*2048; if(i<nk){ const float ge=ge_[k_]; const f32x4_t g4=g4_[k_]; *(__attribute__((address_space(3))) f32x4_t*)(shm3+LDS_GT+i*4)=(f32x4_t){g4[0]-ge,g4[1]-ge,g4[2]-ge,g4[3]-ge}; } }
    if(tid<(nk>>6)){ const float c_=(tid==0||64*tid>=q0)?1.f:__builtin_amdgcn_exp2f(Gg[64*tid-1]-Gg[64*tid+63]); *(__attribute__((address_space(3))) float*)(shm3+LDS_CF+tid*4)=c_; } }
  { float qs=0.f;
    #pragma unroll
    for(int d0=0;d0<4;++d0){
      #pragma unroll
      for(int e=0;e<8;++e){const float f=__uint_as_float(((unsigned)(unsigned short)qr[d0][e])<<16);qs+=f*f;}}
    {auto rr=__builtin_amdgcn_permlane32_swap(__float_as_uint(qs),__float_as_uint(qs),false,false);qs=__uint_as_float(rr[0])+__uint_as_float(rr[1]);}
    #pragma unroll
    for(int o_=1;o_<32;o_<<=1)qs=fmaxf(qs,__shfl_xor(qs,o_));
    if(lane==0)*(__attribute__((address_space(3))) float*)(shm3+LDS_QM+wid*4)=qs; }
  asm volatile("s_waitcnt vmcnt(0) lgkmcnt(0)\n\ts_barrier":::"memory");
  int j0;
  { float qm=0.f;
    #pragma unroll
    for(int w=0;w<8;++w)qm=fmaxf(qm,*(const __attribute__((address_space(3))) float*)(shm3+LDS_QM+w*4));
    const float lim=Gg[q0]-(2.f*sqrtf(qm)*kmax*1.01f+150.f);
    const int nt0=4*qb; int ln_=lane; asm volatile("":"+v"(ln_)); const bool c0=(ln_<nt0)&&(Gg[64*ln_+63]<lim); const bool c1=(ln_+64<nt0)&&(Gg[64*ln_+4096+63]<lim);
    j0=(__popcll(__ballot(c0))+__popcll(__ballot(c1)))&~1; j0=__builtin_amdgcn_readfirstlane(j0); }
  const bf16*Kh=K+(rowbase+(long)j0*KVBLK)*DM+h*D,*Vh=V+(rowbase+(long)j0*KVBLK)*DM+h*D;
  const lds_cptr cf0=shm3+LDS_CF+j0*4;
  const lds_cptr gp0=shm3+LDS_GT+j0*256+hi*16;
  const unsigned lds0=(unsigned)(uintptr_t)shm;
  float*wsf=(float*)(shm+LDS_WS)+wid*64;
  const bf16*ksrc=Kh+(long)lane*DM+wid*8;
  const bf16*vsrc=Vh+(long)(16*(wid&3)+(lane>>2))*DM+(wid>>2)*32+(lane&3)*8;
  const unsigned kdst=lds0+LDS_K+wid*1024, vdst=lds0+LDS_V+wid*1024;
  #define DMA_K(t,slot) glds16(ksrc+(long)(t)*KVBLK*DM,(unsigned)__builtin_amdgcn_readfirstlane(kdst+(slot)))
  #define DMA_V(t,slot) glds16(vsrc+(long)(t)*KVBLK*DM,(unsigned)__builtin_amdgcn_readfirstlane(vdst+(slot)))
  const char*Kbase=shm+LDS_K; bf16x8 kf[8];
  const lds_cptr kp0=shm3+LDS_K+hi*1024+r32*16; const lds_cptr vp0=shm3+LDS_V+((lane>>4)&1)*32+(lane&3)*8+(4*hi+((lane&15)>>2))*64;
  const int NT=(q0+QB)/KVBLK-j0;
  DMA_K(0,0);DMA_V(0,0);DMA_K(1,SLOTB);
  float mhat=0.f,l_reg=0.f;f32x16 o[2];o[0]=f32x16{};o[1]=f32x16{};
  const int qrel=wid*QBLK+r32;
  #define CMASK(P0,P1,t) do{int jb_=(t)-(NT-4); if(jb_>=0)cmask(P0,P1,jb_,qrel,hi);}while(0)
  #define BIASINIT(P0,P1,t) do{ const lds_cptr gp_=gp0+(t)*256; \
    _Pragma("unroll") for(int i_=0;i_<4;++i_){ const f32x4_t ga_=*(const __attribute__((address_space(3))) f32x4_t*)(gp_+i_*32), gb_=*(const __attribute__((address_space(3))) f32x4_t*)(gp_+128+i_*32); \
      P0[4*i_]=ga_[0]-mhat;P0[4*i_+1]=ga_[1]-mhat;P0[4*i_+2]=ga_[2]-mhat;P0[4*i_+3]=ga_[3]-mhat; P1[4*i_]=gb_[0]-mhat;P1[4*i_+1]=gb_[1]-mhat;P1[4*i_+2]=gb_[2]-mhat;P1[4*i_+3]=gb_[3]-mhat; } }while(0)
  bool resc=false;
  #define START(P0,P1) do{ const float rm=rowmax(P0,P1); resc=false; \
    { const float dl=rm; mhat=fadd_s(mhat,dl); \
      _Pragma("unroll") for(int r=0;r<16;++r){P0[r]=fsub_s(P0[r],dl);P1[r]=fsub_s(P1[r],dl);} \
      } \
    _Pragma("unroll") for(int r=0;r<16;++r)P0[r]=__builtin_amdgcn_exp2f(P0[r]); }while(0)
  #define RESC(t) do{ const float cf_=*(const __attribute__((address_space(3))) float*)(cf0+(t)*4); l_reg*=cf_; \
      if(resc){ asm volatile("s_waitcnt lgkmcnt(0)":::"memory"); \
        _Pragma("unroll") for(int d_=0;d_<2;++d_) _Pragma("unroll") for(int r=0;r<16;++r)o[d_][r]*=cf_*wsf[crow(r,hi)]; } \
      else { _Pragma("unroll") for(int d_=0;d_<2;++d_) _Pragma("unroll") for(int r=0;r<16;++r)o[d_][r]*=cf_; } }while(0)
  f32x16 pA0,pA1,pB0,pB1;
  int sl_prev=0,sl_cur=0,sl_next=SLOTB;
  #define ROT() do{sl_prev=sl_cur;sl_cur=sl_next;sl_next=(sl_next==(NSLOT-1)*SLOTB)?0:sl_next+SLOTB;}while(0)
  DMA_K(2,2*SLOTB);
  WAIT_BAR(3);
  BIASINIT(pA0,pA1,0);qkt(pA0,pA1,Kbase,qr,r32,hi);asm volatile("s_nop 15\n\ts_nop 7":"+v"(pA0),"+v"(pA1));CMASK(pA0,pA1,0);
  START(pA0,pA1);
  _Pragma("unroll") for(int r=0;r<16;++r)pA1[r]=__builtin_amdgcn_exp2f(pA1[r]);
  WAIT_BAR(0);
  DMA_K(3,0);DMA_V(1,SLOTB);
  ROT();
  kload8(kf,kp0+sl_cur);
  WAIT_BAR(2);
  s16x4 vlo[8],vhi[8]; u32x4 pw0,pw1,pw2,pw3;
  #define PKW(P,B) cvtpk_s(P[B],P[B+1])
  #define PAF(k) __builtin_bit_cast(bf16x8,pw##k)
  #define VFR(i) (bf16x8){vlo[i][0],vlo[i][1],vlo[i][2],vlo[i][3],vhi[i][0],vhi[i][1],vhi[i][2],vhi[i][3]}
  #define PIN(x) asm volatile("":"+v"(x))
  #define MX3(a,b,c) __builtin_fmaxf(__builtin_fmaxf((a),(b)),(c))
  #define GAPA(MF,A0,A1,A2,A3,W0,W1,PW) do{ MF; sacc+=A0; sacc+=A1; sacc+=A2; sacc+=A3; PIN(sacc); W0; W1; PIN(PW); SBAR(); }while(0)
  #define EX(v) __builtin_amdgcn_exp2f(v)
  #define GAPB(MF,X,B) do{ MF; X[B]=EX(X[B]); X[B+1]=EX(X[B+1]); X[B+2]=EX(X[B+2]); X[B+3]=EX(X[B+3]); PIN(X); SBAR(); }while(0)
  #define VRD(i) do{ vlo[i]=vtr(vp_+(((i)>>2)*4096+((i)&3)*1024)); vhi[i]=vtr(vp_+(((i)>>2)*4096+((i)&3)*1024+512)); }while(0)
  #define KRD(G,j) do{ if(G){ kload2(kf,kp0+sl_next,j); SBAR(); } }while(0)
  #define STEP(C0,C1,P0,P1,t,GK,GV,GL) do{ SBAR(); BIASINIT(C0,C1,t); SBAR(); \
    const lds_cptr vp_=vp0+sl_prev; \
    VRD(0); SBAR(); float sacc=(P0[0]+P0[1]); \
    GAPA(C0=__builtin_amdgcn_mfma_f32_32x32x16_bf16(kf[0],qr[0],C0,0,0,0), P0[2],P0[3],P0[4],P0[5],     pw0[0]=PKW(P0,0), pw0[1]=PKW(P0,2), pw0); \
    VRD(4); SBAR(); GAPA(C1=__builtin_amdgcn_mfma_f32_32x32x16_bf16(kf[1],qr[0],C1,0,0,0), P0[6],P0[7],P0[8],P0[9],     pw0[2]=PKW(P0,4), pw0[3]=PKW(P0,6), pw0); \
    VRD(1); SBAR(); GAPA(C0=__builtin_amdgcn_mfma_f32_32x32x16_bf16(kf[2],qr[1],C0,0,0,0),   P0[10],P0[11],P0[12],P0[13], pw1[0]=PKW(P0,8), pw1[1]=PKW(P0,10), pw1); \
    VRD(5); SBAR(); GAPA(C1=__builtin_amdgcn_mfma_f32_32x32x16_bf16(kf[3],qr[1],C1,0,0,0),   P0[14],P0[15],P1[0],P1[1],   pw1[2]=PKW(P0,12),pw1[3]=PKW(P0,14), pw1); \
    VRD(2); SBAR(); GAPA(C0=__builtin_amdgcn_mfma_f32_32x32x16_bf16(kf[4],qr[2],C0,0,0,0),   P1[2],P1[3],P1[4],P1[5],     pw2[0]=PKW(P1,0), pw2[1]=PKW(P1,2), pw2); \
    VRD(6); SBAR(); GAPA(C1=__builtin_amdgcn_mfma_f32_32x32x16_bf16(kf[5],qr[2],C1,0,0,0),   P1[6],P1[7],P1[8],P1[9],     pw2[2]=PKW(P1,4), pw2[3]=PKW(P1,6), pw2); \
    VRD(3); SBAR(); GAPA(C0=__builtin_amdgcn_mfma_f32_32x32x16_bf16(kf[6],qr[3],C0,0,0,0),   P1[10],P1[11],P1[12],P1[13], pw3[0]=PKW(P1,8), pw3[1]=PKW(P1,10), pw3); \
    VRD(7); SBAR(); GAPA(C1=__builtin_amdgcn_mfma_f32_32x32x16_bf16(kf[7],qr[3],C1,0,0,0),   P1[14],P1[15],0.f,0.f,       pw3[2]=PKW(P1,12),pw3[3]=PKW(P1,14), pw3); \
    l_reg+=sacc; \
    if(GK){DMA_K((t)+3,sl_cur);} if(GV){DMA_V((t)+1,sl_next);} \
    CMASK(C0,C1,t); \
    { float a=MX3(C0[0],C0[1],C1[0]),b=MX3(C0[2],C0[3],C1[1]); a=MX3(a,C1[2],C1[3]); \
      _Pragma("unroll") for(int r=4;r<16;r+=4){a=MX3(a,C0[r],C0[r+1]);b=MX3(b,C0[r+2],C0[r+3]);a=MX3(a,C1[r],C1[r+1]);b=MX3(b,C1[r+2],C1[r+3]);} \
      float rm=__builtin_fmaxf(a,b); { auto rr=__builtin_amdgcn_permlane32_swap(__float_as_uint(rm),__float_as_uint(rm),false,false); rm=__builtin_fmaxf(__uint_as_float(rr[0]),__uint_as_float(rr[1])); } \
      resc=false; \
      if(__builtin_expect(__any(rm>(float)THRL),0)){ const float dl=__builtin_fmaxf(rm,0.f); mhat+=dl; \
        _Pragma("unroll") for(int r=0;r<16;++r){C0[r]-=dl;C1[r]-=dl;} \
        const float f=__builtin_amdgcn_exp2f(-dl); l_reg*=f; if(hi==0)wsf[r32]=f; resc=true; } } \
    SBAR(); \
    GAPB(o[0]=__builtin_amdgcn_mfma_f32_32x32x16_bf16(PAF(0),VFR(0),o[0],0,0,0), C0,0); \
    GAPB(o[1]=__builtin_amdgcn_mfma_f32_32x32x16_bf16(PAF(0),VFR(4),o[1],0,0,0), C0,4); \
    KRD(GL,0); GAPB(o[0]=__builtin_amdgcn_mfma_f32_32x32x16_bf16(PAF(1),VFR(1),o[0],0,0,0), C0,8); \
    KRD(GL,1); GAPB(o[1]=__builtin_amdgcn_mfma_f32_32x32x16_bf16(PAF(1),VFR(5),o[1],0,0,0), C0,12); \
    KRD(GL,2); GAPB(o[0]=__builtin_amdgcn_mfma_f32_32x32x16_bf16(PAF(2),VFR(2),o[0],0,0,0), C1,0); \
    KRD(GL,3); GAPB(o[1]=__builtin_amdgcn_mfma_f32_32x32x16_bf16(PAF(2),VFR(6),o[1],0,0,0), C1,4); \
    GAPB(o[0]=__builtin_amdgcn_mfma_f32_32x32x16_bf16(PAF(3),VFR(3),o[0],0,0,0), C1,8); \
    GAPB(o[1]=__builtin_amdgcn_mfma_f32_32x32x16_bf16(PAF(3),VFR(7),o[1],0,0,0), C1,12); \
    }while(0)
  int t=1;
  #undef CMASK
  #define CMASK(P0,P1,t) do{}while(0)
  for(;t+5<NT;t+=2){
    STEP(pB0,pB1,pA0,pA1,t,true,true,true);     WAIT_BAR(2); RESC(t); ROT();
    STEP(pA0,pA1,pB0,pB1,t+1,true,true,true);   WAIT_BAR(2); RESC(t+1); ROT();
  }
  #undef CMASK
  #define CMASK(P0,P1,t) do{int jb_=(t)-(NT-4); if(jb_>=0)cmask(P0,P1,jb_,qrel,hi);}while(0)
  #define ENDW(tt) do{ if((tt)+3<NT){WAIT_BAR(2);} else if((tt)+2<NT){WAIT_BAR(1);} else {WAIT_BAR(0);} }while(0)
  for(;t+1<NT;t+=2){
    STEP(pB0,pB1,pA0,pA1,t,(t+3<NT),(t+1<NT),(t+1<NT));       ENDW(t);   RESC(t); ROT();
    STEP(pA0,pA1,pB0,pB1,t+1,(t+4<NT),(t+2<NT),(t+2<NT));     ENDW(t+1); RESC(t+1); ROT();
  }
  STEP(pB0,pB1,pA0,pA1,NT-1,false,false,false); RESC(NT-1);
  { float sacc=pB0[0]+pB0[1]; _Pragma("unroll") for(int r=2;r<16;++r)sacc+=pB0[r]; _Pragma("unroll") for(int r=0;r<16;++r)sacc+=pB1[r]; l_reg+=sacc;
    pw0=(u32x4){PKW(pB0,0),PKW(pB0,2),PKW(pB0,4),PKW(pB0,6)};pw1=(u32x4){PKW(pB0,8),PKW(pB0,10),PKW(pB0,12),PKW(pB0,14)};pw2=(u32x4){PKW(pB1,0),PKW(pB1,2),PKW(pB1,4),PKW(pB1,6)};pw3=(u32x4){PKW(pB1,8),PKW(pB1,10),PKW(pB1,12),PKW(pB1,14)};
    SBAR(); pv(o,(int)(lds0+LDS_V)+((lane>>4)&1)*32+(lane&3)*8+(4*hi+((lane&15)>>2))*64+sl_cur,PAF(0),PAF(1),PAF(2),PAF(3)); }
  #undef PKW
  #undef PAF
  #undef VFR
  #undef PIN
  #undef MX3
  #undef GAPA
  #undef GAPB
  #undef EX
  #undef VRD
  #undef KRD
  #undef STEP
  #undef ENDW
  {auto rr=__builtin_amdgcn_permlane32_swap(__float_as_uint(l_reg),__float_as_uint(l_reg),false,false);l_reg=__uint_as_float(rr[0])+__uint_as_float(rr[1]);}
  if(hi==0)wsf[32+r32]=l_reg;asm volatile("s_waitcnt lgkmcnt(0)":::"memory");
  float rli[16];
  #pragma unroll
  for(int r=0;r<16;++r)rli[r]=__builtin_amdgcn_rcpf(wsf[32+crow(r,hi)]);
  bf16*Ow=O+(rowbase+q0+wid*QBLK)*DM+h*D;
  { bf16*stg=(bf16*)(shm+LDS_OST)+wid*2048;
    #pragma unroll
    for(int r=0;r<16;++r){const int orow=crow(r,hi);
      #pragma unroll
      for(int d0=0;d0<2;++d0)stg[orow*64+d0*32+r32]=__float2bfloat16(o[d0][r]*rli[r]);}
    asm volatile("s_waitcnt lgkmcnt(0)":::"memory");
    #pragma unroll
    for(int i=0;i<4;++i){const int row=i*8+(lane>>3),ch=lane&7; const u32x4 v=*(const u32x4*)(stg+row*64+ch*8); ATTN_STORE16(Ow+(long)row*DM+ch*8,v);} }
  asm volatile("s_waitcnt lgkmcnt(0)\n\ts_barrier":::"memory");
  #undef DMA_K
  #undef DMA_V
  #undef CMASK
  #undef BIASINIT
  #undef START
  #undef RESC
  #undef ROT
}
constexpr int ATTN_LDS_BYTES=LDS_BYTES;
struct AttnTensors { const bf16* Q; const bf16* K; const bf16* V; bf16* O; const float* G; const float* kmax; };
template<int THRL=8> __device__ __forceinline__ void attn_phase(char*lds,const AttnTensors&T,unsigned*counter){
  const lds_cptr shm3=(lds_cptr)lds;
  { const int t_=threadIdx.x;
    if(t_<32)*(__attribute__((address_space(3))) float*)(shm3+LDS_ORD+t_*4)=T.G[(size_t)t_*SEQ+SEQ-1];
    asm volatile("s_waitcnt vmcnt(0) lgkmcnt(0)\n\ts_barrier":::"memory");
    if(t_<32){ const float g_=*(const __attribute__((address_space(3))) float*)(shm3+LDS_ORD+t_*4); int r_=0;
      for(int j=0;j<32;++j){ const float o_=*(const __attribute__((address_space(3))) float*)(shm3+LDS_ORD+j*4); r_+=(o_<g_||(o_==g_&&j<t_))?1:0; }
      *(__attribute__((address_space(3))) int*)(shm3+LDS_ORD+128+r_*4)=t_; }
    asm volatile("s_waitcnt lgkmcnt(0)\n\ts_barrier":::"memory"); }
  for(;;){
    if(threadIdx.x==0){ const unsigned v=atomicAdd(counter,1u); *(__attribute__((address_space(3))) unsigned*)(shm3+LDS_QM+32)=v; }
    asm volatile("s_waitcnt vmcnt(0) lgkmcnt(0)\n\ts_barrier":::"memory");
    const unsigned idx=*(const __attribute__((address_space(3))) unsigned*)(shm3+LDS_QM+32);
    if(idx>=(unsigned)(BATCH*NHEAD*NQB))break;
    const int bh=*(const __attribute__((address_space(3))) int*)(shm3+LDS_ORD+128+(idx>>5)*4), qb=NQB-1-(int)(idx&31u);
    attn_unit<THRL>(bh/NHEAD,bh%NHEAD,qb,T.Q,T.K,T.V,T.O,T.G+(size_t)bh*SEQ,T.kmax[bh],lds);
  }
}
#undef SBAR
#undef WAIT_BAR
}

#define LAS __attribute__((address_space(3)))
typedef unsigned short bf16;
typedef unsigned v4u __attribute__((ext_vector_type(4)));
typedef float f32x4 __attribute__((ext_vector_type(4)));
typedef short bf16x8 __attribute__((ext_vector_type(8)));
typedef float f2v __attribute__((ext_vector_type(2)));
__device__ __forceinline__ f2v mk2(float a, float b) { f2v r; r.x = a; r.y = b; return r; }

constexpr int M = 16384, D = 1024, FF = 4096, SEQ = 8192, NPH = 25;
constexpr int TCH = 32, NCHUNK = M / TCH  , KUX = 640  ;
constexpr size_t MiB = 1u << 20;
constexpr size_t OFF_CTL = 0, OFF_BAR = 4096, ZERO_BYTES = 32768;
constexpr int LDS_MISC = 147456 - 64;
constexpr size_t OFF_LOGF = 1 * MiB, OFF_G = 2 * MiB, OFF_KMAX = 3 * MiB, OFF_WF = 3 * MiB + 4096;
constexpr size_t OFF_LAMPOW = 4 * MiB, OFF_BBAR = 4 * MiB + 1310720, OFF_KTAB = 6 * MiB;
constexpr size_t OFF_SS = OFF_KTAB;
constexpr size_t OFF_W1 = 8 * MiB, OFF_W2 = 16 * MiB, OFF_MIX = 24 * MiB, OFF_HB = 32 * MiB;
constexpr size_t OFF_K = 64 * MiB, OFF_V = 96 * MiB;
constexpr size_t OFF_A2 = 64 * MiB, OFF_WEND = 104 * MiB;
constexpr size_t OFF_A = 128 * MiB;
constexpr size_t OFF_UX = 128 * MiB, OFF_SL = 168 * MiB, OFF_Z = 192 * MiB, OFF_QO = 128 * MiB;
constexpr size_t WS_END = 256 * MiB;
constexpr int LDS_BYTES = 147456;

struct Params { const float* in[20]; float* out; unsigned char* ws; int ph_lo, ph_hi; };
enum { I_X = 0, I_MIXN, I_MLPN, I_W1, I_W2, I_LOGDT, I_ARE, I_AIM, I_BRE, I_BIM, I_CRE, I_CIM, I_DSK, I_WGLU, I_KVN, I_WKVF, I_BF, I_WQ, I_WO, I_FINN };

struct Frame { LAS unsigned char* lds; int tid, lane, wave, G; };
typedef const float* cfp_t;
__device__ __forceinline__ cfp_t kin(int i) { asm volatile("" : "+s"(i)); const __attribute__((address_space(4))) cfp_t* k = (const __attribute__((address_space(4))) cfp_t*)__builtin_amdgcn_kernarg_segment_ptr(); return k[i]; }
static_assert(offsetof(Params, in) == 0, "kin() reads Params::in at kernarg offset 0");

__device__ __forceinline__ float wave_sum(float v) {
#pragma unroll
    for (int o = 1; o < 64; o <<= 1) v += __shfl_xor(v, o);
    return v;
}
__device__ __forceinline__ unsigned pk2(float lo, float hi) { return pg8::cvt_pk_bf16(lo, hi); }
__device__ __forceinline__ float bf2f(unsigned short b) { return __uint_as_float(((unsigned)b) << 16); }

template <int MODE> __device__ __forceinline__ void conv_w(const Frame& F, const float* W, int K, int srcN, int n0, int ncols, bf16* WT, const float* gk, int b0 = 0) {
    constexpr int SP = 33;
    LAS float* scr = (LAS float*)(F.lds + F.wave * (64 * SP * 4));
    if (b0 > 0 && (int)blockIdx.x < b0) return;
    const int gw = ((int)blockIdx.x - b0) * 8 + F.wave, NGW = (F.G - b0) * 8, lane = F.lane;
    const int nblk = ncols / 32, nitems = (K / 64) * nblk;
    for (int it = gw; it < nitems; it += NGW) {
        const int kb = it / nblk, nb = it % nblk, k0 = 64 * kb, nn0 = 32 * nb;
        const float* src = W + (size_t)(k0 + (lane >> 3)) * srcN + n0 + nn0 + (lane & 7) * 4;
        f32x4 w[8];
#pragma unroll
        for (int i = 0; i < 8; ++i) w[i] = __builtin_nontemporal_load((const f32x4*)(src + (size_t)(8 * i) * srcN));
#pragma unroll
        for (int i = 0; i < 8; ++i) { const int kk = 8 * i + (lane >> 3); const float g = gk ? gk[k0 + kk] : 1.f; LAS float* d = scr + kk * SP + (lane & 7) * 4;
            d[0] = w[i][0] * g; d[1] = w[i][1] * g; d[2] = w[i][2] * g; d[3] = w[i][3] * g; }
        asm volatile("s_waitcnt lgkmcnt(0)" ::: "memory");
        const int c = lane & 7;
#pragma unroll
        for (int j = 0; j < 4; ++j) { const int n = (lane >> 3) + 8 * j; const LAS float* s = scr + (8 * c) * SP + n;
            v4u o; o.x = pk2(s[0 * SP], s[1 * SP]); o.y = pk2(s[2 * SP], s[3 * SP]); o.z = pk2(s[4 * SP], s[5 * SP]); o.w = pk2(s[6 * SP], s[7 * SP]);
            const int nn = nn0 + n; const int row = (MODE == 1) ? (((nn & 1023) >> 7) * 256 + ((nn >> 10) & 1) * 128 + (nn & 127)) : nn;
            *(v4u*)(WT + (size_t)row * K + k0 + 8 * c) = o; }
        asm volatile("s_waitcnt lgkmcnt(0)" ::: "memory");
    }
}
__device__ __forceinline__ void conv_wf(const Frame& F, const float* wkvf, const float* kvn, bf16* WF) {
    for (int e = blockIdx.x * 512 + F.tid; e < 16 * 1024; e += F.G * 512) { const int j = e >> 10, k = e & 1023; const float w = wkvf[(size_t)k * 2064 + 2048 + j] * kvn[k];
        unsigned u = __float_as_uint(w); u = (u + 0x7fffu + ((u >> 16) & 1u)) >> 16; WF[e] = (bf16)u; }
}

__device__ __forceinline__ double dconst(double c) { asm volatile("" : "+s"(c)); return c; }
__device__ __forceinline__ double exp_d(double x) {
    const double n = rint(x * dconst(1.4426950408889634074)); const double r = (x - n * dconst(6.93147180369123816490e-01)) - n * dconst(1.90821492927058770002e-10);
    double s = 1.0, t = 1.0;
#pragma unroll 1
    for (int k = 1; k <= 16; ++k) { t *= r / (double)k; s += t; }
    const long long bits = ((long long)((int)n + 1023)) << 52; return s * __longlong_as_double(bits);
}
__device__ __forceinline__ void sincos_d(double x, double& s, double& c) {
    const double q = rint(x * dconst(0.63661977236758134308)); const int qi = (int)q;
    double r = x - q * dconst(1.57079632679489655800e+00); r -= q * dconst(6.12323399573676603587e-17);
    const double r2 = r * r;
    double sr = r, cr = 1.0, ts = r, tc = 1.0;
#pragma unroll 1
    for (int n = 1; n <= 10; ++n) { ts *= -r2 / (double)((2 * n) * (2 * n + 1)); sr += ts; tc *= -r2 / (double)((2 * n - 1) * (2 * n)); cr += tc; }
    switch (qi & 3) { case 0: s = sr; c = cr; break; case 1: s = cr; c = -sr; break; case 2: s = -sr; c = -cr; break; default: s = -cr; c = sr; break; }
}
__device__ __forceinline__ void s5_tables(const Frame& F, const Params& P, int L) {
    f2v* lampow = (f2v*)(P.ws + OFF_LAMPOW); f2v* Bbar = (f2v*)(P.ws + OFF_BBAR); float* Ktab = (float*)(P.ws + OFF_KTAB);
    LAS f2v* lp = (LAS f2v*)(F.lds);
    LAS f2v* bb = lp + 64 * 33;
    LAS f2v* cc = bb + 64 * 16;
    LAS f2v* cf = cc + 16 * 64;
    for (int item = blockIdx.x; item < 256; item += F.G) { const int g = item >> 2, qt = item & 3;
        if (F.tid < 64) { const int p = F.tid; const double dt = exp_d((double)kin(I_LOGDT)[L * 64 + g]);
            const double ar = (double)kin(I_ARE)[(L * 64 + g) * 64 + p], ai = (double)kin(I_AIM)[(L * 64 + g) * 64 + p];
            const double mag = exp_d(ar * dt); double sn, cs; sincos_d(ai * dt, sn, cs); const double lr = mag * cs, li = mag * sn;
            double pr = 1.0, pi = 0.0;
            for (int tau = 0; tau <= 32; ++tau) { const f2v v = mk2((float)pr, (float)pi); lp[p * 33 + tau] = v; if (qt == 0) lampow[(size_t)(g * 64 + p) * 33 + tau] = v; const double nr = pr * lr - pi * li, ni = pr * li + pi * lr; pr = nr; pi = ni; }
            const double nr = lr - 1.0, ni = li, den = ar * ar + ai * ai; cf[p] = mk2((float)((nr * ar + ni * ai) / den), (float)((ni * ar - nr * ai) / den)); }
        __syncthreads();
        { const float* bre_ = kin(I_BRE) + (size_t)((L * 64 + g) * 64) * 16; const float* bim_ = kin(I_BIM) + (size_t)((L * 64 + g) * 64) * 16; const float* cre_ = kin(I_CRE) + (size_t)(L * 64 + g) * 1024; const float* cim_ = kin(I_CIM) + (size_t)(L * 64 + g) * 1024;
          for (int e = F.tid; e < 1024; e += 512) { const int p = e >> 4; const float br = bre_[e], bi = bim_[e]; const f2v c = cf[p];
            const f2v v = mk2(c.x * br - c.y * bi, c.x * bi + c.y * br); bb[e] = v; if (qt == 0) Bbar[(size_t)g * 1024 + e] = v;
            cc[e] = mk2(cre_[e], cim_[e]); } }
        __syncthreads();
        { const float* dsk_ = kin(I_DSK) + L * 1024 + 16 * g;
          for (int e = qt * 2048 + F.tid; e < (qt + 1) * 2048; e += 512) { const int tau = e >> 8, cp = (e >> 4) & 15, c = e & 15; float acc = 0.f;
            for (int p = 0; p < 64; ++p) { const f2v C = cc[cp * 64 + p], l = lp[p * 33 + tau], B = bb[p * 16 + c]; const float tr = C.x * l.x - C.y * l.y, ti = C.x * l.y + C.y * l.x; acc += tr * B.x - ti * B.y; }
            if (tau == 0 && cp == c) acc += dsk_[c];
            Ktab[(size_t)g * 8192 + e] = acc; } }
        __syncthreads();
    }
}
__device__ __forceinline__ void s5_expand(const Frame& F, const Params& P, int L) {
    const f2v* lampow = (const f2v*)(P.ws + OFF_LAMPOW); const f2v* Bbar = (const f2v*)(P.ws + OFF_BBAR); const float* Ktab = (const float*)(P.ws + OFF_KTAB);
    bf16* A2 = (bf16*)(P.ws + OFF_A2); bf16* Wend = (bf16*)(P.ws + OFF_WEND);
    const int gt = blockIdx.x * 512 + F.tid, GT = F.G * 512;
    const float* cre_ = kin(I_CRE) + (size_t)L * 65536; const float* cim_ = kin(I_CIM) + (size_t)L * 65536;
#pragma unroll 4
    for (int ch = gt; ch < 32768 * 64; ch += GT) { const int row = ch >> 6, c8 = (ch & 63) * 8, g = row >> 9, tc = row & 511, t = tc >> 4, cp = tc & 15, s = c8 >> 4, c0 = c8 & 15;
        const int lag = (t - s) < 0 ? 0 : (t - s); const float* kp = Ktab + ((size_t)(g * 32 + lag) * 256 + cp * 16 + c0); f32x4 a = *(const f32x4*)kp, b = *(const f32x4*)(kp + 4);
        if (s > t) { a = (f32x4){0.f, 0.f, 0.f, 0.f}; b = a; }
        v4u o; o.x = pk2(a[0], a[1]); o.y = pk2(a[2], a[3]); o.z = pk2(b[0], b[1]); o.w = pk2(b[2], b[3]);
        *(v4u*)(A2 + (size_t)row * KUX + c8) = o; }
#pragma unroll 2
    for (int ch = gt; ch < 32768 * 16; ch += GT) { const int row = ch >> 4, j = (ch & 15) * 8, g = row >> 9, tc = row & 511, t = tc >> 4, cp = tc & 15, im = j >> 6, p0 = j & 63; float v[8];
        const size_t ci = (size_t)(g * 16 + cp) * 64 + p0; const f32x4 cr0 = *(const f32x4*)(cre_ + ci), cr1 = *(const f32x4*)(cre_ + ci + 4), ci0 = *(const f32x4*)(cim_ + ci), ci1 = *(const f32x4*)(cim_ + ci + 4);
#pragma unroll
        for (int e = 0; e < 8; ++e) { const float cr = e < 4 ? cr0[e & 3] : cr1[e & 3], cim = e < 4 ? ci0[e & 3] : ci1[e & 3]; const f2v l = lampow[(size_t)(g * 64 + p0 + e) * 33 + t + 1];
            v[e] = im ? -(cr * l.y + cim * l.x) : (cr * l.x - cim * l.y); }
        v4u o; o.x = pk2(v[0], v[1]); o.y = pk2(v[2], v[3]); o.z = pk2(v[4], v[5]); o.w = pk2(v[6], v[7]);
        *(v4u*)(A2 + (size_t)row * KUX + 512 + j) = o; }
#pragma unroll 2
    for (int ch = gt; ch < 16384 * 64; ch += GT) { const int row = ch >> 6, c8 = (ch & 63) * 8, g = row >> 8, rho = row & 255, s = c8 >> 4, c0 = c8 & 15, p = rho & 63, im = (rho >> 6) & 1; float v[8];
        const f2v l = lampow[(size_t)(g * 64 + p) * 33 + 31 - s]; const f2v* Bp = Bbar + (size_t)(g * 64 + p) * 16 + c0;
#pragma unroll
        for (int e = 0; e < 8; ++e) { const f2v B = Bp[e]; const float x = im ? (l.x * B.y + l.y * B.x) : (l.x * B.x - l.y * B.y); v[e] = (rho < 128) ? x : 0.f; }
        v4u o; o.x = pk2(v[0], v[1]); o.y = pk2(v[2], v[3]); o.z = pk2(v[4], v[5]); o.w = pk2(v[6], v[7]);
        *(v4u*)(Wend + (size_t)row * 512 + c8) = o; }
}
template <bool BF> __device__ __forceinline__ void phase_normu(const Frame& F, const void* hin, const float* gw, bf16* UX) {
    constexpr int PITCH = 1032;
    LAS bf16* tile = (LAS bf16*)F.lds;
    for (int n = blockIdx.x; n < NCHUNK; n += F.G) {
        f32x4 v[4][4]; float ss[4];
#pragma unroll
        for (int q = 0; q < 4; ++q) { const size_t ro = (size_t)(TCH * n + F.wave * 4 + q) * D;
            if (BF) { const v4u* xr = (const v4u*)((const bf16*)hin + ro) + 2 * F.lane; const v4u a = xr[0], b = xr[1];
                v[q][0] = (f32x4){pg8::bflo(a.x), pg8::bfhi(a.x), pg8::bflo(a.y), pg8::bfhi(a.y)}; v[q][1] = (f32x4){pg8::bflo(a.z), pg8::bfhi(a.z), pg8::bflo(a.w), pg8::bfhi(a.w)};
                v[q][2] = (f32x4){pg8::bflo(b.x), pg8::bfhi(b.x), pg8::bflo(b.y), pg8::bfhi(b.y)}; v[q][3] = (f32x4){pg8::bflo(b.z), pg8::bfhi(b.z), pg8::bflo(b.w), pg8::bfhi(b.w)}; }
            else { const f32x4* xr = (const f32x4*)((const float*)hin + ro) + F.lane;
#pragma unroll
                for (int j = 0; j < 4; ++j) v[q][j] = xr[64 * j]; } }
#pragma unroll
        for (int q = 0; q < 4; ++q) { float s = 0.f;
#pragma unroll
            for (int j = 0; j < 4; ++j) s += (v[q][j][0] * v[q][j][0] + v[q][j][1] * v[q][j][1]) + (v[q][j][2] * v[q][j][2] + v[q][j][3] * v[q][j][3]);
            ss[q] = pg8::rstd_of(wave_sum(s)); }
#pragma unroll
        for (int j = 0; j < 4; ++j) { const int e0 = BF ? (16 * F.lane + 4 * j) : (4 * (F.lane + 64 * j)); const f32x4 g4 = *(const f32x4*)(gw + e0);
#pragma unroll
            for (int q = 0; q < 4; ++q) { const f32x4 u = v[q][j] * ss[q] * g4; LAS unsigned* dst = (LAS unsigned*)(tile + (F.wave * 4 + q) * PITCH + e0); dst[0] = pk2(u[0], u[1]); dst[1] = pk2(u[2], u[3]); } }
        __syncthreads();
#pragma unroll 1
        for (int pass = 0; pass < 8; ++pass) { const int g = pass * 8 + (F.tid >> 6), s = (F.tid & 63) >> 1, half = F.tid & 1;
            const v4u val = *(const LAS v4u*)(tile + s * PITCH + 16 * g + 8 * half);
            *(v4u*)(UX + (size_t)(g * NCHUNK + n) * KUX + s * 16 + 8 * half) = val; }
        __syncthreads();
    }
}
__device__ __forceinline__ void phase_scan(const Frame& F, const Params& P) {
    const f2v* lampow = (const f2v*)(P.ws + OFF_LAMPOW); const float* Sl = (const float*)(P.ws + OFF_SL); bf16* UX = (bf16*)(P.ws + OFF_UX);
    for (int bg = F.wave * F.G + blockIdx.x; bg < 128; bg += 8 * F.G) { const int b = bg >> 6, g = bg & 63, p = F.lane;
        const f2v lt = lampow[(size_t)(g * 64 + p) * 33 + 32]; float xr = 0.f, xi = 0.f;
        const float* sl = Sl + (size_t)(g * NCHUNK + b * 256) * 128 + p; bf16* ux = UX + (size_t)(g * NCHUNK + b * 256) * KUX + 512 + p;
#pragma unroll 1
        for (int k0 = 0; k0 < 256; k0 += 8) { float sr[8], si[8];
#pragma unroll
            for (int j = 0; j < 8; ++j) { sr[j] = sl[(size_t)(k0 + j) * 128]; si[j] = sl[(size_t)(k0 + j) * 128 + 64]; }
#pragma unroll
            for (int j = 0; j < 8; ++j) { const unsigned w = pk2(xr, xi); ux[(size_t)(k0 + j) * KUX] = (bf16)(w & 0xffffu); ux[(size_t)(k0 + j) * KUX + 64] = (bf16)(w >> 16);
                const float nr = lt.x * xr - lt.y * xi + sr[j], ni = lt.x * xi + lt.y * xr + si[j]; xr = nr; xi = ni; } }
    }
}
__device__ __forceinline__ void phase_flogit(const Frame& F, const Params& P, const float* ss) {
    const bf16* hb = (const bf16*)(P.ws + OFF_HB); const bf16* WF = (const bf16*)(P.ws + OFF_WF); float* logf = (float*)(P.ws + OFF_LOGF);
    const int r = F.lane & 15, kq = F.lane >> 4; const float* bf_ = kin(I_BF);
    for (int task = blockIdx.x * 8 + F.wave; task < M / 16; task += F.G * 8) { const int row = task * 16 + r; f32x4 acc = {0.f, 0.f, 0.f, 0.f};
        const bf16* ap = hb + (size_t)row * D + kq * 8; const bf16* bp = WF + (size_t)r * D + kq * 8;
#pragma unroll 8
        for (int ks = 0; ks < 32; ++ks) { const bf16x8 a = *(const bf16x8*)(ap + ks * 32), b = *(const bf16x8*)(bp + ks * 32); acc = __builtin_amdgcn_mfma_f32_16x16x32_bf16(b, a, acc, 0, 0, 0); }
        const float rs = pg8::rstd_slots(ss, row, 16, kq); f32x4 o;
#pragma unroll
        for (int i = 0; i < 4; ++i) { const float x = acc[i] * rs + bf_[4 * kq + i]; o[i] = fminf(x, 0.f) - 0.6931471805599453f * __builtin_amdgcn_logf(1.0f + __builtin_amdgcn_exp2f(-1.4426950408889634f * fabsf(x))); }
        *(f32x4*)(logf + (size_t)row * 16 + 4 * kq) = o; }
}
__device__ __forceinline__ void phase_fscan(const Frame& F, const Params& P) {
    const float* logf = (const float*)(P.ws + OFF_LOGF); float* Gt = (float*)(P.ws + OFF_G); float* kmax = (float*)(P.ws + OFF_KMAX); const bf16* Kb = (const bf16*)(P.ws + OFF_K);
    LAS float* wsum = (LAS float*)F.lds; LAS float* wmax = wsum + 8;
    for (int bh = blockIdx.x; bh < 32; bh += F.G) { const int b = bh >> 4, h = bh & 15, t0 = F.tid * 16; float v[16]; float s = 0.f;
#pragma unroll
        for (int i = 0; i < 16; ++i) { v[i] = -1.4426950408889634f * logf[(size_t)(b * SEQ + t0 + i) * 16 + h]; s += v[i]; }
        float incl = s;
#pragma unroll
        for (int o = 1; o < 64; o <<= 1) { const float t = __shfl_up(incl, o); if (F.lane >= o) incl += t; }
        float km = 0.f;
#pragma unroll 4
        for (int i = 0; i < 16; ++i) { const bf16* kp = Kb + (size_t)(b * SEQ + t0 + i) * D + 64 * h; float q = 0.f;
#pragma unroll
            for (int c = 0; c < 8; ++c) { const bf16x8 kv = *(const bf16x8*)(kp + 8 * c);
#pragma unroll
                for (int e = 0; e < 8; ++e) { const float f = bf2f((unsigned short)kv[e]); q += f * f; } }
            km = fmaxf(km, q); }
#pragma unroll
        for (int o = 1; o < 64; o <<= 1) km = fmaxf(km, __shfl_xor(km, o));
        if (F.lane == 63) wsum[F.wave] = incl;
        if (F.lane == 0) wmax[F.wave] = km;
        __syncthreads();
        float base = 0.f, kmx = 0.f;
#pragma unroll
        for (int w = 0; w < 8; ++w) { if (w < F.wave) base += wsum[w]; kmx = fmaxf(kmx, wmax[w]); }
        float run = base + incl - s;
#pragma unroll
        for (int i = 0; i < 16; ++i) { run += v[i]; v[i] = run; }
#pragma unroll
        for (int i = 0; i < 4; ++i) *(f32x4*)(Gt + (size_t)bh * SEQ + t0 + 4 * i) = (f32x4){v[4 * i], v[4 * i + 1], v[4 * i + 2], v[4 * i + 3]};
        if (F.tid == 0) kmax[bh] = sqrtf(kmx);
        __syncthreads();
    }
}
__device__ __forceinline__ void phase_final(const Frame& F, const bf16* hb, float* out, const float* gw) {
    f32x4 g4[4];
#pragma unroll
    for (int j = 0; j < 4; ++j) g4[j] = *(const f32x4*)(gw + 16 * F.lane + 4 * j);
    const int stride = F.G * 8;
    for (int m0 = blockIdx.x * 8 + F.wave; m0 < M; m0 += 2 * stride) { v4u a[2], b[2];
#pragma unroll
        for (int r = 0; r < 2; ++r) { const int m = (m0 + r * stride < M) ? m0 + r * stride : m0; const v4u* xr = (const v4u*)(hb + (size_t)m * D) + 2 * F.lane; a[r] = xr[0]; b[r] = xr[1]; }
#pragma unroll
        for (int r = 0; r < 2; ++r) { const int m = m0 + r * stride; if (m >= M) break; f32x4 v[4];
            v[0] = (f32x4){pg8::bflo(a[r].x), pg8::bfhi(a[r].x), pg8::bflo(a[r].y), pg8::bfhi(a[r].y)}; v[1] = (f32x4){pg8::bflo(a[r].z), pg8::bfhi(a[r].z), pg8::bflo(a[r].w), pg8::bfhi(a[r].w)};
            v[2] = (f32x4){pg8::bflo(b[r].x), pg8::bfhi(b[r].x), pg8::bflo(b[r].y), pg8::bfhi(b[r].y)}; v[3] = (f32x4){pg8::bflo(b[r].z), pg8::bfhi(b[r].z), pg8::bflo(b[r].w), pg8::bfhi(b[r].w)};
            float ss = 0.f;
#pragma unroll
            for (int j = 0; j < 4; ++j) ss += (v[j][0] * v[j][0] + v[j][1] * v[j][1]) + (v[j][2] * v[j][2] + v[j][3] * v[j][3]);
            const float rstd = pg8::rstd_of(wave_sum(ss)); f32x4* o = (f32x4*)(out + (size_t)m * D + 16 * F.lane);
#pragma unroll
            for (int j = 0; j < 4; ++j) o[j] = v[j] * rstd * g4[j]; } }
}

__device__ __forceinline__ void conv_w1(const Frame& F, const Params& P, int L, int b0 = 0) { conv_w<0>(F, kin(I_W1) + (size_t)L * D * FF, D, FF, 0, FF, (bf16*)(P.ws + OFF_W1), kin(I_MLPN) + L * D, b0); }
__device__ __forceinline__ void conv_w2(const Frame& F, const Params& P, int L, int b0 = 0) { conv_w<0>(F, kin(I_W2) + (size_t)L * FF * D, FF, D, 0, D, (bf16*)(P.ws + OFF_W2), nullptr, b0); }
__device__ __forceinline__ void conv_glu(const Frame& F, const Params& P, int L) { conv_w<1>(F, kin(I_WGLU) + (size_t)L * D * 2 * D, D, 2 * D, 0, 2 * D, (bf16*)(P.ws + OFF_MIX), nullptr); }
__device__ __forceinline__ void conv_attn(const Frame& F, const Params& P, int j, bool with_kv) {
    bf16* mix = (bf16*)(P.ws + OFF_MIX);
    conv_w<0>(F, kin(I_WQ) + (size_t)j * D * D, D, D, 0, D, mix, kin(I_MIXN) + (2 + j) * D);
    conv_w<0>(F, kin(I_WO) + (size_t)j * D * D, D, D, 0, D, mix + (size_t)3 * D * D, nullptr);
    if (with_kv) { conv_w<0>(F, kin(I_WKVF), D, 2064, 0, 2 * D, mix + (size_t)D * D, kin(I_KVN)); conv_wf(F, kin(I_WKVF), kin(I_KVN), (bf16*)(P.ws + OFF_WF)); }
}
__device__ __forceinline__ bool side_jobs(const Frame& F, const Params& P, int ph) {
    switch (ph) {
    case 0:  s5_tables(F, P, 0); conv_glu(F, P, 0); return true;
    case 2:  { const int b0 = (F.G > 128) ? 128 : 0; conv_w1(F, P, 0, b0); conv_w2(F, P, 0, b0); } return true;
    case 5:  conv_glu(F, P, 1); return true;
    case 6:  s5_tables(F, P, 1); return true;
    case 8:  { const int b0 = (F.G > 128) ? 128 : 0; conv_w1(F, P, 1, b0); conv_w2(F, P, 1, b0); } return true;
    case 11: conv_attn(F, P, 0, true); return true;
    case 14: { const int b0 = (F.G > 32) ? 32 : 0; conv_w1(F, P, 2, b0); conv_w2(F, P, 2, b0); } return true;
    case 17: conv_attn(F, P, 1, false); return true;
    case 18: conv_w1(F, P, 3); return true;
    case 19: conv_w2(F, P, 3); return true;
    default: return false;
    }
}

#define XB_TMO      128
#define XB_XCNT(j)  (256  + 64 * (j))
#define XB_XSUB(j)  (1280 + 64 * (j))
#define XB_XGEN(j)  (2304 + 64 * (j))
#define XB_TOP      3328
#define XB_TOPGEN   3392
#define XCD_BAR_WORDS 3456
#define XB_SPIN_CAP (1u << 18)

__device__ __forceinline__ unsigned xb_ld(unsigned* p)              { return __hip_atomic_load(p, __ATOMIC_RELAXED, __HIP_MEMORY_SCOPE_AGENT); }
__device__ __forceinline__ unsigned xb_add(unsigned* p, unsigned v) { return __hip_atomic_fetch_add(p, v, __ATOMIC_RELAXED, __HIP_MEMORY_SCOPE_AGENT); }
__device__ __forceinline__ unsigned xb_xcc_id() { return (unsigned)__builtin_amdgcn_s_getreg((3 << 11) | 20) & 0xFu; }
#define XB_SPIN(cond, bar) do { unsigned _sp = 0; while (cond) { __builtin_amdgcn_s_sleep(1); \
    if ((++_sp & 255u) == 0u) { if (xb_ld(&(bar)[XB_TMO])) break; if (_sp > XB_SPIN_CAP) { atomicAdd(&(bar)[XB_TMO], 1u); break; } } } } while (0)

struct XcdBarrier {
    unsigned* bar; unsigned x;
    volatile LAS unsigned* st;
};

__device__ __forceinline__ XcdBarrier xcd_barrier_post(unsigned* bar, volatile LAS unsigned* st) {
    XcdBarrier b; b.bar = bar; b.x = xb_xcc_id(); b.st = st;
    if (threadIdx.x == 0) (void)xb_add(&bar[XB_XCNT(b.x)], 1u);
    return b;
}
__device__ __forceinline__ void xcd_barrier_complete(unsigned* bar, unsigned x, unsigned& nloc, unsigned& nx) {
    const unsigned G = gridDim.x * gridDim.y * gridDim.z;
    unsigned sum, cnt, mine, sp = 0u;
    for (;;) {
        sum = 0u; cnt = 0u; mine = 0u;
#pragma unroll
        for (unsigned j = 0; j < 16; ++j) { const unsigned c = xb_ld(&bar[XB_XCNT(j)]); sum += c; cnt += (c > 0u) ? 1u : 0u; mine = (j == x) ? c : mine; }
        if (sum == G) break;
        __builtin_amdgcn_s_sleep(1);
        if ((++sp & 255u) == 0u) { if (xb_ld(&bar[XB_TMO])) break; if (sp > XB_SPIN_CAP) { atomicAdd(&bar[XB_TMO], 1u); break; } }
    }
    nloc = mine > 0u ? mine : 1u; nx = cnt > 0u ? cnt : 1u;
}

__device__ __forceinline__ void xcd_barrier(const XcdBarrier& b) {
    asm volatile("s_waitcnt vmcnt(0)" ::: "memory");
    __syncthreads();
    if (ltid() == 0) {
        unsigned* bar = b.bar;
        __builtin_amdgcn_s_waitcnt(0);
        unsigned nloc = b.st[0], nx = b.st[1];
        if (nloc == 0u) { xcd_barrier_complete(bar, b.x, nloc, nx); b.st[0] = nloc; b.st[1] = nx; }
        const unsigned old = xb_add(&bar[XB_XSUB(b.x)], 1u);
        const unsigned gen = old / nloc;
        if (old + 1u == (gen + 1u) * nloc) {
            __builtin_amdgcn_fence(__ATOMIC_RELEASE, "agent");
            asm volatile("s_waitcnt vmcnt(0)" ::: "memory");
            const unsigned og = xb_add(&bar[XB_TOP], 1u);
            const unsigned tg = og / nx;
            if (og + 1u == (tg + 1u) * nx) xb_add(&bar[XB_TOPGEN], 1u);
            else XB_SPIN(xb_ld(&bar[XB_TOPGEN]) == tg, bar);
            __builtin_amdgcn_fence(__ATOMIC_ACQUIRE, "agent");
            xb_add(&bar[XB_XGEN(b.x)], 1u);
            asm volatile("s_waitcnt vmcnt(0)" ::: "memory");
        } else {
            XB_SPIN(xb_ld(&bar[XB_XGEN(b.x)]) == gen, bar);
            __builtin_amdgcn_fence(__ATOMIC_ACQUIRE, "agent");
            asm volatile("s_waitcnt vmcnt(0)" ::: "memory");
        }
    }
    __syncthreads();
}

constexpr int LDS_RSTD = 131072 + 1024;
template <class Sched> __device__ __forceinline__ void precompute_rstd(const Frame& F, const Sched& S, const float* ss, int ns) {
    LAS float* rb = (LAS float*)(F.lds + LDS_RSTD); pg8::Unit u;
    for (int i = 0; i < 8 && S.next(i, u); ++i) { const int row = F.tid >> 1, half = F.tid & 1; const f32x4* p = (const f32x4*)(ss + (size_t)(u.pm * 256 + row) * ns + half * (ns >> 1));
        f32x4 v = p[0]; float s = (v[0] + v[1]) + (v[2] + v[3]); v = p[1]; s += (v[0] + v[1]) + (v[2] + v[3]);
        if (ns == 32) { v = p[2]; s += (v[0] + v[1]) + (v[2] + v[3]); v = p[3]; s += (v[0] + v[1]) + (v[2] + v[3]); }
        s += __shfl_xor(s, 1); if (!half) rb[i * 256 + row] = pg8::rstd_of(s); }
    __syncthreads();
}

__global__ void __launch_bounds__(512, 2) trunk_fwd(Params P) {
    extern __shared__ __attribute__((aligned(16))) unsigned char lds[];
    Frame F; F.lds = (LAS unsigned char*)lds; F.G = gridDim.x;
    volatile LAS unsigned* bst = (volatile LAS unsigned*)((LAS unsigned char*)lds + LDS_MISC);
    if (threadIdx.x < 2) bst[threadIdx.x] = 0u;
    __syncthreads();
    const bool one_launch = (P.ph_hi - P.ph_lo) > 1;
    XcdBarrier bar; bar.bar = (unsigned*)(P.ws + OFF_BAR); bar.x = 0; bar.st = bst;
    if (one_launch) bar = xcd_barrier_post((unsigned*)(P.ws + OFF_BAR), bst);
    unsigned char* ws = P.ws;
    float* ssp = (float*)(ws + OFF_SS);
    bf16* HB = (bf16*)(ws + OFF_HB);
    bool dup_done = false;
    for (int ph = P.ph_lo; ph < P.ph_hi; ++ph) {
        F.tid = ltid(); F.lane = F.tid & 63; F.wave = __builtin_amdgcn_readfirstlane(F.tid >> 6); { int g_ = (int)gridDim.x; asm volatile("" : "+s"(g_)); F.G = g_; }
        int kind, L;
        if (ph == 0) { kind = 0; L = 0; }
        else if (ph <= 12) { L = (ph - 1) / 6; const int k = (ph - 1) % 6; kind = (k < 2) ? 1 + k : 2 + k; }
        else if (ph <= 18) { L = 2; const int k = ph - 13; kind = (k < 4) ? 8 + k : 2 + k; }
        else if (ph <= 23) { L = 3; const int k = ph - 19; kind = (k == 0) ? 8 : (k <= 2 ? 9 + k : 3 + k); }
        else { kind = 12; L = 3; }
        if (DBG_SIDE_REPS > 1 && !dup_done) { side_jobs(F, P, ph); asm volatile("s_waitcnt vmcnt(0) lgkmcnt(0)" ::: "memory"); __syncthreads(); }
        if (((DBG_KM >> 0) & 1) && !dup_done && side_jobs(F, P, ph)) { asm volatile("s_waitcnt vmcnt(0) lgkmcnt(0)" ::: "memory"); __syncthreads(); }
        switch (kind) {
        case 1: if constexpr ((DBG_KM >> 1) & 1) { s5_expand(F, P, L); if (L == 0) phase_normu<false>(F, kin(I_X), kin(I_MIXN), (bf16*)(ws + OFF_UX)); else phase_normu<true>(F, HB, kin(I_MIXN) + L * D, (bf16*)(ws + OFF_UX)); } break;
        case 2: if constexpr ((DBG_KM >> 2) & 1) { pg8::Gemm g{(const bf16*)(ws + OFF_UX), (const bf16*)(ws + OFF_WEND), KUX, 512, 512}; pg8::OrderSloc S{F.G, (int)blockIdx.x};
                  pg8::EpiSlocScan E{(const pg8::f2v_t*)(ws + OFF_LAMPOW), (bf16*)(ws + OFF_UX)};
                  pg8::gemm_phase<pg8::EpiSlocScan, pg8::OrderSloc, true, true>(F.lds, g, S, E); } break;
        case 4: if constexpr ((DBG_KM >> 4) & 1) { pg8::Gemm g{(const bf16*)(ws + OFF_UX), (const bf16*)(ws + OFF_A2), KUX, KUX, KUX}; pg8::OrderY S{F.G, (int)blockIdx.x}; pg8::EpiY E{(bf16*)(ws + OFF_Z)};
                  pg8::gemm_phase<pg8::EpiY, pg8::OrderY, true, true>(F.lds, g, S, E); } break;
        case 5: if constexpr ((DBG_KM >> 5) & 1) { pg8::Gemm g{(const bf16*)(ws + OFF_Z), (const bf16*)(ws + OFF_MIX), 16, D, D, M * 32, 4 * M * 32, 16 * M * 32};      pg8::StaticOrder S; S.init(M, 2 * D, F.G, (int)blockIdx.x);
                  pg8::EpiRes<true> E{(L == 0) ? kin(I_X) : (const float*)nullptr, HB, ssp};
                  pg8::gemm_phase<pg8::EpiRes<true>, pg8::StaticOrder, true, true>(F.lds, g, S, E); } break;
        case 6: if constexpr ((DBG_KM >> 6) & 1) { const int ns = (L < 2) ? 32 : 16;
                  pg8::Gemm g{HB, (const bf16*)(ws + OFF_W1), D, D, D}; pg8::StaticOrder S; S.init(M, FF, F.G, (int)blockIdx.x); precompute_rstd(F, S, ssp, ns); pg8::EpiMLP1 E{(bf16*)(ws + OFF_A), (const LAS float*)(F.lds + LDS_RSTD)};
                  pg8::gemm_phase<pg8::EpiMLP1, pg8::StaticOrder, true, true>(F.lds, g, S, E); } break;
        case 7: case 11: if constexpr ((DBG_KM >> 7) & 1) { const bool mlp = (kind == 7); const bool need_ss = !(mlp && (L == 0 || L == 3));
                  pg8::Gemm g{mlp ? (const bf16*)(ws + OFF_A) : (const bf16*)(ws + OFF_Z), mlp ? (const bf16*)(ws + OFF_W2) : (const bf16*)(ws + OFF_MIX) + (size_t)3 * D * D, mlp ? 256 : D, mlp ? FF : D, mlp ? FF : D, 32, 128, mlp ? M * 512 : 512};
                  pg8::StaticOrder S; S.init(M, D, F.G, (int)blockIdx.x); pg8::EpiRes<false> E{(const float*)nullptr, HB, need_ss ? ssp : (float*)nullptr};
                  pg8::gemm_phase<pg8::EpiRes<false>, pg8::StaticOrder, true, true>(F.lds, g, S, E); } break;
        case 8: if constexpr ((DBG_KM >> 8) & 1) { const float* ss = ssp;
                  if (L == 2) phase_flogit(F, P, ss);
                  pg8::Gemm g{HB, (const bf16*)(ws + OFF_MIX), D, D, D}; pg8::StaticOrder S; S.init(M, (L == 2) ? 3 * D : D, F.G, (int)blockIdx.x);
                  static_assert(OFF_V == OFF_K + 32 * MiB && OFF_QO == OFF_K + 64 * MiB, "EpiQKV slot map"); precompute_rstd(F, S, ss, 16); pg8::EpiQKV E{(bf16*)(ws + OFF_K), (const LAS float*)(F.lds + LDS_RSTD), attn_body::C2};
                  pg8::gemm_phase<pg8::EpiQKV, pg8::StaticOrder, true, true>(F.lds, g, S, E); } break;
        case 9: if constexpr ((DBG_KM >> 9) & 1) { phase_fscan(F, P); } break;
        case 10: if constexpr ((DBG_KM >> 10) & 1) { const attn_body::AttnTensors AT{(const attn_body::bf16*)(ws + OFF_QO), (const attn_body::bf16*)(ws + OFF_K), (const attn_body::bf16*)(ws + OFF_V), (attn_body::bf16*)(ws + OFF_Z), (const float*)(ws + OFF_G), (const float*)(ws + OFF_KMAX)};
                  attn_body::attn_phase<32>((char*)lds, AT, (unsigned*)(ws + OFF_CTL) + 64 * (L - 2) + (dup_done ? 128 : 0)); } break;
        case 12: if constexpr ((DBG_KM >> 12) & 1) { phase_final(F, HB, P.out, kin(I_FINN)); } break;
        default: break;
        }
        if (DBG_DUP != 0u) { if (((DBG_DUP >> kind) & 1u) && !dup_done) { dup_done = true; --ph; xcd_barrier(bar); continue; } dup_done = false; }
        if (ph + 1 < P.ph_hi) {
            for (int r_ = 0; r_ < DBG_SYNC_REPS; ++r_) xcd_barrier(bar);
        }
        if (P.ph_hi < 0) cg::this_grid().sync();
    }
}

extern "C" void kernel_launch(void* const* d_in, const int* in_sizes, int n_in, void* d_out, int out_size, void* d_ws, size_t ws_size, hipStream_t stream) {
    static int grid = 0;
    if (grid == 0) {
        if (n_in != 20 || in_sizes[0] != M * D || out_size != M * D || ws_size < WS_END) { fprintf(stderr, "kernel_launch: unexpected shapes (n_in %d, in0 %d, out %d, ws %zu); nothing launched\n", n_in, n_in > 0 ? in_sizes[0] : -1, out_size, ws_size); grid = -1; return; }
        int dev = 0, cus = 0, per_cu = 0;
        if (hipGetDevice(&dev) != hipSuccess || hipDeviceGetAttribute(&cus, hipDeviceAttributeMultiprocessorCount, dev) != hipSuccess) { grid = -1; return; }
        if (hipFuncSetAttribute((const void*)trunk_fwd, hipFuncAttributeMaxDynamicSharedMemorySize, LDS_BYTES) != hipSuccess) { fprintf(stderr, "kernel_launch: hipFuncSetAttribute failed\n"); grid = -1; return; }
        if (hipOccupancyMaxActiveBlocksPerMultiprocessor(&per_cu, (const void*)trunk_fwd, 512, LDS_BYTES) != hipSuccess || per_cu < 1) { fprintf(stderr, "kernel_launch: occupancy query says %d\n", per_cu); per_cu = 1; }
        (void)hipGetLastError();
        grid = cus * per_cu;
    }
    if (grid < 0) return;
    (void)hipMemsetAsync((char*)d_ws + OFF_CTL, 0, ZERO_BYTES, stream);
    Params p{};
    for (int i = 0; i < 20; ++i) p.in[i] = (const float*)d_in[i];
    p.out = (float*)d_out; p.ws = (unsigned char*)d_ws;
#if MK_MULTI_LAUNCH
    for (int ph = 0; ph < NPH; ++ph) { p.ph_lo = ph; p.ph_hi = ph + 1; hipLaunchKernelGGL(trunk_fwd, dim3(grid), dim3(512), LDS_BYTES, stream, p); }
#else
    p.ph_lo = 0; p.ph_hi = NPH;
    void* args[] = {&p};
    const hipError_t e = hipLaunchCooperativeKernel((const void*)trunk_fwd, dim3(grid), dim3(512), args, LDS_BYTES, stream);
    if (e != hipSuccess) fprintf(stderr, "kernel_launch: cooperative launch failed: %s (grid %d)\n", hipGetErrorString(e), grid);
#endif
}
```

```cpp
#include <hip/hip_runtime.h>
#include <hip/hip_cooperative_groups.h>
#include <hip/hip_bf16.h>
#include <cstdio>
#include <cstdint>
#include <cmath>
namespace cg = cooperative_groups;
#ifndef MK_MULTI_LAUNCH
#define MK_MULTI_LAUNCH 0
#endif
__device__ __forceinline__ int ltid() { int t = (int)threadIdx.x; asm volatile("" : "+v"(t)); return t; }
#ifndef DBG_KM
#define DBG_KM 0xffffu
#endif
#ifndef DBG_SYNC_REPS
#define DBG_SYNC_REPS 1
#endif
#ifndef DBG_DUP
#define DBG_DUP 0u
#endif
#ifndef DBG_SIDE_REPS
#define DBG_SIDE_REPS 1
#endif
#ifndef DBG_PROBE
#define DBG_PROBE 0
#endif
namespace pg8 {
#define PG8_LAS __attribute__((address_space(3)))
typedef unsigned short bf16_t;
typedef short bf16x8 __attribute__((ext_vector_type(8)));
typedef float f32x4 __attribute__((ext_vector_type(4)));
typedef unsigned u32x4 __attribute__((ext_vector_type(4)));
constexpr int BM = 256, BK = 64, HALF = 128, HTB = HALF * BK * 2  , STAGE_BYTES = 8 * HTB, NXCD = 8, WGM = 8;

__host__ __device__ __forceinline__ int lds_byte(int r, int c) { const int st = (r >> 4) * 2 + (c >> 5), rr = r & 15, cc = c & 31, ob = rr * 64 + cc * 2; return st * 1024 + (ob ^ (((ob >> 9) & 1) << 5)); }
__host__ __device__ __forceinline__ void stage_rc(int b, int& R, int& C) { const int st = b / 1024, sb = b % 1024, swz = sb ^ (((sb >> 9) & 1) << 5); R = (st >> 1) * 16 + swz / 64; C = (st & 1) * 32 + (swz % 64) / 2; }
__host__ __device__ __forceinline__ int perm32(int rho) { const int n = rho >> 4, i = rho & 15; return 8 * (i >> 2) + 4 * n + (i & 3); }

struct Unit { int pm, pn; };
struct Gemm { const bf16_t* A; const bf16_t* Bt; int lda, ldb, K; int a_gs = 32, a_ks = 128, a_ts = 512; };

struct StaticOrder {
    int nM, nN, nwg, G, c;
    __host__ __device__ void init(int M, int N, int G_, int c_) { nM = M / BM; nN = N / BM; nwg = nM * nN; G = G_; c = c_; }
    __host__ __device__ bool next(int i, Unit& u) const {
        const long L = (long)i * G + c; if (L >= nwg) return false;
        int wgid = (int)L; { const int q = nwg / NXCD, r = nwg % NXCD, xcd = wgid % NXCD, off = wgid / NXCD; wgid = (xcd < r ? xcd * (q + 1) : r * (q + 1) + (xcd - r) * q) + off; }
        const int nig = WGM * nN, gid = wgid / nig, fm = gid * WGM, gsz = (nM - fm) < WGM ? (nM - fm) : WGM;
        u.pm = fm + ((wgid % nig) % gsz); u.pn = (wgid % nig) / gsz; return true;
    }
    __device__ __forceinline__ void a_ready(const Unit&) const {}
    __device__ __forceinline__ void done(const Unit&) const {}
};

typedef float cvt_f32x2_t __attribute__((ext_vector_type(2))); typedef __bf16 cvt_bf16x2_t __attribute__((ext_vector_type(2)));
__device__ __forceinline__ unsigned cvt_pk_bf16(float lo, float hi) { const cvt_f32x2_t v = {lo, hi}; const cvt_bf16x2_t b = __builtin_convertvector(v, cvt_bf16x2_t); return __builtin_bit_cast(unsigned, b); }
typedef float f32x2 __attribute__((ext_vector_type(2)));
__device__ __forceinline__ f32x2 gelu_pk(f32x2 v) {
    const f32x2 av = __builtin_elementwise_abs(v), d = av * 0.2316418882f + 1.0f;
    f32x2 t; t.x = __builtin_amdgcn_rcpf(d.x); t.y = __builtin_amdgcn_rcpf(d.y);
    f32x2 q = t * 0.5307027145f + (-0.7265760135f); q = q * t + 0.7107068705f; q = q * t + (-0.142248368f); q = q * t + 0.127414796f; q = q * t;
    const f32x2 s = (v * v) * (-0.72134752044f);
    f32x2 e; e.x = __builtin_amdgcn_exp2f(s.x); e.y = __builtin_amdgcn_exp2f(s.y);
    const f32x2 m = v * (q * e), r = v - m;
    f32x2 o; o.x = v.x < 0.f ? m.x : r.x; o.y = v.y < 0.f ? m.y : r.y; return o;
}

template <int ACT  > struct EpiBf16 {
    static constexpr bool PERM = true, AFTER_DRAIN = false; static_assert(ACT == 0 || ACT == 1, "EpiBf16: ACT is 0 (none) or 1 (gelu_pk)");
    bf16_t* O; int ldc; const float* bias; int split_cols; size_t split_stride; float scale0;
    __device__ __forceinline__ void operator()(const f32x4 (&acc)[2][2][4][2], const Unit& u, int wr, int wc, int fr, int fq) const {
        const int row0 = u.pm * BM + wr * 64 + fr; int colt = u.pn * BM; bf16_t* base = O;
        float sc = 1.f; if (split_cols) { const int t = colt / split_cols; base += (size_t)t * split_stride; colt -= t * split_cols; if (t == 0) sc = scale0; }
        const int col0 = colt + wc * 32 + 8 * fq, bcol0 = u.pn * BM + wc * 32 + 8 * fq;
        f32x4 bv[2][2];
#pragma unroll
        for (int bj = 0; bj < 2; ++bj)
#pragma unroll
            for (int n = 0; n < 2; ++n) bv[bj][n] = bias ? *(const f32x4*)(bias + bcol0 + bj * HALF + 4 * n) : (f32x4){0.f, 0.f, 0.f, 0.f};
#pragma unroll
        for (int ai = 0; ai < 2; ++ai)
#pragma unroll
            for (int m = 0; m < 4; ++m) { bf16_t* rowp = base + (size_t)(row0 + ai * HALF + m * 16) * ldc + col0;
#pragma unroll
                for (int bj = 0; bj < 2; ++bj) { f32x4 v0 = acc[ai][bj][m][0] + bv[bj][0], v1 = acc[ai][bj][m][1] + bv[bj][1];
                    if (ACT == 1) { f32x2 a = gelu_pk((f32x2){v0[0], v0[1]}), b = gelu_pk((f32x2){v0[2], v0[3]}), c = gelu_pk((f32x2){v1[0], v1[1]}), d = gelu_pk((f32x2){v1[2], v1[3]});
                        v0 = (f32x4){a.x, a.y, b.x, b.y}; v1 = (f32x4){c.x, c.y, d.x, d.y}; }
                    v0 = v0 * sc; v1 = v1 * sc; u32x4 w; w.x = cvt_pk_bf16(v0[0], v0[1]); w.y = cvt_pk_bf16(v0[2], v0[3]); w.z = cvt_pk_bf16(v1[0], v1[1]); w.w = cvt_pk_bf16(v1[2], v1[3]);
                    *(u32x4*)(rowp + bj * HALF) = w; } }
    }
};


constexpr float RMS_EPS_F = 1e-6f;
__device__ __forceinline__ float rstd_of(float ss) { return 1.0f / sqrtf(ss * (1.0f / 1024.0f) + RMS_EPS_F); }
__device__ __forceinline__ float rstd_slots(const float* ss, int row, int ns, int fq) {
    const f32x4* p = (const f32x4*)(ss + (size_t)row * ns + fq * (ns >> 2)); f32x4 v = p[0]; float s = (v[0] + v[1]) + (v[2] + v[3]);
    if (ns == 32) { v = p[1]; s += (v[0] + v[1]) + (v[2] + v[3]); }
    s += __shfl_xor(s, 16); s += __shfl_xor(s, 32); return rstd_of(s); }
__device__ __forceinline__ u32x4 pack8(f32x4 v0, f32x4 v1) { u32x4 w; w.x = cvt_pk_bf16(v0[0], v0[1]); w.y = cvt_pk_bf16(v0[2], v0[3]); w.z = cvt_pk_bf16(v1[0], v1[1]); w.w = cvt_pk_bf16(v1[2], v1[3]); return w; }
__device__ __forceinline__ float fast_sigmoid(float x) { return __builtin_amdgcn_rcpf(1.0f + __builtin_amdgcn_exp2f(-1.4426950408889634f * x)); }
__device__ __forceinline__ f32x2 gelu_tanh2(f32x2 y) {
    const f32x2 t = y * y, u = y * (t * (-0.10294324f) + (-2.3022082f));
    f32x2 e; e.x = __builtin_amdgcn_exp2f(u.x); e.y = __builtin_amdgcn_exp2f(u.y);
    const f32x2 d = e + 1.0f; f32x2 r; r.x = __builtin_amdgcn_rcpf(d.x); r.y = __builtin_amdgcn_rcpf(d.y);
    return y * r;
}

struct EpiQKV {
    static constexpr bool PERM = true, AFTER_DRAIN = false;
    bf16_t* Kb; const PG8_LAS float* rb; float scale0; mutable int ui = 0;
    __device__ __forceinline__ void operator()(const f32x4 (&acc)[2][2][4][2], const Unit& u, int wr, int wc, int fr, int fq) const {
        int colt = u.pn * BM; const int t = colt >> 10; colt &= 1023; const int slot = (t == 0) ? 2 : (t - 1); bf16_t* base = Kb + (size_t)slot * (16u << 20); const float sc = (t == 0) ? scale0 : 1.f;
        const int col0 = colt + wc * 32 + 8 * fq, row0 = u.pm * BM + wr * 64 + fr;
        const PG8_LAS float* rq = rb + ui * 256; ++ui;
#pragma unroll
        for (int ai = 0; ai < 2; ++ai)
#pragma unroll
            for (int m = 0; m < 4; ++m) { const int row = row0 + ai * HALF + m * 16; const float rs = rq[wr * 64 + fr + ai * HALF + m * 16] * sc; bf16_t* rowp = base + (size_t)row * 1024 + col0;
#pragma unroll
                for (int bj = 0; bj < 2; ++bj) *(u32x4*)(rowp + bj * HALF) = pack8(acc[ai][bj][m][0] * rs, acc[ai][bj][m][1] * rs); }
    }
};
struct EpiMLP1 {
    static constexpr bool PERM = true, AFTER_DRAIN = false;
    bf16_t* O; const PG8_LAS float* rb; mutable int ui = 0;
    __device__ __forceinline__ void operator()(const f32x4 (&acc)[2][2][4][2], const Unit& u, int wr, int wc, int fr, int fq) const {
        const int row0 = u.pm * BM + wr * 64 + fr; const PG8_LAS float* rq = rb + ui * 256; ++ui;
#pragma unroll
        for (int ai = 0; ai < 2; ++ai)
#pragma unroll
            for (int m = 0; m < 4; ++m) { const int row = row0 + ai * HALF + m * 16; const float rs = rq[wr * 64 + fr + ai * HALF + m * 16]; bf16_t* rowp = O + ((size_t)u.pn * 16384 + row) * 256 + wc * 32 + 8 * fq;
#pragma unroll
                for (int bj = 0; bj < 2; ++bj) { f32x4 v0 = acc[ai][bj][m][0] * rs, v1 = acc[ai][bj][m][1] * rs;
#pragma unroll
                    for (int e = 0; e < 4; ++e) { const float a = fmaxf(v0[e], 0.f), b = fmaxf(v1[e], 0.f); v0[e] = a * a; v1[e] = b * b; }
                    *(u32x4*)(rowp + bj * HALF) = pack8(v0, v1); } }
    }
};
__device__ __forceinline__ float bflo(unsigned w) { return __uint_as_float(w << 16); }
__device__ __forceinline__ float bfhi(unsigned w) { return __uint_as_float(w & 0xffff0000u); }
template <bool GLU> struct EpiRes {
    static constexpr bool PERM = true, AFTER_DRAIN = false;
    const float* hin32; bf16_t* hb; float* ss;
    __device__ __forceinline__ void operator()(const f32x4 (&acc)[2][2][4][2], const Unit& u, int wr, int wc, int fr, int fq) const {
        constexpr int NB = GLU ? 1 : 2;
        const int row0 = u.pm * BM + wr * 64 + fr, colb = GLU ? (u.pn * HALF + wc * 32 + 8 * fq) : (u.pn * BM + wc * 32 + 8 * fq);
#pragma unroll
        for (int ai = 0; ai < 2; ++ai) {
            f32x4 r0[4][NB], r1[4][NB];
            if (hin32) {
#pragma unroll
                for (int m = 0; m < 4; ++m)
#pragma unroll
                    for (int bj = 0; bj < NB; ++bj) { const size_t off = (size_t)(row0 + ai * HALF + m * 16) * 1024 + colb + bj * HALF; r0[m][bj] = __builtin_nontemporal_load((const f32x4*)(hin32 + off)); r1[m][bj] = __builtin_nontemporal_load((const f32x4*)(hin32 + off + 4)); }
            } else { u32x4 w[4][NB];
#pragma unroll
                for (int m = 0; m < 4; ++m)
#pragma unroll
                    for (int bj = 0; bj < NB; ++bj) w[m][bj] = *(const u32x4*)(hb + (size_t)(row0 + ai * HALF + m * 16) * 1024 + colb + bj * HALF);
#pragma unroll
                for (int m = 0; m < 4; ++m)
#pragma unroll
                    for (int bj = 0; bj < NB; ++bj) { const u32x4 x = w[m][bj]; r0[m][bj] = (f32x4){bflo(x.x), bfhi(x.x), bflo(x.y), bfhi(x.y)}; r1[m][bj] = (f32x4){bflo(x.z), bfhi(x.z), bflo(x.w), bfhi(x.w)}; } }
#pragma unroll
            for (int m = 0; m < 4; ++m) { const int row = row0 + ai * HALF + m * 16; float s = 0.f;
#pragma unroll
                for (int bj = 0; bj < NB; ++bj) { const size_t off = (size_t)row * 1024 + colb + bj * HALF; f32x4 o[2] = {r0[m][bj], r1[m][bj]};
#pragma unroll
                    for (int n = 0; n < 2; ++n) { f32x4 v = acc[ai][bj][m][n];
                        if (GLU) { const f32x4 gt = acc[ai][1][m][n];
#pragma unroll
                            for (int e = 0; e < 4; ++e) v[e] = v[e] * fast_sigmoid(gt[e]); }
                        o[n] = o[n] + v;
                        s += (o[n][0] * o[n][0] + o[n][1] * o[n][1]) + (o[n][2] * o[n][2] + o[n][3] * o[n][3]); }
                    *(u32x4*)(hb + off) = pack8(o[0], o[1]); }
                s += __shfl_xor(s, 16); s += __shfl_xor(s, 32);
                if (ss && fq == 0) ss[(size_t)row * (GLU ? 32 : 16) + u.pn * 4 + wc] = s; } }
    }
};
typedef float f2v_t __attribute__((ext_vector_type(2)));
struct EpiSlocScan {
    static constexpr bool PERM = true, AFTER_DRAIN = true;
    const f2v_t* lampow; bf16_t* UX;
    __device__ __forceinline__ void fused(f32x4 (&acc)[2][2][4][2], const Unit& u, int wr, int wc, int fr, int fq, PG8_LAS unsigned char* lds, int wid, int lane) const {
        constexpr int TP = 132;
        PG8_LAS float* T = (PG8_LAS float*)lds; const int col = wc * 32 + 8 * fq;
#pragma unroll
        for (int ai = 0; ai < 2; ++ai)
#pragma unroll
            for (int m = 0; m < 4; ++m) { const int n = ai * HALF + wr * 64 + m * 16 + fr; PG8_LAS float* p = T + n * TP + col;
                *(PG8_LAS f32x4*)(p) = acc[ai][0][m][0]; *(PG8_LAS f32x4*)(p + 4) = acc[ai][0][m][1]; }
        asm volatile("s_waitcnt lgkmcnt(0)" ::: "memory"); __builtin_amdgcn_s_barrier(); asm volatile("" ::: "memory");
        { const int g = u.pn, p = lane; const f2v_t lt = lampow[(size_t)(g * 64 + p) * 33 + 32]; float xr = 0.f, xi = 0.f;
          PG8_LAS float* Tw = T + (wid * 32) * TP + p; PG8_LAS float* E = T + 256 * TP;
#pragma unroll 4
          for (int k = 0; k < 32; ++k) { const float sr = Tw[k * TP], si = Tw[k * TP + 64]; const float nr = lt.x * xr - lt.y * xi + sr, ni = lt.x * xi + lt.y * xr + si; xr = nr; xi = ni; }
          E[wid * 128 + p] = xr; E[wid * 128 + 64 + p] = xi;
          f2v_t l32 = lt;
#pragma unroll
          for (int q = 0; q < 5; ++q) { const float a = l32.x * l32.x - l32.y * l32.y, b = 2.f * l32.x * l32.y; l32.x = a; l32.y = b; }
          asm volatile("s_waitcnt lgkmcnt(0)" ::: "memory"); __builtin_amdgcn_s_barrier(); asm volatile("" ::: "memory");
          xr = 0.f; xi = 0.f;
          for (int v = 0; v < wid; ++v) { const float er = E[v * 128 + p], ei = E[v * 128 + 64 + p]; const float nr = l32.x * xr - l32.y * xi + er, ni = l32.x * xi + l32.y * xr + ei; xr = nr; xi = ni; }
          bf16_t* ux = UX + (size_t)(u.pm * 256 + wid * 32) * 640 + 512 + p;
#pragma unroll 4
          for (int k = 0; k < 32; ++k) { const float sr = Tw[k * TP], si = Tw[k * TP + 64]; const unsigned w = cvt_pk_bf16(xr, xi);
              ux[(size_t)k * 640] = (bf16_t)(w & 0xffffu); ux[(size_t)k * 640 + 64] = (bf16_t)(w >> 16);
              const float nr = lt.x * xr - lt.y * xi + sr, ni = lt.x * xi + lt.y * xr + si; xr = nr; xi = ni; } }
    }
};
struct EpiY {
    static constexpr bool PERM = true, AFTER_DRAIN = false;
    bf16_t* Z;
    __device__ __forceinline__ void operator()(const f32x4 (&acc)[2][2][4][2], const Unit& u, int wr, int wc, int fr, int fq) const {
        const int g = u.pm >> 1, i = u.pm & 1, j = u.pn & 1;
#pragma unroll
        for (int ai = 0; ai < 2; ++ai)
#pragma unroll
            for (int m = 0; m < 4; ++m) { const int n = 256 * i + ai * HALF + wr * 64 + m * 16 + fr;
#pragma unroll
                for (int bj = 0; bj < 2; ++bj) { const int cc = 256 * j + 128 * bj + 32 * wc + 8 * fq, t = cc >> 4, c0 = cc & 15;
                    f32x4 v0 = acc[ai][bj][m][0], v1 = acc[ai][bj][m][1];
                    { const f32x2 a = gelu_tanh2((f32x2){v0[0], v0[1]}), b = gelu_tanh2((f32x2){v0[2], v0[3]}), c = gelu_tanh2((f32x2){v1[0], v1[1]}), d = gelu_tanh2((f32x2){v1[2], v1[3]});
                      v0 = (f32x4){a.x, a.y, b.x, b.y}; v1 = (f32x4){c.x, c.y, d.x, d.y}; }
                    *(u32x4*)(Z + ((size_t)g * 16384 + (32 * n + t)) * 16 + c0) = pack8(v0, v1); } }
    }
};
struct OrderSloc {
    int G, c;
    __device__ __forceinline__ bool next(int i, Unit& u) const { const int L = i * G + c; if (L >= 128) return false;
        int g, h; if (G >= 128 && (G & 7) == 0) { const int x = L & 7, sl = L >> 3; g = x * 8 + (sl >> 1); h = sl & 1; } else { g = L >> 1; h = L & 1; }
        u.pm = 2 * g + h; u.pn = g; return true; }
    __device__ __forceinline__ void a_ready(const Unit&) const {}
    __device__ __forceinline__ void done(const Unit&) const {}
};
struct OrderY {
    int G, c;
    __device__ __forceinline__ bool next(int i, Unit& u) const { const int L = i * G + c; if (L >= 256) return false;
        int g, q; if (G == 256) { const int x = L & 7, sl = L >> 3; g = x * 8 + (sl >> 2); q = sl & 3; } else { g = L >> 2; q = L & 3; }
        u.pm = 2 * g + (q >> 1); u.pn = 2 * g + (q & 1); return true; }
    __device__ __forceinline__ void a_ready(const Unit&) const {}
    __device__ __forceinline__ void done(const Unit&) const {}
};

template <class Epi, class Sched, bool ALIGN_EPI = false, bool SP2 = false>
__device__ __forceinline__ void gemm_phase(PG8_LAS unsigned char* lds, const Gemm g, const Sched& S, const Epi& E) {
    const int tid = ltid(), wid = __builtin_amdgcn_readfirstlane(tid >> 6), lane = tid & 63, wr = wid >> 2, wc = wid & 3, fr = lane & 15, fq = lane >> 4;
    const int K = g.K, nt = K / BK;
    unsigned voffA[2], voffB[2];
#pragma unroll
    for (int i = 0; i < 2; ++i) { int R, C; stage_rc(tid * 16 + i * 8192, R, C); const int Rb = Epi::PERM ? ((R & ~31) + perm32(R & 31)) : R;
        voffA[i] = (unsigned)(R * g.lda * 2 + (C >> 4) * g.a_gs + (C & 15) * 2); voffB[i] = (unsigned)(Rb * g.ldb + C) * 2u; }
    const size_t kstep = (size_t)(BK * 2);
#define PG8_AOFF(x) ((size_t)((x) >> 2) * (size_t)g.a_ts + (size_t)((x) & 3) * (size_t)g.a_ks)
    const size_t hstepA = (size_t)HALF * g.lda * 2, hstepB = (size_t)HALF * g.ldb * 2;
    const size_t tstepA = 2 * hstepA, tstepB = 2 * hstepB;
    const unsigned ldsw = (unsigned)wid * 1024u;
    const int aoff = lds_byte(wr * 64 + fr, fq * 8), boff = lds_byte(wc * 32 + fr, fq * 8);
#define PG8_SA(b, h) (((b) * 2 + (h)) * HTB)
#define PG8_SB(b, h) ((4 + (b) * 2 + (h)) * HTB)
#define PG8_STAGE(bufoff, gbase, voff) do { _Pragma("unroll") for (int _i = 0; _i < 2; ++_i) \
        __builtin_amdgcn_global_load_lds((const unsigned*)((const char*)(gbase) + (voff)[_i]), (PG8_LAS unsigned*)(lds + (bufoff) + ldsw + _i * 8192), 16, 0, 0); } while (0)
#define PG8_LDA(dst, b, h) do { _Pragma("unroll") for (int m = 0; m < 4; ++m) _Pragma("unroll") for (int k = 0; k < 2; ++k) dst[m][k] = *(const PG8_LAS bf16x8*)(lds + PG8_SA(b, h) + aoff + m * 2048 + k * 1024); } while (0)
#define PG8_LDB(dst, b, h) do { _Pragma("unroll") for (int n = 0; n < 2; ++n) _Pragma("unroll") for (int k = 0; k < 2; ++k) dst[n][k] = *(const PG8_LAS bf16x8*)(lds + PG8_SB(b, h) + boff + n * 2048 + k * 1024); } while (0)
#define PG8_MMA(ai, bj, At, Bt) do { __builtin_amdgcn_s_setprio(1); _Pragma("unroll") for (int m = 0; m < 4; ++m) _Pragma("unroll") for (int n = 0; n < 2; ++n) _Pragma("unroll") for (int k = 0; k < 2; ++k) \
        acc[ai][bj][m][n] = __builtin_amdgcn_mfma_f32_16x16x32_bf16(Bt[n][k], At[m][k], acc[ai][bj][m][n], 0, 0, 0); __builtin_amdgcn_s_setprio(0); } while (0)
#define PG8_WAIT_V(n) asm volatile("s_waitcnt vmcnt(" #n ")" ::: "memory")
#define PG8_WAIT_L(n) asm volatile("s_waitcnt lgkmcnt(" #n ")" ::: "memory")
#define PG8_BAR __builtin_amdgcn_s_barrier()
#define PG8_SCHED __builtin_amdgcn_sched_barrier(0)
    Unit cur, nxt; int ui = 0;
    if (!S.next(0, cur)) return;
    f32x4 acc[2][2][4][2];
#pragma unroll
    for (int a = 0; a < 2; ++a)
#pragma unroll
        for (int b = 0; b < 2; ++b)
#pragma unroll
            for (int m = 0; m < 4; ++m)
#pragma unroll
                for (int n = 0; n < 2; ++n) acc[a][b][m][n] = (f32x4){0.f, 0.f, 0.f, 0.f};
    bf16x8 At[4][2], B0[2][2], B1[2][2];
    const char* cA = (const char*)g.A + (size_t)cur.pm * tstepA; const char* cB = (const char*)g.Bt + (size_t)cur.pn * tstepB;
    S.a_ready(cur);
    if constexpr (SP2) {
        PG8_STAGE(PG8_SB(0, 0), cB, voffB); PG8_STAGE(PG8_SB(0, 1), cB + hstepB, voffB); PG8_STAGE(PG8_SA(0, 0), cA, voffA); PG8_STAGE(PG8_SA(0, 1), cA + hstepA, voffA);
        if (wr == 1) PG8_BAR;
        PG8_WAIT_V(2); PG8_BAR;
        PG8_STAGE(PG8_SB(1, 0), cB + kstep, voffB); PG8_STAGE(PG8_SA(1, 0), cA + PG8_AOFF(1), voffA); PG8_STAGE(PG8_SB(1, 1), cB + hstepB + kstep, voffB);
        PG8_WAIT_V(6); PG8_BAR;
    } else {
        PG8_STAGE(PG8_SB(0, 0), cB, voffB); PG8_STAGE(PG8_SA(0, 0), cA, voffA); PG8_STAGE(PG8_SB(0, 1), cB + hstepB, voffB); PG8_STAGE(PG8_SA(0, 1), cA + hstepA, voffA);
        if (wr == 1) PG8_BAR;
        PG8_WAIT_V(4); PG8_BAR;
        PG8_STAGE(PG8_SB(1, 0), cB + kstep, voffB); PG8_STAGE(PG8_SA(1, 0), cA + PG8_AOFF(1), voffA); PG8_STAGE(PG8_SB(1, 1), cB + hstepB + kstep, voffB);
        PG8_WAIT_V(6); PG8_BAR;
    }
    for (;;) {
        const bool has_next = S.next(ui + 1, nxt);
        const char* nA = has_next ? (const char*)g.A + (size_t)nxt.pm * tstepA : cA; const char* nB = has_next ? (const char*)g.Bt + (size_t)nxt.pn * tstepB : cB;
        for (int t = 0; t < nt; t += 2) {
            const bool last = (t == nt - 2);
            const char* a1 = cA + PG8_AOFF(t + 1);
            const char* a2 = last ? nA : cA + PG8_AOFF(t + 2); const char* b2 = last ? nB : cB + (size_t)(t + 2) * kstep;
            const char* a3 = a2 + (size_t)g.a_ks; const char* b3 = b2 + kstep;
            if (last && has_next) S.a_ready(nxt);
            if constexpr (SP2) {
            PG8_LDB(B0, 0, 0); PG8_LDB(B1, 0, 1); PG8_SCHED; PG8_LDA(At, 0, 0); PG8_STAGE(PG8_SA(1, 1), a1 + hstepA, voffA);
            PG8_WAIT_V(8); PG8_WAIT_L(0); PG8_BAR; PG8_MMA(0, 0, At, B0); PG8_MMA(0, 1, At, B1); PG8_BAR; PG8_SCHED;
            PG8_LDA(At, 0, 1); PG8_STAGE(PG8_SB(0, 0), b2, voffB); PG8_STAGE(PG8_SB(0, 1), b2 + hstepB, voffB); PG8_STAGE(PG8_SA(0, 0), a2, voffA);
            PG8_WAIT_V(8); PG8_WAIT_L(0); PG8_BAR; PG8_MMA(1, 0, At, B0); PG8_MMA(1, 1, At, B1); PG8_BAR; PG8_SCHED;
            PG8_LDB(B0, 1, 0); PG8_LDB(B1, 1, 1); PG8_SCHED; PG8_LDA(At, 1, 0); PG8_STAGE(PG8_SA(0, 1), a2 + hstepA, voffA);
            PG8_WAIT_V(8); PG8_WAIT_L(0); PG8_BAR; PG8_MMA(0, 0, At, B0); PG8_MMA(0, 1, At, B1); PG8_BAR; PG8_SCHED;
            PG8_LDA(At, 1, 1); PG8_STAGE(PG8_SB(1, 0), b3, voffB); PG8_STAGE(PG8_SB(1, 1), b3 + hstepB, voffB); PG8_STAGE(PG8_SA(1, 0), a3, voffA);
            PG8_WAIT_V(8); PG8_WAIT_L(0); PG8_BAR; PG8_MMA(1, 0, At, B0); PG8_MMA(1, 1, At, B1); PG8_BAR; PG8_SCHED;
            } else {
            PG8_LDB(B0, 0, 0); PG8_SCHED; PG8_LDA(At, 0, 0); PG8_STAGE(PG8_SA(1, 1), a1 + hstepA, voffA);
            PG8_WAIT_L(8); PG8_BAR; PG8_WAIT_L(0); PG8_MMA(0, 0, At, B0); PG8_BAR; PG8_SCHED;
            PG8_LDB(B1, 0, 1); PG8_STAGE(PG8_SB(0, 0), b2, voffB);
            PG8_BAR; PG8_WAIT_L(0); PG8_MMA(0, 1, At, B1); PG8_BAR;
            PG8_LDA(At, 0, 1); PG8_STAGE(PG8_SA(0, 0), a2, voffA);
            PG8_BAR; PG8_WAIT_L(0); PG8_MMA(1, 0, At, B0); PG8_BAR; PG8_SCHED;
            PG8_STAGE(PG8_SB(0, 1), b2 + hstepB, voffB);
            PG8_WAIT_V(6); PG8_BAR; PG8_MMA(1, 1, At, B1); PG8_BAR;
            PG8_LDB(B0, 1, 0); PG8_SCHED; PG8_LDA(At, 1, 0); PG8_STAGE(PG8_SA(0, 1), a2 + hstepA, voffA);
            PG8_WAIT_L(8); PG8_BAR; PG8_WAIT_L(0); PG8_MMA(0, 0, At, B0); PG8_BAR; PG8_SCHED;
            PG8_LDB(B1, 1, 1); PG8_STAGE(PG8_SB(1, 0), b3, voffB);
            PG8_BAR; PG8_WAIT_L(0); PG8_MMA(0, 1, At, B1); PG8_BAR;
            PG8_LDA(At, 1, 1); PG8_STAGE(PG8_SA(1, 0), a3, voffA);
            PG8_BAR; PG8_WAIT_L(0); PG8_MMA(1, 0, At, B0); PG8_BAR; PG8_SCHED;
            PG8_STAGE(PG8_SB(1, 1), b3 + hstepB, voffB);
            PG8_WAIT_V(6); PG8_BAR; PG8_MMA(1, 1, At, B1); PG8_BAR;
            }
        }
        if constexpr (ALIGN_EPI) { if (wr == 0) PG8_BAR; }
        if constexpr (!Epi::AFTER_DRAIN) { E(acc, cur, wr, wc, fr, fq); S.done(cur); }
        if (!has_next) break;
#pragma unroll
        for (int a = 0; a < 2; ++a)
#pragma unroll
            for (int b = 0; b < 2; ++b)
#pragma unroll
                for (int m = 0; m < 4; ++m)
#pragma unroll
                    for (int n = 0; n < 2; ++n) acc[a][b][m][n] = (f32x4){0.f, 0.f, 0.f, 0.f};
        cur = nxt; cA = nA; cB = nB; ++ui;
        if constexpr (ALIGN_EPI) { if (wr == 1) PG8_BAR; }
    }
    PG8_WAIT_V(0);
    if constexpr (!ALIGN_EPI) { if (wr == 0) PG8_BAR; }
    PG8_BAR;
    if constexpr (Epi::AFTER_DRAIN) { E.fused(acc, cur, wr, wc, fr, fq, lds, wid, lane); S.done(cur); }
#undef PG8_AOFF
#undef PG8_SA
#undef PG8_SB
#undef PG8_STAGE
#undef PG8_LDA
#undef PG8_LDB
#undef PG8_MMA
#undef PG8_WAIT_V
#undef PG8_WAIT_L
#undef PG8_BAR
#undef PG8_SCHED
}
}
namespace attn_body {
using bf16=__hip_bfloat16;
using bf16x8=__attribute__((ext_vector_type(8)))short;
using s16x4=__attribute__((ext_vector_type(4)))short;
using f32x16=__attribute__((ext_vector_type(16)))float;
using u32x4=__attribute__((ext_vector_type(4)))unsigned;
using f32x4_t=__attribute__((ext_vector_type(4)))float;
constexpr int BATCH=2,NHEAD=16,SEQ=8192,D=64,DM=NHEAD*D;
constexpr int NW=8,QBLK=32,QB=QBLK*NW,KVBLK=64,NQB=SEQ/QB;
constexpr int ATTN_PITCH=DM, ATTN_UNIT_ROWS=QB;
__device__ __forceinline__ int crow(int r,int hi){return (r&3)+8*(r>>2)+4*hi;}
#define SBAR() __builtin_amdgcn_sched_barrier(0)
__device__ __forceinline__ void cmask(f32x16&p0,f32x16&p1,int jb,int qrel,int hi){
  const float NEG=-INFINITY; int kb=64*jb+4*hi;
  #pragma unroll
  for(int r=0;r<16;++r){int kv=kb+(r&3)+8*(r>>2); if(kv>qrel)p0[r]=NEG; if(kv+32>qrel)p1[r]=NEG;}
}

constexpr int NSLOT=3, SLOTB=8192;
constexpr int LDS_K=0, LDS_V=NSLOT*SLOTB, LDS_WS=2*NSLOT*SLOTB, LDS_OST=LDS_WS+NW*64*4, LDS_GT=LDS_OST+NW*4096, LDS_QM=LDS_GT+SEQ*4, LDS_CF=LDS_QM+64, LDS_ORD=LDS_CF+512, LDS_BYTES=LDS_ORD+256;
constexpr float C2=0.125f*1.4426950408889634f;
__device__ __forceinline__ void glds16(const void*gsrc,unsigned lds_dst){unsigned keep;
  asm volatile("s_mov_b32 %0, m0\n\ts_mov_b32 m0, %2\n\ts_nop 0\n\tglobal_load_lds_dwordx4 %1, off\n\ts_mov_b32 m0, %0":"=&s"(keep):"v"(gsrc),"s"(lds_dst):"memory");}
__device__ __forceinline__ float max3f(float a,float b,float c){float r;asm("v_max3_f32 %0, %1, %2, %3":"=v"(r):"v"(a),"v"(b),"v"(c));return r;}
__device__ __forceinline__ float max2f(float a,float b){float r;asm("v_max_f32_e32 %0, %1, %2":"=v"(r):"v"(a),"v"(b));return r;}
__device__ __forceinline__ float fadd_s(float a,float b){float r;asm("v_add_f32_e32 %0, %1, %2":"=v"(r):"v"(a),"v"(b));return r;}
__device__ __forceinline__ float fsub_s(float a,float b){float r;asm("v_sub_f32_e32 %0, %1, %2":"=v"(r):"v"(a),"v"(b));return r;}
typedef float f32x2_t __attribute__((ext_vector_type(2))); typedef __bf16 bf16x2_t __attribute__((ext_vector_type(2)));
__device__ __forceinline__ unsigned cvtpk_s(float lo,float hi){f32x2_t v={lo,hi};bf16x2_t b=__builtin_convertvector(v,bf16x2_t);return __builtin_bit_cast(unsigned,b);}
#define WAIT_BAR(N) asm volatile("s_waitcnt vmcnt(" #N ") lgkmcnt(0)\n\ts_barrier":::"memory")

__device__ __forceinline__ void qkt(f32x16&p0,f32x16&p1,const char*Kslot,const bf16x8*qr,int r32,int hi){
  const char*kb=Kslot+hi*1024+r32*16;
  #pragma unroll
  for(int d0=0;d0<4;++d0){
    const bf16x8 b0=*reinterpret_cast<const bf16x8*>(kb+d0*2048);
    const bf16x8 b1=*reinterpret_cast<const bf16x8*>(kb+d0*2048+512);
    {p0=__builtin_amdgcn_mfma_f32_32x32x16_bf16(b0,qr[d0],p0,0,0,0);p1=__builtin_amdgcn_mfma_f32_32x32x16_bf16(b1,qr[d0],p1,0,0,0);}}
}
typedef __attribute__((address_space(3))) const char* lds_cptr;
typedef short v4i16_t __attribute__((ext_vector_type(4)));
__device__ __forceinline__ void kload8(bf16x8*kf,lds_cptr kp){
  kf[0]=*(const __attribute__((address_space(3))) bf16x8*)(kp);      kf[1]=*(const __attribute__((address_space(3))) bf16x8*)(kp+512);
  kf[2]=*(const __attribute__((address_space(3))) bf16x8*)(kp+2048); kf[3]=*(const __attribute__((address_space(3))) bf16x8*)(kp+2560);
  kf[4]=*(const __attribute__((address_space(3))) bf16x8*)(kp+4096); kf[5]=*(const __attribute__((address_space(3))) bf16x8*)(kp+4608);
  kf[6]=*(const __attribute__((address_space(3))) bf16x8*)(kp+6144); kf[7]=*(const __attribute__((address_space(3))) bf16x8*)(kp+6656);
}
__device__ __forceinline__ void kload2(bf16x8*kf,lds_cptr kp,int j){ kf[2*j]=*(const __attribute__((address_space(3))) bf16x8*)(kp+j*2048); kf[2*j+1]=*(const __attribute__((address_space(3))) bf16x8*)(kp+j*2048+512); }
__device__ __forceinline__ s16x4 vtr(lds_cptr p){ return __builtin_bit_cast(s16x4,__builtin_amdgcn_ds_read_tr16_b64_v4i16((__attribute__((address_space(3))) v4i16_t*)p)); }
__device__ __forceinline__ float rowmax(const f32x16&p0,const f32x16&p1){
  float a=max3f(p0[0],p0[1],p1[0]),b=max3f(p0[2],p0[3],p1[1]);a=max3f(a,p1[2],p1[3]);
  #pragma unroll
  for(int r=4;r<16;r+=4){a=max3f(a,p0[r],p0[r+1]);b=max3f(b,p0[r+2],p0[r+3]);a=max3f(a,p1[r],p1[r+1]);b=max3f(b,p1[r+2],p1[r+3]);}
  const float m=max2f(a,b);
  auto rr=__builtin_amdgcn_permlane32_swap(__float_as_uint(m),__float_as_uint(m),false,false);
  return max2f(__uint_as_float(rr[0]),__uint_as_float(rr[1]));
}
__device__ __forceinline__ void pv(f32x16*o,int vb,bf16x8 pa0,bf16x8 pa1,bf16x8 pa2,bf16x8 pa3){
  #pragma unroll
  for(int d0=0;d0<2;++d0){s16x4 lo[4],hi[4];
    #pragma unroll
    for(int ks=0;ks<4;++ks){
      asm volatile("ds_read_b64_tr_b16 %0,%1 offset:%c2":"=&v"(lo[ks]):"v"(vb),"i"(d0*4096+ks*1024):"memory");
      asm volatile("ds_read_b64_tr_b16 %0,%1 offset:%c2":"=&v"(hi[ks]):"v"(vb),"i"(d0*4096+ks*1024+512):"memory");}
    asm volatile("s_waitcnt lgkmcnt(0)":::"memory");SBAR();
    #define PK(k) (bf16x8){lo[k][0],lo[k][1],lo[k][2],lo[k][3],hi[k][0],hi[k][1],hi[k][2],hi[k][3]}
    o[d0]=__builtin_amdgcn_mfma_f32_32x32x16_bf16(pa0,PK(0),o[d0],0,0,0);
    o[d0]=__builtin_amdgcn_mfma_f32_32x32x16_bf16(pa1,PK(1),o[d0],0,0,0);
    o[d0]=__builtin_amdgcn_mfma_f32_32x32x16_bf16(pa2,PK(2),o[d0],0,0,0);
    o[d0]=__builtin_amdgcn_mfma_f32_32x32x16_bf16(pa3,PK(3),o[d0],0,0,0);
    #undef PK
  }
}

#ifndef ATTN_STORE16
#define ATTN_STORE16(p,v) (*(u32x4*)(p)=(v))
#endif
template<int THRL> __device__ __forceinline__ void attn_unit(int b,int h,int qb,const bf16*Q,const bf16*__restrict__ K,const bf16*__restrict__ V,bf16*O,const float*__restrict__ Gg,float kmax,char*shm){
  const int tid=ltid(),lane=tid&63,r32=lane&31,hi=lane>>5; const int wid=__builtin_amdgcn_readfirstlane(tid>>6);
  const long rowbase=(long)b*SEQ; const int q0=qb*QB;
  const bf16*Qw=Q+(rowbase+q0+wid*QBLK)*DM+h*D;
  const lds_cptr shm3=(lds_cptr)shm;
  bf16x8 qr[4];
  #pragma unroll
  for(int d0=0;d0<4;++d0)qr[d0]=*reinterpret_cast<const bf16x8*>(&Qw[(long)r32*DM+d0*16+hi*8]);
  { const int nk=q0+QB; const float gb=q0?Gg[q0-1]:0.f;
    f32x4_t g4_[4]; float ge_[4];
    #pragma unroll
    for(int k_=0;k_<4;++k_){ const int i=tid*4+k_*2048; if(i<nk){ g4_[k_]=*(const f32x4_t*)(Gg+i); ge_[k_]=(i>=q0)?gb:Gg[i|63]; } }
    #pragma unroll
    for(int k_=0;k_<4;++k_){ const int i=tid*4+k_*2048; if(i<nk){ const float ge=ge_[k_]; const f32x4_t g4=g4_[k_]; *(__attribute__((address_space(3))) f32x4_t*)(shm3+LDS_GT+i*4)=(f32x4_t){g4[0]-ge,g4[1]-ge,g4[2]-ge,g4[3]-ge}; } }
    if(tid<(nk>>6)){ const float c_=(tid==0||64*tid>=q0)?1.f:__builtin_amdgcn_exp2f(Gg[64*tid-1]-Gg[64*tid+63]); *(__attribute__((address_space(3))) float*)(shm3+LDS_CF+tid*4)=c_; } }
  { float qs=0.f;
    #pragma unroll
    for(int d0=0;d0<4;++d0){
      #pragma unroll
      for(int e=0;e<8;++e){const float f=__uint_as_float(((unsigned)(unsigned short)qr[d0][e])<<16);qs+=f*f;}}
    {auto rr=__builtin_amdgcn_permlane32_swap(__float_as_uint(qs),__float_as_uint(qs),false,false);qs=__uint_as_float(rr[0])+__uint_as_float(rr[1]);}
    #pragma unroll
    for(int o_=1;o_<32;o_<<=1)qs=fmaxf(qs,__shfl_xor(qs,o_));
    if(lane==0)*(__attribute__((address_space(3))) float*)(shm3+LDS_QM+wid*4)=qs; }
  asm volatile("s_waitcnt vmcnt(0) lgkmcnt(0)\n\ts_barrier":::"memory");
  int j0;
  { float qm=0.f;
    #pragma unroll
    for(int w=0;w<8;++w)qm=fmaxf(qm,*(const __attribute__((address_space(3))) float*)(shm3+LDS_QM+w*4));
    const float lim=Gg[q0]-(2.f*sqrtf(qm)*kmax*1.01f+150.f);
    const int nt0=4*qb; int ln_=lane; asm volatile("":"+v"(ln_)); const bool c0=(ln_<nt0)&&(Gg[64*ln_+63]<lim); const bool c1=(ln_+64<nt0)&&(Gg[64*ln_+4096+63]<lim);
    j0=(__popcll(__ballot(c0))+__popcll(__ballot(c1)))&~1; j0=__builtin_amdgcn_readfirstlane(j0); }
  const bf16*Kh=K+(rowbase+(long)j0*KVBLK)*DM+h*D,*Vh=V+(rowbase+(long)j0*KVBLK)*DM+h*D;
  const lds_cptr cf0=shm3+LDS_CF+j0*4;
  const lds_cptr gp0=shm3+LDS_GT+j0*256+hi*16;
  const unsigned lds0=(unsigned)(uintptr_t)shm;
  float*wsf=(float*)(shm+LDS_WS)+wid*64;
  const bf16*ksrc=Kh+(long)lane*DM+wid*8;
  const bf16*vsrc=Vh+(long)(16*(wid&3)+(lane>>2))*DM+(wid>>2)*32+(lane&3)*8;
  const unsigned kdst=lds0+LDS_K+wid*1024, vdst=lds0+LDS_V+wid*1024;
  #define DMA_K(t,slot) glds16(ksrc+(long)(t)*KVBLK*DM,(unsigned)__builtin_amdgcn_readfirstlane(kdst+(slot)))
  #define DMA_V(t,slot) glds16(vsrc+(long)(t)*KVBLK*DM,(unsigned)__builtin_amdgcn_readfirstlane(vdst+(slot)))
  const char*Kbase=shm+LDS_K; bf16x8 kf[8];
  const lds_cptr kp0=shm3+LDS_K+hi*1024+r32*16; const lds_cptr vp0=shm3+LDS_V+((lane>>4)&1)*32+(lane&3)*8+(4*hi+((lane&15)>>2))*64;
  const int NT=(q0+QB)/KVBLK-j0;
  DMA_K(0,0);DMA_V(0,0);DMA_K(1,SLOTB);
  float mhat=0.f,l_reg=0.f;f32x16 o[2];o[0]=f32x16{};o[1]=f32x16{};
  const int qrel=wid*QBLK+r32;
  #define CMASK(P0,P1,t) do{int jb_=(t)-(NT-4); if(jb_>=0)cmask(P0,P1,jb_,qrel,hi);}while(0)
  #define BIASINIT(P0,P1,t) do{ const lds_cptr gp_=gp0+(t)*256; \
    _Pragma("unroll") for(int i_=0;i_<4;++i_){ const f32x4_t ga_=*(const __attribute__((address_space(3))) f32x4_t*)(gp_+i_*32), gb_=*(const __attribute__((address_space(3))) f32x4_t*)(gp_+128+i_*32); \
      P0[4*i_]=ga_[0]-mhat;P0[4*i_+1]=ga_[1]-mhat;P0[4*i_+2]=ga_[2]-mhat;P0[4*i_+3]=ga_[3]-mhat; P1[4*i_]=gb_[0]-mhat;P1[4*i_+1]=gb_[1]-mhat;P1[4*i_+2]=gb_[2]-mhat;P1[4*i_+3]=gb_[3]-mhat; } }while(0)
  bool resc=false;
  #define START(P0,P1) do{ const float rm=rowmax(P0,P1); resc=false; \
    { const float dl=rm; mhat=fadd_s(mhat,dl); \
      _Pragma("unroll") for(int r=0;r<16;++r){P0[r]=fsub_s(P0[r],dl);P1[r]=fsub_s(P1[r],dl);} \
      } \
    _Pragma("unroll") for(int r=0;r<16;++r)P0[r]=__builtin_amdgcn_exp2f(P0[r]); }while(0)
  #define RESC(t) do{ const float cf_=*(const __attribute__((address_space(3))) float*)(cf0+(t)*4); l_reg*=cf_; \
      if(resc){ asm volatile("s_waitcnt lgkmcnt(0)":::"memory"); \
        _Pragma("unroll") for(int d_=0;d_<2;++d_) _Pragma("unroll") for(int r=0;r<16;++r)o[d_][r]*=cf_*wsf[crow(r,hi)]; } \
      else { _Pragma("unroll") for(int d_=0;d_<2;++d_) _Pragma("unroll") for(int r=0;r<16;++r)o[d_][r]*=cf_; } }while(0)
  f32x16 pA0,pA1,pB0,pB1;
  int sl_prev=0,sl_cur=0,sl_next=SLOTB;
  #define ROT() do{sl_prev=sl_cur;sl_cur=sl_next;sl_next=(sl_next==(NSLOT-1)*SLOTB)?0:sl_next+SLOTB;}while(0)
  DMA_K(2,2*SLOTB);
  WAIT_BAR(3);
  BIASINIT(pA0,pA1,0);qkt(pA0,pA1,Kbase,qr,r32,hi);asm volatile("s_nop 15\n\ts_nop 7":"+v"(pA0),"+v"(pA1));CMASK(pA0,pA1,0);
  START(pA0,pA1);
  _Pragma("unroll") for(int r=0;r<16;++r)pA1[r]=__builtin_amdgcn_exp2f(pA1[r]);
  WAIT_BAR(0);
  DMA_K(3,0);DMA_V(1,SLOTB);
  ROT();
  kload8(kf,kp0+sl_cur);
  WAIT_BAR(2);
  s16x4 vlo[8],vhi[8]; u32x4 pw0,pw1,pw2,pw3;
  #define PKW(P,B) cvtpk_s(P[B],P[B+1])
  #define PAF(k) __builtin_bit_cast(bf16x8,pw##k)
  #define VFR(i) (bf16x8){vlo[i][0],vlo[i][1],vlo[i][2],vlo[i][3],vhi[i][0],vhi[i][1],vhi[i][2],vhi[i][3]}
  #define PIN(x) asm volatile("":"+v"(x))
  #define MX3(a,b,c) __builtin_fmaxf(__builtin_fmaxf((a),(b)),(c))
  #define GAPA(MF,A0,A1,A2,A3,W0,W1,PW) do{ MF; sacc+=A0; sacc+=A1; sacc+=A2; sacc+=A3; PIN(sacc); W0; W1; PIN(PW); SBAR(); }while(0)
  #define EX(v) __builtin_amdgcn_exp2f(v)
  #define GAPB(MF,X,B) do{ MF; X[B]=EX(X[B]); X[B+1]=EX(X[B+1]); X[B+2]=EX(X[B+2]); X[B+3]=EX(X[B+3]); PIN(X); SBAR(); }while(0)
  #define VRD(i) do{ vlo[i]=vtr(vp_+(((i)>>2)*4096+((i)&3)*1024)); vhi[i]=vtr(vp_+(((i)>>2)*4096+((i)&3)*1024+512)); }while(0)
  #define KRD(G,j) do{ if(G){ kload2(kf,kp0+sl_next,j); SBAR(); } }while(0)
  #define STEP(C0,C1,P0,P1,t,GK,GV,GL) do{ SBAR(); BIASINIT(C0,C1,t); SBAR(); \
    const lds_cptr vp_=vp0+sl_prev; \
    VRD(0); SBAR(); float sacc=(P0[0]+P0[1]); \
    GAPA(C0=__builtin_amdgcn_mfma_f32_32x32x16_bf16(kf[0],qr[0],C0,0,0,0), P0[2],P0[3],P0[4],P0[5],     pw0[0]=PKW(P0,0), pw0[1]=PKW(P0,2), pw0); \
    VRD(4); SBAR(); GAPA(C1=__builtin_amdgcn_mfma_f32_32x32x16_bf16(kf[1],qr[0],C1,0,0,0), P0[6],P0[7],P0[8],P0[9],     pw0[2]=PKW(P0,4), pw0[3]=PKW(P0,6), pw0); \
    VRD(1); SBAR(); GAPA(C0=__builtin_amdgcn_mfma_f32_32x32x16_bf16(kf[2],qr[1],C0,0,0,0),   P0[10],P0[11],P0[12],P0[13], pw1[0]=PKW(P0,8), pw1[1]=PKW(P0,10), pw1); \
    VRD(5); SBAR(); GAPA(C1=__builtin_amdgcn_mfma_f32_32x32x16_bf16(kf[3],qr[1],C1,0,0,0),   P0[14],P0[15],P1[0],P1[1],   pw1[2]=PKW(P0,12),pw1[3]=PKW(P0,14), pw1); \
    VRD(2); SBAR(); GAPA(C0=__builtin_amdgcn_mfma_f32_32x32x16_bf16(kf[4],qr[2],C0,0,0,0),   P1[2],P1[3],P1[4],P1[5],     pw2[0]=PKW(P1,0), pw2[1]=PKW(P1,2), pw2); \
    VRD(6); SBAR(); GAPA(C1=__builtin_amdgcn_mfma_f32_32x32x16_bf16(kf[5],qr[2],C1,0,0,0),   P1[6],P1[7],P1[8],P1[9],     pw2[2]=PKW(P1,4), pw2[3]=PKW(P1,6), pw2); \
    VRD(3); SBAR(); GAPA(C0=__builtin_amdgcn_mfma_f32_32x32x16_bf16(kf[6],qr[3],C0,0,0,0),   P1[10],P1[11],P1[12],P1[13], pw3[0]=PKW(P1,8), pw3[1]=PKW(P1,10), pw3); \
    VRD(7); SBAR(); GAPA(C1=__builtin_amdgcn_mfma_f32_32x32x16_bf16(kf[7],qr[3],C1,0,0,0),   P1[14],P1[15],0.f,0.f,       pw3[2]=PKW(P1,12),pw3[3]=PKW(P1,14), pw3); \
    l_reg+=sacc; \
    if(GK){DMA_K((t)+3,sl_cur);} if(GV){DMA_V((t)+1,sl_next);} \
    CMASK(C0,C1,t); \
    { float a=MX3(C0[0],C0[1],C1[0]),b=MX3(C0[2],C0[3],C1[1]); a=MX3(a,C1[2],C1[3]); \
      _Pragma("unroll") for(int r=4;r<16;r+=4){a=MX3(a,C0[r],C0[r+1]);b=MX3(b,C0[r+2],C0[r+3]);a=MX3(a,C1[r],C1[r+1]);b=MX3(b,C1[r+2],C1[r+3]);} \
      float rm=__builtin_fmaxf(a,b); { auto rr=__builtin_amdgcn_permlane32_swap(__float_as_uint(rm),__float_as_uint(rm),false,false); rm=__builtin_fmaxf(__uint_as_float(rr[0]),__uint_as_float(rr[1])); } \
      resc=false; \
      if(__builtin_expect(__any(rm>(float)THRL),0)){ const float dl=__builtin_fmaxf(rm,0.f); mhat+=dl; \
        _Pragma("unroll") for(int r=0;r<16;++r){C0[r]-=dl;C1[r]-=dl;} \
        const float f=__builtin_amdgcn_exp2f(-dl); l_reg*=f; if(hi==0)wsf[r32]=f; resc=true; } } \
    SBAR(); \
    GAPB(o[0]=__builtin_amdgcn_mfma_f32_32x32x16_bf16(PAF(0),VFR(0),o[0],0,0,0), C0,0); \
    GAPB(o[1]=__builtin_amdgcn_mfma_f32_32x32x16_bf16(PAF(0),VFR(4),o[1],0,0,0), C0,4); \
    KRD(GL,0); GAPB(o[0]=__builtin_amdgcn_mfma_f32_32x32x16_bf16(PAF(1),VFR(1),o[0],0,0,0), C0,8); \
    KRD(GL,1); GAPB(o[1]=__builtin_amdgcn_mfma_f32_32x32x16_bf16(PAF(1),VFR(5),o[1],0,0,0), C0,12); \
    KRD(GL,2); GAPB(o[0]=__builtin_amdgcn_mfma_f32_32x32x16_bf16(PAF(2),VFR(2),o[0],0,0,0), C1,0); \
    KRD(GL,3); GAPB(o[1]=__builtin_amdgcn_mfma_f32_32x32x16_bf16(PAF(2),VFR(6),o[1],0,0,0), C1,4); \
    GAPB(o[0]=__builtin_amdgcn_mfma_f32_32x32x16_bf16(PAF(3),VFR(3),o[0],0,0,0), C1,8); \
    GAPB(o[1]=__builtin_amdgcn_mfma_f32_32x32x16_bf16(PAF(3),VFR(7),o[1],0,0,0), C1,12); \
    }while(0)
  int t=1;
  #undef CMASK
  #define CMASK(P0,P1,t) do{}while(0)
  for(;t+5<NT;t+=2){
    STEP(pB0,pB1,pA0,pA1,t,true,true,true);     WAIT_BAR(2); RESC(t); ROT();
    STEP(pA0,pA1,pB0,pB1,t+1,true,true,true);   WAIT_BAR(2); RESC(t+1); ROT();
  }
  #undef CMASK
  #define CMASK(P0,P1,t) do{int jb_=(t)-(NT-4); if(jb_>=0)cmask(P0,P1,jb_,qrel,hi);}while(0)
  #define ENDW(tt) do{ if((tt)+3<NT){WAIT_BAR(2);} else if((tt)+2<NT){WAIT_BAR(1);} else {WAIT_BAR(0);} }while(0)
  for(;t+1<NT;t+=2){
    STEP(pB0,pB1,pA0,pA1,t,(t+3<NT),(t+1<NT),(t+1<NT));       ENDW(t);   RESC(t); ROT();
    STEP(pA0,pA1,pB0,pB1,t+1,(t+4<NT),(t+2<NT),(t+2<NT));     ENDW(t+1); RESC(t+1); ROT();
  }
  STEP(pB0,pB1,pA0,pA1,NT-1,false,false,false); RESC(NT-1);
  { float sacc=pB0[0]+pB0[1]; _Pragma("unroll") for(int r=2;r<16;++r)sacc+=pB0[r]; _Pragma("unroll") for(int r=0;r<16;++r)sacc+=pB1[r]; l_reg+=sacc;
    pw0=(u32x4){PKW(pB0,0),PKW(pB0,2),PKW(pB0,4),PKW(pB0,6)};pw1=(u32x4){PKW(pB0,8),PKW(pB0,10),PKW(pB0,12),PKW(pB0,14)};pw2=(u32x4){PKW(pB1,0),PKW(pB1,2),PKW(pB1,4),PKW(pB1,6)};pw3=(u32x4){PKW(pB1,8),PKW(pB1,10),PKW(pB1,12),PKW(pB1,14)};
    SBAR(); pv(o,(int)(lds0+LDS_V)+((lane>>4)&1)*32+(lane&3)*8+(4*hi+((lane&15)>>2))*64+sl_cur,PAF(0),PAF(1),PAF(2),PAF(3)); }
  #undef PKW
  #undef PAF
  #undef VFR
  #undef PIN
  #undef MX3
  #undef GAPA
  #undef GAPB
  #undef EX
  #undef VRD
  #undef KRD
  #undef STEP
  #undef ENDW
  {auto rr=__builtin_amdgcn_permlane32_swap(__float_as_uint(l_reg),__float_as_uint(l_reg),false,false);l_reg=__uint_as_float(rr[0])+__uint_as_float(rr[1]);}
  if(hi==0)wsf[32+r32]=l_reg;asm volatile("s_waitcnt lgkmcnt(0)":::"memory");
  float rli[16];
  #pragma unroll
  for(int r=0;r<16;++r)rli[r]=__builtin_amdgcn_rcpf(wsf[32+crow(r,hi)]);
  bf16*Ow=O+(rowbase+q0+wid*QBLK)*DM+h*D;
  { bf16*stg=(bf16*)(shm+LDS_OST)+wid*2048;
    #pragma unroll
    for(int r=0;r<16;++r){const int orow=crow(r,hi);
      #pragma unroll
      for(int d0=0;d0<2;++d0)stg[orow*64+d0*32+r32]=__float2bfloat16(o[d0][r]*rli[r]);}
    asm volatile("s_waitcnt lgkmcnt(0)":::"memory");
    #pragma unroll
    for(int i=0;i<4;++i){const int row=i*8+(lane>>3),ch=lane&7; const u32x4 v=*(const u32x4*)(stg+row*64+ch*8); ATTN_STORE16(Ow+(long)row*DM+ch*8,v);} }
  asm volatile("s_waitcnt lgkmcnt(0)\n\ts_barrier":::"memory");
  #undef DMA_K
  #undef DMA_V
  #undef CMASK
  #undef BIASINIT
  #undef START
  #undef RESC
  #undef ROT
}
constexpr int ATTN_LDS_BYTES=LDS_BYTES;
struct AttnTensors { const bf16* Q; const bf16* K; const bf16* V; bf16* O; const float* G; const float* kmax; };
template<int THRL=8> __device__ __forceinline__ void attn_phase(char*lds,const AttnTensors&T,unsigned*counter){
  const lds_cptr shm3=(lds_cptr)lds;
  { const int t_=threadIdx.x;
    if(t_<32)*(__attribute__((address_space(3))) float*)(shm3+LDS_ORD+t_*4)=T.G[(size_t)t_*SEQ+SEQ-1];
    asm volatile("s_waitcnt vmcnt(0) lgkmcnt(0)\n\ts_barrier":::"memory");
    if(t_<32){ const float g_=*(const __attribute__((address_space(3))) float*)(shm3+LDS_ORD+t_*4); int r_=0;
      for(int j=0;j<32;++j){ const float o_=*(const __attribute__((address_space(3))) float*)(shm3+LDS_ORD+j*4); r_+=(o_<g_||(o_==g_&&j<t_))?1:0; }
      *(__attribute__((address_space(3))) int*)(shm3+LDS_ORD+128+r_*4)=t_; }
    asm volatile("s_waitcnt lgkmcnt(0)\n\ts_barrier":::"memory"); }
  for(;;){
    if(threadIdx.x==0){ const unsigned v=atomicAdd(counter,1u); *(__attribute__((address_space(3))) unsigned*)(shm3+LDS_QM+32)=v; }
    asm volatile("s_waitcnt vmcnt(0) lgkmcnt(0)\n\ts_barrier":::"memory");
    const unsigned idx=*(const __attribute__((address_space(3))) unsigned*)(shm3+LDS_QM+32);
    if(idx>=(unsigned)(BATCH*NHEAD*NQB))break;
    const int bh=*(const __attribute__((address_space(3))) int*)(shm3+LDS_ORD+128+(idx>>5)*4), qb=NQB-1-(int)(idx&31u);
    attn_unit<THRL>(bh/NHEAD,bh%NHEAD,qb,T.Q,T.K,T.V,T.O,T.G+(size_t)bh*SEQ,T.kmax[bh],lds);
  }
}
#undef SBAR
#undef WAIT_BAR
}

#define LAS __attribute__((address_space(3)))
typedef unsigned short bf16;
typedef unsigned v4u __attribute__((ext_vector_type(4)));
typedef float f32x4 __attribute__((ext_vector_type(4)));
typedef short bf16x8 __attribute__((ext_vector_type(8)));
typedef float f2v __attribute__((ext_vector_type(2)));
__device__ __forceinline__ f2v mk2(float a, float b) { f2v r; r.x = a; r.y = b; return r; }

constexpr int M = 16384, D = 1024, FF = 4096, SEQ = 8192, NPH = 25;
constexpr int TCH = 32, NCHUNK = M / TCH  , KUX = 640  ;
constexpr size_t MiB = 1u << 20;
constexpr size_t OFF_CTL = 0, OFF_BAR = 4096, ZERO_BYTES = 32768;
constexpr int LDS_MISC = 147456 - 64;
constexpr size_t OFF_LOGF = 1 * MiB, OFF_G = 2 * MiB, OFF_KMAX = 3 * MiB, OFF_WF = 3 * MiB + 4096;
constexpr size_t OFF_LAMPOW = 4 * MiB, OFF_BBAR = 4 * MiB + 1310720, OFF_KTAB = 6 * MiB;
constexpr size_t OFF_SS = OFF_KTAB;
constexpr size_t OFF_W1 = 8 * MiB, OFF_W2 = 16 * MiB, OFF_MIX = 24 * MiB, OFF_HB = 32 * MiB;
constexpr size_t OFF_K = 64 * MiB, OFF_V = 96 * MiB;
constexpr size_t OFF_A2 = 64 * MiB, OFF_WEND = 104 * MiB;
constexpr size_t OFF_A = 128 * MiB;
constexpr size_t OFF_UX = 128 * MiB, OFF_SL = 168 * MiB, OFF_Z = 192 * MiB, OFF_QO = 128 * MiB;
constexpr size_t WS_END = 256 * MiB;
constexpr int LDS_BYTES = 147456;

struct Params { const float* in[20]; float* out; unsigned char* ws; int ph_lo, ph_hi; };
enum { I_X = 0, I_MIXN, I_MLPN, I_W1, I_W2, I_LOGDT, I_ARE, I_AIM, I_BRE, I_BIM, I_CRE, I_CIM, I_DSK, I_WGLU, I_KVN, I_WKVF, I_BF, I_WQ, I_WO, I_FINN };

struct Frame { LAS unsigned char* lds; int tid, lane, wave, G; };
typedef const float* cfp_t;
__device__ __forceinline__ cfp_t kin(int i) { asm volatile("" : "+s"(i)); const __attribute__((address_space(4))) cfp_t* k = (const __attribute__((address_space(4))) cfp_t*)__builtin_amdgcn_kernarg_segment_ptr(); return k[i]; }
static_assert(offsetof(Params, in) == 0, "kin() reads Params::in at kernarg offset 0");

__device__ __forceinline__ float wave_sum(float v) {
#pragma unroll
    for (int o = 1; o < 64; o <<= 1) v += __shfl_xor(v, o);
    return v;
}
__device__ __forceinline__ unsigned pk2(float lo, float hi) { return pg8::cvt_pk_bf16(lo, hi); }
__device__ __forceinline__ float bf2f(unsigned short b) { return __uint_as_float(((unsigned)b) << 16); }

template <int MODE> __device__ __forceinline__ void conv_w(const Frame& F, const float* W, int K, int srcN, int n0, int ncols, bf16* WT, const float* gk, int b0 = 0) {
    constexpr int SP = 33;
    LAS float* scr = (LAS float*)(F.lds + F.wave * (64 * SP * 4));
    if (b0 > 0 && (int)blockIdx.x < b0) return;
    const int gw = ((int)blockIdx.x - b0) * 8 + F.wave, NGW = (F.G - b0) * 8, lane = F.lane;
    const int nblk = ncols / 32, nitems = (K / 64) * nblk;
    for (int it = gw; it < nitems; it += NGW) {
        const int kb = it / nblk, nb = it % nblk, k0 = 64 * kb, nn0 = 32 * nb;
        const float* src = W + (size_t)(k0 + (lane >> 3)) * srcN + n0 + nn0 + (lane & 7) * 4;
        f32x4 w[8];
#pragma unroll
        for (int i = 0; i < 8; ++i) w[i] = __builtin_nontemporal_load((const f32x4*)(src + (size_t)(8 * i) * srcN));
#pragma unroll
        for (int i = 0; i < 8; ++i) { const int kk = 8 * i + (lane >> 3); const float g = gk ? gk[k0 + kk] : 1.f; LAS float* d = scr + kk * SP + (lane & 7) * 4;
            d[0] = w[i][0] * g; d[1] = w[i][1] * g; d[2] = w[i][2] * g; d[3] = w[i][3] * g; }
        asm volatile("s_waitcnt lgkmcnt(0)" ::: "memory");
        const int c = lane & 7;
#pragma unroll
        for (int j = 0; j < 4; ++j) { const int n = (lane >> 3) + 8 * j; const LAS float* s = scr + (8 * c) * SP + n;
            v4u o; o.x = pk2(s[0 * SP], s[1 * SP]); o.y = pk2(s[2 * SP], s[3 * SP]); o.z = pk2(s[4 * SP], s[5 * SP]); o.w = pk2(s[6 * SP], s[7 * SP]);
            const int nn = nn0 + n; const int row = (MODE == 1) ? (((nn & 1023) >> 7) * 256 + ((nn >> 10) & 1) * 128 + (nn & 127)) : nn;
            *(v4u*)(WT + (size_t)row * K + k0 + 8 * c) = o; }
        asm volatile("s_waitcnt lgkmcnt(0)" ::: "memory");
    }
}
__device__ __forceinline__ void conv_wf(const Frame& F, const float* wkvf, const float* kvn, bf16* WF) {
    for (int e = blockIdx.x * 512 + F.tid; e < 16 * 1024; e += F.G * 512) { const int j = e >> 10, k = e & 1023; const float w = wkvf[(size_t)k * 2064 + 2048 + j] * kvn[k];
        unsigned u = __float_as_uint(w); u = (u + 0x7fffu + ((u >> 16) & 1u)) >> 16; WF[e] = (bf16)u; }
}

__device__ __forceinline__ double dconst(double c) { asm volatile("" : "+s"(c)); return c; }
__device__ __forceinline__ double exp_d(double x) {
    const double n = rint(x * dconst(1.4426950408889634074)); const double r = (x - n * dconst(6.93147180369123816490e-01)) - n * dconst(1.90821492927058770002e-10);
    double s = 1.0, t = 1.0;
#pragma unroll 1
    for (int k = 1; k <= 16; ++k) { t *= r / (double)k; s += t; }
    const long long bits = ((long long)((int)n + 1023)) << 52; return s * __longlong_as_double(bits);
}
__device__ __forceinline__ void sincos_d(double x, double& s, double& c) {
    const double q = rint(x * dconst(0.63661977236758134308)); const int qi = (int)q;
    double r = x - q * dconst(1.57079632679489655800e+00); r -= q * dconst(6.12323399573676603587e-17);
    const double r2 = r * r;
    double sr = r, cr = 1.0, ts = r, tc = 1.0;
#pragma unroll 1
    for (int n = 1; n <= 10; ++n) { ts *= -r2 / (double)((2 * n) * (2 * n + 1)); sr += ts; tc *= -r2 / (double)((2 * n - 1) * (2 * n)); cr += tc; }
    switch (qi & 3) { case 0: s = sr; c = cr; break; case 1: s = cr; c = -sr; break; case 2: s = -sr; c = -cr; break; default: s = -cr; c = sr; break; }
}
__device__ __forceinline__ void s5_tables(const Frame& F, const Params& P, int L) {
    f2v* lampow = (f2v*)(P.ws + OFF_LAMPOW); f2v* Bbar = (f2v*)(P.ws + OFF_BBAR); float* Ktab = (float*)(P.ws + OFF_KTAB);
    LAS f2v* lp = (LAS f2v*)(F.lds);
    LAS f2v* bb = lp + 64 * 33;
    LAS f2v* cc = bb + 64 * 16;
    LAS f2v* cf = cc + 16 * 64;
    for (int item = blockIdx.x; item < 256; item += F.G) { const int g = item >> 2, qt = item & 3;
        if (F.tid < 64) { const int p = F.tid; const double dt = exp_d((double)kin(I_LOGDT)[L * 64 + g]);
            const double ar = (double)kin(I_ARE)[(L * 64 + g) * 64 + p], ai = (double)kin(I_AIM)[(L * 64 + g) * 64 + p];
            const double mag = exp_d(ar * dt); double sn, cs; sincos_d(ai * dt, sn, cs); const double lr = mag * cs, li = mag * sn;
            double pr = 1.0, pi = 0.0;
            for (int tau = 0; tau <= 32; ++tau) { const f2v v = mk2((float)pr, (float)pi); lp[p * 33 + tau] = v; if (qt == 0) lampow[(size_t)(g * 64 + p) * 33 + tau] = v; const double nr = pr * lr - pi * li, ni = pr * li + pi * lr; pr = nr; pi = ni; }
            const double nr = lr - 1.0, ni = li, den = ar * ar + ai * ai; cf[p] = mk2((float)((nr * ar + ni * ai) / den), (float)((ni * ar - nr * ai) / den)); }
        __syncthreads();
        { const float* bre_ = kin(I_BRE) + (size_t)((L * 64 + g) * 64) * 16; const float* bim_ = kin(I_BIM) + (size_t)((L * 64 + g) * 64) * 16; const float* cre_ = kin(I_CRE) + (size_t)(L * 64 + g) * 1024; const float* cim_ = kin(I_CIM) + (size_t)(L * 64 + g) * 1024;
          for (int e = F.tid; e < 1024; e += 512) { const int p = e >> 4; const float br = bre_[e], bi = bim_[e]; const f2v c = cf[p];
            const f2v v = mk2(c.x * br - c.y * bi, c.x * bi + c.y * br); bb[e] = v; if (qt == 0) Bbar[(size_t)g * 1024 + e] = v;
            cc[e] = mk2(cre_[e], cim_[e]); } }
        __syncthreads();
        { const float* dsk_ = kin(I_DSK) + L * 1024 + 16 * g;
          for (int e = qt * 2048 + F.tid; e < (qt + 1) * 2048; e += 512) { const int tau = e >> 8, cp = (e >> 4) & 15, c = e & 15; float acc = 0.f;
            for (int p = 0; p < 64; ++p) { const f2v C = cc[cp * 64 + p], l = lp[p * 33 + tau], B = bb[p * 16 + c]; const float tr = C.x * l.x - C.y * l.y, ti = C.x * l.y + C.y * l.x; acc += tr * B.x - ti * B.y; }
            if (tau == 0 && cp == c) acc += dsk_[c];
            Ktab[(size_t)g * 8192 + e] = acc; } }
        __syncthreads();
    }
}
__device__ __forceinline__ void s5_expand(const Frame& F, const Params& P, int L) {
    const f2v* lampow = (const f2v*)(P.ws + OFF_LAMPOW); const f2v* Bbar = (const f2v*)(P.ws + OFF_BBAR); const float* Ktab = (const float*)(P.ws + OFF_KTAB);
    bf16* A2 = (bf16*)(P.ws + OFF_A2); bf16* Wend = (bf16*)(P.ws + OFF_WEND);
    const int gt = blockIdx.x * 512 + F.tid, GT = F.G * 512;
    const float* cre_ = kin(I_CRE) + (size_t)L * 65536; const float* cim_ = kin(I_CIM) + (size_t)L * 65536;
#pragma unroll 4
    for (int ch = gt; ch < 32768 * 64; ch += GT) { const int row = ch >> 6, c8 = (ch & 63) * 8, g = row >> 9, tc = row & 511, t = tc >> 4, cp = tc & 15, s = c8 >> 4, c0 = c8 & 15;
        const int lag = (t - s) < 0 ? 0 : (t - s); const float* kp = Ktab + ((size_t)(g * 32 + lag) * 256 + cp * 16 + c0); f32x4 a = *(const f32x4*)kp, b = *(const f32x4*)(kp + 4);
        if (s > t) { a = (f32x4){0.f, 0.f, 0.f, 0.f}; b = a; }
        v4u o; o.x = pk2(a[0], a[1]); o.y = pk2(a[2], a[3]); o.z = pk2(b[0], b[1]); o.w = pk2(b[2], b[3]);
        *(v4u*)(A2 + (size_t)row * KUX + c8) = o; }
#pragma unroll 2
    for (int ch = gt; ch < 32768 * 16; ch += GT) { const int row = ch >> 4, j = (ch & 15) * 8, g = row >> 9, tc = row & 511, t = tc >> 4, cp = tc & 15, im = j >> 6, p0 = j & 63; float v[8];
        const size_t ci = (size_t)(g * 16 + cp) * 64 + p0; const f32x4 cr0 = *(const f32x4*)(cre_ + ci), cr1 = *(const f32x4*)(cre_ + ci + 4), ci0 = *(const f32x4*)(cim_ + ci), ci1 = *(const f32x4*)(cim_ + ci + 4);
#pragma unroll
        for (int e = 0; e < 8; ++e) { const float cr = e < 4 ? cr0[e & 3] : cr1[e & 3], cim = e < 4 ? ci0[e & 3] : ci1[e & 3]; const f2v l = lampow[(size_t)(g * 64 + p0 + e) * 33 + t + 1];
            v[e] = im ? -(cr * l.y + cim * l.x) : (cr * l.x - cim * l.y); }
        v4u o; o.x = pk2(v[0], v[1]); o.y = pk2(v[2], v[3]); o.z = pk2(v[4], v[5]); o.w = pk2(v[6], v[7]);
        *(v4u*)(A2 + (size_t)row * KUX + 512 + j) = o; }
#pragma unroll 2
    for (int ch = gt; ch < 16384 * 64; ch += GT) { const int row = ch >> 6, c8 = (ch & 63) * 8, g = row >> 8, rho = row & 255, s = c8 >> 4, c0 = c8 & 15, p = rho & 63, im = (rho >> 6) & 1; float v[8];
        const f2v l = lampow[(size_t)(g * 64 + p) * 33 + 31 - s]; const f2v* Bp = Bbar + (size_t)(g * 64 + p) * 16 + c0;
#pragma unroll
        for (int e = 0; e < 8; ++e) { const f2v B = Bp[e]; const float x = im ? (l.x * B.y + l.y * B.x) : (l.x * B.x - l.y * B.y); v[e] = (rho < 128) ? x : 0.f; }
        v4u o; o.x = pk2(v[0], v[1]); o.y = pk2(v[2], v[3]); o.z = pk2(v[4], v[5]); o.w = pk2(v[6], v[7]);
        *(v4u*)(Wend + (size_t)row * 512 + c8) = o; }
}
template <bool BF> __device__ __forceinline__ void phase_normu(const Frame& F, const void* hin, const float* gw, bf16* UX) {
    constexpr int PITCH = 1032;
    LAS bf16* tile = (LAS bf16*)F.lds;
    for (int n = blockIdx.x; n < NCHUNK; n += F.G) {
        f32x4 v[4][4]; float ss[4];
#pragma unroll
        for (int q = 0; q < 4; ++q) { const size_t ro = (size_t)(TCH * n + F.wave * 4 + q) * D;
            if (BF) { const v4u* xr = (const v4u*)((const bf16*)hin + ro) + 2 * F.lane; const v4u a = __builtin_nontemporal_load(xr), b = __builtin_nontemporal_load(xr + 1);
                v[q][0] = (f32x4){pg8::bflo(a.x), pg8::bfhi(a.x), pg8::bflo(a.y), pg8::bfhi(a.y)}; v[q][1] = (f32x4){pg8::bflo(a.z), pg8::bfhi(a.z), pg8::bflo(a.w), pg8::bfhi(a.w)};
                v[q][2] = (f32x4){pg8::bflo(b.x), pg8::bfhi(b.x), pg8::bflo(b.y), pg8::bfhi(b.y)}; v[q][3] = (f32x4){pg8::bflo(b.z), pg8::bfhi(b.z), pg8::bflo(b.w), pg8::bfhi(b.w)}; }
            else { const f32x4* xr = (const f32x4*)((const float*)hin + ro) + F.lane;
#pragma unroll
                for (int j = 0; j < 4; ++j) v[q][j] = __builtin_nontemporal_load(xr + 64 * j); } }
#pragma unroll
        for (int q = 0; q < 4; ++q) { float s = 0.f;
#pragma unroll
            for (int j = 0; j < 4; ++j) s += (v[q][j][0] * v[q][j][0] + v[q][j][1] * v[q][j][1]) + (v[q][j][2] * v[q][j][2] + v[q][j][3] * v[q][j][3]);
            ss[q] = pg8::rstd_of(wave_sum(s)); }
#pragma unroll
        for (int j = 0; j < 4; ++j) { const int e0 = BF ? (16 * F.lane + 4 * j) : (4 * (F.lane + 64 * j)); const f32x4 g4 = *(const f32x4*)(gw + e0);
#pragma unroll
            for (int q = 0; q < 4; ++q) { const f32x4 u = v[q][j] * ss[q] * g4; LAS unsigned* dst = (LAS unsigned*)(tile + (F.wave * 4 + q) * PITCH + e0); dst[0] = pk2(u[0], u[1]); dst[1] = pk2(u[2], u[3]); } }
        __syncthreads();
#pragma unroll 1
        for (int pass = 0; pass < 8; ++pass) { const int g = pass * 8 + (F.tid >> 6), s = (F.tid & 63) >> 1, half = F.tid & 1;
            const v4u val = *(const LAS v4u*)(tile + s * PITCH + 16 * g + 8 * half);
            *(v4u*)(UX + (size_t)(g * NCHUNK + n) * KUX + s * 16 + 8 * half) = val; }
        __syncthreads();
    }
}
__device__ __forceinline__ void phase_scan(const Frame& F, const Params& P) {
    const f2v* lampow = (const f2v*)(P.ws + OFF_LAMPOW); const float* Sl = (const float*)(P.ws + OFF_SL); bf16* UX = (bf16*)(P.ws + OFF_UX);
    for (int bg = F.wave * F.G + blockIdx.x; bg < 128; bg += 8 * F.G) { const int b = bg >> 6, g = bg & 63, p = F.lane;
        const f2v lt = lampow[(size_t)(g * 64 + p) * 33 + 32]; float xr = 0.f, xi = 0.f;
        const float* sl = Sl + (size_t)(g * NCHUNK + b * 256) * 128 + p; bf16* ux = UX + (size_t)(g * NCHUNK + b * 256) * KUX + 512 + p;
#pragma unroll 1
        for (int k0 = 0; k0 < 256; k0 += 8) { float sr[8], si[8];
#pragma unroll
            for (int j = 0; j < 8; ++j) { sr[j] = sl[(size_t)(k0 + j) * 128]; si[j] = sl[(size_t)(k0 + j) * 128 + 64]; }
#pragma unroll
            for (int j = 0; j < 8; ++j) { const unsigned w = pk2(xr, xi); ux[(size_t)(k0 + j) * KUX] = (bf16)(w & 0xffffu); ux[(size_t)(k0 + j) * KUX + 64] = (bf16)(w >> 16);
                const float nr = lt.x * xr - lt.y * xi + sr[j], ni = lt.x * xi + lt.y * xr + si[j]; xr = nr; xi = ni; } }
    }
}
__device__ __forceinline__ void phase_flogit(const Frame& F, const Params& P, const float* ss) {
    const bf16* hb = (const bf16*)(P.ws + OFF_HB); const bf16* WF = (const bf16*)(P.ws + OFF_WF); float* logf = (float*)(P.ws + OFF_LOGF);
    const int r = F.lane & 15, kq = F.lane >> 4; const float* bf_ = kin(I_BF);
    for (int task = blockIdx.x * 8 + F.wave; task < M / 16; task += F.G * 8) { const int row = task * 16 + r; f32x4 acc = {0.f, 0.f, 0.f, 0.f};
        const bf16* ap = hb + (size_t)row * D + kq * 8; const bf16* bp = WF + (size_t)r * D + kq * 8;
#pragma unroll 8
        for (int ks = 0; ks < 32; ++ks) { const bf16x8 a = *(const bf16x8*)(ap + ks * 32), b = *(const bf16x8*)(bp + ks * 32); acc = __builtin_amdgcn_mfma_f32_16x16x32_bf16(b, a, acc, 0, 0, 0); }
        const float rs = pg8::rstd_slots(ss, row, 16, kq); f32x4 o;
#pragma unroll
        for (int i = 0; i < 4; ++i) { const float x = acc[i] * rs + bf_[4 * kq + i]; o[i] = fminf(x, 0.f) - 0.6931471805599453f * __builtin_amdgcn_logf(1.0f + __builtin_amdgcn_exp2f(-1.4426950408889634f * fabsf(x))); }
        *(f32x4*)(logf + (size_t)row * 16 + 4 * kq) = o; }
}
__device__ __forceinline__ void phase_fscan(const Frame& F, const Params& P) {
    const float* logf = (const float*)(P.ws + OFF_LOGF); float* Gt = (float*)(P.ws + OFF_G); float* kmax = (float*)(P.ws + OFF_KMAX); const bf16* Kb = (const bf16*)(P.ws + OFF_K);
    LAS float* wsum = (LAS float*)F.lds; LAS float* wmax = wsum + 8;
    for (int bh = blockIdx.x; bh < 32; bh += F.G) { const int b = bh >> 4, h = bh & 15, t0 = F.tid * 16; float v[16]; float s = 0.f;
#pragma unroll
        for (int i = 0; i < 16; ++i) { v[i] = -1.4426950408889634f * logf[(size_t)(b * SEQ + t0 + i) * 16 + h]; s += v[i]; }
        float incl = s;
#pragma unroll
        for (int o = 1; o < 64; o <<= 1) { const float t = __shfl_up(incl, o); if (F.lane >= o) incl += t; }
        float km = 0.f;
#pragma unroll 4
        for (int i = 0; i < 16; ++i) { const bf16* kp = Kb + (size_t)(b * SEQ + t0 + i) * D + 64 * h; float q = 0.f;
#pragma unroll
            for (int c = 0; c < 8; ++c) { const bf16x8 kv = *(const bf16x8*)(kp + 8 * c);
#pragma unroll
                for (int e = 0; e < 8; ++e) { const float f = bf2f((unsigned short)kv[e]); q += f * f; } }
            km = fmaxf(km, q); }
#pragma unroll
        for (int o = 1; o < 64; o <<= 1) km = fmaxf(km, __shfl_xor(km, o));
        if (F.lane == 63) wsum[F.wave] = incl;
        if (F.lane == 0) wmax[F.wave] = km;
        __syncthreads();
        float base = 0.f, kmx = 0.f;
#pragma unroll
        for (int w = 0; w < 8; ++w) { if (w < F.wave) base += wsum[w]; kmx = fmaxf(kmx, wmax[w]); }
        float run = base + incl - s;
#pragma unroll
        for (int i = 0; i < 16; ++i) { run += v[i]; v[i] = run; }
#pragma unroll
        for (int i = 0; i < 4; ++i) *(f32x4*)(Gt + (size_t)bh * SEQ + t0 + 4 * i) = (f32x4){v[4 * i], v[4 * i + 1], v[4 * i + 2], v[4 * i + 3]};
        if (F.tid == 0) kmax[bh] = sqrtf(kmx);
        __syncthreads();
    }
}
__device__ __forceinline__ void phase_final(const Frame& F, const bf16* hb, float* out, const float* gw) {
    f32x4 g4[4];
#pragma unroll
    for (int j = 0; j < 4; ++j) g4[j] = *(const f32x4*)(gw + 16 * F.lane + 4 * j);
    const int stride = F.G * 8;
    for (int m0 = blockIdx.x * 8 + F.wave; m0 < M; m0 += 2 * stride) { v4u a[2], b[2];
#pragma unroll
        for (int r = 0; r < 2; ++r) { const int m = (m0 + r * stride < M) ? m0 + r * stride : m0; const v4u* xr = (const v4u*)(hb + (size_t)m * D) + 2 * F.lane; a[r] = __builtin_nontemporal_load(xr); b[r] = __builtin_nontemporal_load(xr + 1); }
#pragma unroll
        for (int r = 0; r < 2; ++r) { const int m = m0 + r * stride; if (m >= M) break; f32x4 v[4];
            v[0] = (f32x4){pg8::bflo(a[r].x), pg8::bfhi(a[r].x), pg8::bflo(a[r].y), pg8::bfhi(a[r].y)}; v[1] = (f32x4){pg8::bflo(a[r].z), pg8::bfhi(a[r].z), pg8::bflo(a[r].w), pg8::bfhi(a[r].w)};
            v[2] = (f32x4){pg8::bflo(b[r].x), pg8::bfhi(b[r].x), pg8::bflo(b[r].y), pg8::bfhi(b[r].y)}; v[3] = (f32x4){pg8::bflo(b[r].z), pg8::bfhi(b[r].z), pg8::bflo(b[r].w), pg8::bfhi(b[r].w)};
            float ss = 0.f;
#pragma unroll
            for (int j = 0; j < 4; ++j) ss += (v[j][0] * v[j][0] + v[j][1] * v[j][1]) + (v[j][2] * v[j][2] + v[j][3] * v[j][3]);
            const float rstd = pg8::rstd_of(wave_sum(ss)); f32x4* o = (f32x4*)(out + (size_t)m * D + 16 * F.lane);
#pragma unroll
            for (int j = 0; j < 4; ++j) o[j] = v[j] * rstd * g4[j]; } }
}

__device__ __forceinline__ void conv_w1(const Frame& F, const Params& P, int L, int b0 = 0) { conv_w<0>(F, kin(I_W1) + (size_t)L * D * FF, D, FF, 0, FF, (bf16*)(P.ws + OFF_W1), kin(I_MLPN) + L * D, b0); }
__device__ __forceinline__ void conv_w2(const Frame& F, const Params& P, int L, int b0 = 0) { conv_w<0>(F, kin(I_W2) + (size_t)L * FF * D, FF, D, 0, D, (bf16*)(P.ws + OFF_W2), nullptr, b0); }
__device__ __forceinline__ void conv_glu(const Frame& F, const Params& P, int L) { conv_w<1>(F, kin(I_WGLU) + (size_t)L * D * 2 * D, D, 2 * D, 0, 2 * D, (bf16*)(P.ws + OFF_MIX), nullptr); }
__device__ __forceinline__ void conv_attn(const Frame& F, const Params& P, int j, bool with_kv) {
    bf16* mix = (bf16*)(P.ws + OFF_MIX);
    conv_w<0>(F, kin(I_WQ) + (size_t)j * D * D, D, D, 0, D, mix, kin(I_MIXN) + (2 + j) * D);
    conv_w<0>(F, kin(I_WO) + (size_t)j * D * D, D, D, 0, D, mix + (size_t)3 * D * D, nullptr);
    if (with_kv) { conv_w<0>(F, kin(I_WKVF), D, 2064, 0, 2 * D, mix + (size_t)D * D, kin(I_KVN)); conv_wf(F, kin(I_WKVF), kin(I_KVN), (bf16*)(P.ws + OFF_WF)); }
}
__device__ __forceinline__ bool side_jobs(const Frame& F, const Params& P, int ph) {
    switch (ph) {
    case 0:  s5_tables(F, P, 0); conv_glu(F, P, 0); return true;
    case 2:  { const int b0 = (F.G > 128) ? 128 : 0; conv_w1(F, P, 0, b0); conv_w2(F, P, 0, b0); } return true;
    case 5:  conv_glu(F, P, 1); return true;
    case 6:  s5_tables(F, P, 1); return true;
    case 8:  { const int b0 = (F.G > 128) ? 128 : 0; conv_w1(F, P, 1, b0); conv_w2(F, P, 1, b0); } return true;
    case 11: conv_attn(F, P, 0, true); return true;
    case 14: { const int b0 = (F.G > 32) ? 32 : 0; conv_w1(F, P, 2, b0); conv_w2(F, P, 2, b0); } return true;
    case 17: conv_attn(F, P, 1, false); return true;
    case 18: conv_w1(F, P, 3); return true;
    case 19: conv_w2(F, P, 3); return true;
    default: return false;
    }
}

#define XB_TMO      128
#define XB_XCNT(j)  (256  + 64 * (j))
#define XB_XSUB(j)  (1280 + 64 * (j))
#define XB_XGEN(j)  (2304 + 64 * (j))
#define XB_TOP      3328
#define XB_TOPGEN   3392
#define XCD_BAR_WORDS 3456
#define XB_SPIN_CAP (1u << 18)

__device__ __forceinline__ unsigned xb_ld(unsigned* p)              { return __hip_atomic_load(p, __ATOMIC_RELAXED, __HIP_MEMORY_SCOPE_AGENT); }
__device__ __forceinline__ unsigned xb_add(unsigned* p, unsigned v) { return __hip_atomic_fetch_add(p, v, __ATOMIC_RELAXED, __HIP_MEMORY_SCOPE_AGENT); }
__device__ __forceinline__ unsigned xb_xcc_id() { return (unsigned)__builtin_amdgcn_s_getreg((3 << 11) | 20) & 0xFu; }
#define XB_SPIN(cond, bar) do { unsigned _sp = 0; while (cond) { __builtin_amdgcn_s_sleep(1); \
    if ((++_sp & 255u) == 0u) { if (xb_ld(&(bar)[XB_TMO])) break; if (_sp > XB_SPIN_CAP) { atomicAdd(&(bar)[XB_TMO], 1u); break; } } } } while (0)

struct XcdBarrier {
    unsigned* bar; unsigned x;
    volatile LAS unsigned* st;
};

__device__ __forceinline__ XcdBarrier xcd_barrier_post(unsigned* bar, volatile LAS unsigned* st) {
    XcdBarrier b; b.bar = bar; b.x = xb_xcc_id(); b.st = st;
    if (threadIdx.x == 0) (void)xb_add(&bar[XB_XCNT(b.x)], 1u);
    return b;
}
__device__ __forceinline__ void xcd_barrier_complete(unsigned* bar, unsigned x, unsigned& nloc, unsigned& nx) {
    const unsigned G = gridDim.x * gridDim.y * gridDim.z;
    unsigned sum, cnt, mine, sp = 0u;
    for (;;) {
        sum = 0u; cnt = 0u; mine = 0u;
#pragma unroll
        for (unsigned j = 0; j < 16; ++j) { const unsigned c = xb_ld(&bar[XB_XCNT(j)]); sum += c; cnt += (c > 0u) ? 1u : 0u; mine = (j == x) ? c : mine; }
        if (sum == G) break;
        __builtin_amdgcn_s_sleep(1);
        if ((++sp & 255u) == 0u) { if (xb_ld(&bar[XB_TMO])) break; if (sp > XB_SPIN_CAP) { atomicAdd(&bar[XB_TMO], 1u); break; } }
    }
    nloc = mine > 0u ? mine : 1u; nx = cnt > 0u ? cnt : 1u;
}

__device__ __forceinline__ void xcd_barrier(const XcdBarrier& b) {
    asm volatile("s_waitcnt vmcnt(0)" ::: "memory");
    __syncthreads();
    if (ltid() == 0) {
        unsigned* bar = b.bar;
        __builtin_amdgcn_s_waitcnt(0);
        unsigned nloc = b.st[0], nx = b.st[1];
        if (nloc == 0u) { xcd_barrier_complete(bar, b.x, nloc, nx); b.st[0] = nloc; b.st[1] = nx; }
        const unsigned old = xb_add(&bar[XB_XSUB(b.x)], 1u);
        const unsigned gen = old / nloc;
        if (old + 1u == (gen + 1u) * nloc) {
            __builtin_amdgcn_fence(__ATOMIC_RELEASE, "agent");
            asm volatile("s_waitcnt vmcnt(0)" ::: "memory");
            const unsigned og = xb_add(&bar[XB_TOP], 1u);
            const unsigned tg = og / nx;
            if (og + 1u == (tg + 1u) * nx) xb_add(&bar[XB_TOPGEN], 1u);
            else XB_SPIN(xb_ld(&bar[XB_TOPGEN]) == tg, bar);
            __builtin_amdgcn_fence(__ATOMIC_ACQUIRE, "agent");
            xb_add(&bar[XB_XGEN(b.x)], 1u);
            asm volatile("s_waitcnt vmcnt(0)" ::: "memory");
        } else {
            XB_SPIN(xb_ld(&bar[XB_XGEN(b.x)]) == gen, bar);
            __builtin_amdgcn_fence(__ATOMIC_ACQUIRE, "agent");
            asm volatile("s_waitcnt vmcnt(0)" ::: "memory");
        }
    }
    __syncthreads();
}

constexpr int LDS_RSTD = 131072 + 1024;
template <class Sched> __device__ __forceinline__ void precompute_rstd(const Frame& F, const Sched& S, const float* ss, int ns) {
    LAS float* rb = (LAS float*)(F.lds + LDS_RSTD); pg8::Unit u;
    for (int i = 0; i < 8 && S.next(i, u); ++i) { const int row = F.tid >> 1, half = F.tid & 1; const f32x4* p = (const f32x4*)(ss + (size_t)(u.pm * 256 + row) * ns + half * (ns >> 1));
        f32x4 v = p[0]; float s = (v[0] + v[1]) + (v[2] + v[3]); v = p[1]; s += (v[0] + v[1]) + (v[2] + v[3]);
        if (ns == 32) { v = p[2]; s += (v[0] + v[1]) + (v[2] + v[3]); v = p[3]; s += (v[0] + v[1]) + (v[2] + v[3]); }
        s += __shfl_xor(s, 1); if (!half) rb[i * 256 + row] = pg8::rstd_of(s); }
    __syncthreads();
}

__global__ void __launch_bounds__(512, 2) trunk_fwd(Params P) {
    extern __shared__ __attribute__((aligned(16))) unsigned char lds[];
    Frame F; F.lds = (LAS unsigned char*)lds; F.G = gridDim.x;
    volatile LAS unsigned* bst = (volatile LAS unsigned*)((LAS unsigned char*)lds + LDS_MISC);
    if (threadIdx.x < 2) bst[threadIdx.x] = 0u;
    __syncthreads();
    const bool one_launch = (P.ph_hi - P.ph_lo) > 1;
    XcdBarrier bar; bar.bar = (unsigned*)(P.ws + OFF_BAR); bar.x = 0; bar.st = bst;
    if (one_launch) bar = xcd_barrier_post((unsigned*)(P.ws + OFF_BAR), bst);
    unsigned char* ws = P.ws;
    float* ssp = (float*)(ws + OFF_SS);
    bf16* HB = (bf16*)(ws + OFF_HB);
    bool dup_done = false;
    for (int ph = P.ph_lo; ph < P.ph_hi; ++ph) {
        F.tid = ltid(); F.lane = F.tid & 63; F.wave = __builtin_amdgcn_readfirstlane(F.tid >> 6); { int g_ = (int)gridDim.x; asm volatile("" : "+s"(g_)); F.G = g_; }
        int kind, L;
        if (ph == 0) { kind = 0; L = 0; }
        else if (ph <= 12) { L = (ph - 1) / 6; const int k = (ph - 1) % 6; kind = (k < 2) ? 1 + k : 2 + k; }
        else if (ph <= 18) { L = 2; const int k = ph - 13; kind = (k < 4) ? 8 + k : 2 + k; }
        else if (ph <= 23) { L = 3; const int k = ph - 19; kind = (k == 0) ? 8 : (k <= 2 ? 9 + k : 3 + k); }
        else { kind = 12; L = 3; }
        if (DBG_SIDE_REPS > 1 && !dup_done) { side_jobs(F, P, ph); asm volatile("s_waitcnt vmcnt(0) lgkmcnt(0)" ::: "memory"); __syncthreads(); }
        if (((DBG_KM >> 0) & 1) && !dup_done && side_jobs(F, P, ph)) { asm volatile("s_waitcnt vmcnt(0) lgkmcnt(0)" ::: "memory"); __syncthreads(); }
        switch (kind) {
        case 1: if constexpr ((DBG_KM >> 1) & 1) { s5_expand(F, P, L); if (L == 0) phase_normu<false>(F, kin(I_X), kin(I_MIXN), (bf16*)(ws + OFF_UX)); else phase_normu<true>(F, HB, kin(I_MIXN) + L * D, (bf16*)(ws + OFF_UX)); } break;
        case 2: if constexpr ((DBG_KM >> 2) & 1) { pg8::Gemm g{(const bf16*)(ws + OFF_UX), (const bf16*)(ws + OFF_WEND), KUX, 512, 512}; pg8::OrderSloc S{F.G, (int)blockIdx.x};
                  pg8::EpiSlocScan E{(const pg8::f2v_t*)(ws + OFF_LAMPOW), (bf16*)(ws + OFF_UX)};
                  pg8::gemm_phase<pg8::EpiSlocScan, pg8::OrderSloc, true, true>(F.lds, g, S, E); } break;
        case 4: if constexpr ((DBG_KM >> 4) & 1) { pg8::Gemm g{(const bf16*)(ws + OFF_UX), (const bf16*)(ws + OFF_A2), KUX, KUX, KUX}; pg8::OrderY S{F.G, (int)blockIdx.x}; pg8::EpiY E{(bf16*)(ws + OFF_Z)};
                  pg8::gemm_phase<pg8::EpiY, pg8::OrderY, true, true>(F.lds, g, S, E); } break;
        case 5: if constexpr ((DBG_KM >> 5) & 1) { pg8::Gemm g{(const bf16*)(ws + OFF_Z), (const bf16*)(ws + OFF_MIX), 16, D, D, M * 32, 4 * M * 32, 16 * M * 32};      pg8::StaticOrder S; S.init(M, 2 * D, F.G, (int)blockIdx.x);
                  pg8::EpiRes<true> E{(L == 0) ? kin(I_X) : (const float*)nullptr, HB, ssp};
                  pg8::gemm_phase<pg8::EpiRes<true>, pg8::StaticOrder, true, true>(F.lds, g, S, E); } break;
        case 6: if constexpr ((DBG_KM >> 6) & 1) { const int ns = (L < 2) ? 32 : 16;
                  pg8::Gemm g{HB, (const bf16*)(ws + OFF_W1), D, D, D}; pg8::StaticOrder S; S.init(M, FF, F.G, (int)blockIdx.x); precompute_rstd(F, S, ssp, ns); pg8::EpiMLP1 E{(bf16*)(ws + OFF_A), (const LAS float*)(F.lds + LDS_RSTD)};
                  pg8::gemm_phase<pg8::EpiMLP1, pg8::StaticOrder, true, true>(F.lds, g, S, E); } break;
        case 7: case 11: if constexpr ((DBG_KM >> 7) & 1) { const bool mlp = (kind == 7); const bool need_ss = !(mlp && (L == 0 || L == 3));
                  pg8::Gemm g{mlp ? (const bf16*)(ws + OFF_A) : (const bf16*)(ws + OFF_Z), mlp ? (const bf16*)(ws + OFF_W2) : (const bf16*)(ws + OFF_MIX) + (size_t)3 * D * D, mlp ? 256 : D, mlp ? FF : D, mlp ? FF : D, 32, 128, mlp ? M * 512 : 512};
                  pg8::StaticOrder S; S.init(M, D, F.G, (int)blockIdx.x); pg8::EpiRes<false> E{(const float*)nullptr, HB, need_ss ? ssp : (float*)nullptr};
                  pg8::gemm_phase<pg8::EpiRes<false>, pg8::StaticOrder, true, true>(F.lds, g, S, E); } break;
        case 8: if constexpr ((DBG_KM >> 8) & 1) { const float* ss = ssp;
                  if (L == 2) phase_flogit(F, P, ss);
                  pg8::Gemm g{HB, (const bf16*)(ws + OFF_MIX), D, D, D}; pg8::StaticOrder S; S.init(M, (L == 2) ? 3 * D : D, F.G, (int)blockIdx.x);
                  static_assert(OFF_V == OFF_K + 32 * MiB && OFF_QO == OFF_K + 64 * MiB, "EpiQKV slot map"); precompute_rstd(F, S, ss, 16); pg8::EpiQKV E{(bf16*)(ws + OFF_K), (const LAS float*)(F.lds + LDS_RSTD), attn_body::C2};
                  pg8::gemm_phase<pg8::EpiQKV, pg8::StaticOrder, true, true>(F.lds, g, S, E); } break;
        case 9: if constexpr ((DBG_KM >> 9) & 1) { phase_fscan(F, P); } break;
        case 10: if constexpr ((DBG_KM >> 10) & 1) { const attn_body::AttnTensors AT{(const attn_body::bf16*)(ws + OFF_QO), (const attn_body::bf16*)(ws + OFF_K), (const attn_body::bf16*)(ws + OFF_V), (attn_body::bf16*)(ws + OFF_Z), (const float*)(ws + OFF_G), (const float*)(ws + OFF_KMAX)};
                  attn_body::attn_phase<32>((char*)lds, AT, (unsigned*)(ws + OFF_CTL) + 64 * (L - 2) + (dup_done ? 128 : 0)); } break;
        case 12: if constexpr ((DBG_KM >> 12) & 1) { phase_final(F, HB, P.out, kin(I_FINN)); } break;
        default: break;
        }
        if (DBG_DUP != 0u) { if (((DBG_DUP >> kind) & 1u) && !dup_done) { dup_done = true; --ph; xcd_barrier(bar); continue; } dup_done = false; }
        if (ph + 1 < P.ph_hi) {
            for (int r_ = 0; r_ < DBG_SYNC_REPS; ++r_) xcd_barrier(bar);
        }
        if (P.ph_hi < 0) cg::this_grid().sync();
    }
}

extern "C" void kernel_launch(void* const* d_in, const int* in_sizes, int n_in, void* d_out, int out_size, void* d_ws, size_t ws_size, hipStream_t stream) {
    static int grid = 0;
    if (grid == 0) {
        if (n_in != 20 || in_sizes[0] != M * D || out_size != M * D || ws_size < WS_END) { fprintf(stderr, "kernel_launch: unexpected shapes (n_in %d, in0 %d, out %d, ws %zu); nothing launched\n", n_in, n_in > 0 ? in_sizes[0] : -1, out_size, ws_size); grid = -1; return; }
        int dev = 0, cus = 0, per_cu = 0;
        if (hipGetDevice(&dev) != hipSuccess || hipDeviceGetAttribute(&cus, hipDeviceAttributeMultiprocessorCount, dev) != hipSuccess) { grid = -1; return; }
        if (hipFuncSetAttribute((const void*)trunk_fwd, hipFuncAttributeMaxDynamicSharedMemorySize, LDS_BYTES) != hipSuccess) { fprintf(stderr, "kernel_launch: hipFuncSetAttribute failed\n"); grid = -1; return; }
        if (hipOccupancyMaxActiveBlocksPerMultiprocessor(&per_cu, (const void*)trunk_fwd, 512, LDS_BYTES) != hipSuccess || per_cu < 1) { fprintf(stderr, "kernel_launch: occupancy query says %d\n", per_cu); per_cu = 1; }
        (void)hipGetLastError();
        grid = cus * per_cu;
    }
    if (grid < 0) return;
    (void)hipMemsetAsync((char*)d_ws + OFF_CTL, 0, ZERO_BYTES, stream);
    Params p{};
    for (int i = 0; i < 20; ++i) p.in[i] = (const float*)d_in[i];
    p.out = (float*)d_out; p.ws = (unsigned char*)d_ws;
#if MK_MULTI_LAUNCH
    for (int ph = 0; ph < NPH; ++ph) { p.ph_lo = ph; p.ph_hi = ph + 1; hipLaunchKernelGGL(trunk_fwd, dim3(grid), dim3(512), LDS_BYTES, stream, p); }
#else
    p.ph_lo = 0; p.ph_hi = NPH;
    void* args[] = {&p};
    const hipError_t e = hipLaunchCooperativeKernel((const void*)trunk_fwd, dim3(grid), dim3(512), args, LDS_BYTES, stream);
    if (e != hipSuccess) fprintf(stderr, "kernel_launch: cooperative launch failed: %s (grid %d)\n", hipGetErrorString(e), grid);
#endif
}
```

```cpp
#include <hip/hip_runtime.h>
#include <hip/hip_cooperative_groups.h>
#include <hip/hip_bf16.h>
#include <cstdio>
#include <cstdint>
#include <cmath>
namespace cg = cooperative_groups;
#ifndef MK_MULTI_LAUNCH
#define MK_MULTI_LAUNCH 0
#endif
__device__ __forceinline__ int ltid() { int t = (int)threadIdx.x; asm volatile("" : "+v"(t)); return t; }
#ifndef DBG_KM
#define DBG_KM 0xffffu
#endif
#ifndef DBG_SYNC_REPS
#define DBG_SYNC_REPS 1
#endif
#ifndef DBG_DUP
#define DBG_DUP 0u
#endif
#ifndef DBG_SIDE_REPS
#define DBG_SIDE_REPS 1
#endif
#ifndef DBG_PROBE
#define DBG_PROBE 0
#endif
namespace pg8 {
#define PG8_LAS __attribute__((address_space(3)))
typedef unsigned short bf16_t;
typedef short bf16x8 __attribute__((ext_vector_type(8)));
typedef float f32x4 __attribute__((ext_vector_type(4)));
typedef unsigned u32x4 __attribute__((ext_vector_type(4)));
constexpr int BM = 256, BK = 64, HALF = 128, HTB = HALF * BK * 2  , STAGE_BYTES = 8 * HTB, NXCD = 8, WGM = 8;

__host__ __device__ __forceinline__ int lds_byte(int r, int c) { const int st = (r >> 4) * 2 + (c >> 5), rr = r & 15, cc = c & 31, ob = rr * 64 + cc * 2; return st * 1024 + (ob ^ (((ob >> 9) & 1) << 5)); }
__host__ __device__ __forceinline__ void stage_rc(int b, int& R, int& C) { const int st = b / 1024, sb = b % 1024, swz = sb ^ (((sb >> 9) & 1) << 5); R = (st >> 1) * 16 + swz / 64; C = (st & 1) * 32 + (swz % 64) / 2; }
__host__ __device__ __forceinline__ int perm32(int rho) { const int n = rho >> 4, i = rho & 15; return 8 * (i >> 2) + 4 * n + (i & 3); }

struct Unit { int pm, pn; };
struct Gemm { const bf16_t* A; const bf16_t* Bt; int lda, ldb, K; int a_gs = 32, a_ks = 128, a_ts = 512; };

struct StaticOrder {
    int nM, nN, nwg, G, c;
    __host__ __device__ void init(int M, int N, int G_, int c_) { nM = M / BM; nN = N / BM; nwg = nM * nN; G = G_; c = c_; }
    __host__ __device__ bool next(int i, Unit& u) const {
        const long L = (long)i * G + c; if (L >= nwg) return false;
        int wgid = (int)L; { const int q = nwg / NXCD, r = nwg % NXCD, xcd = wgid % NXCD, off = wgid / NXCD; wgid = (xcd < r ? xcd * (q + 1) : r * (q + 1) + (xcd - r) * q) + off; }
        const int nig = WGM * nN, gid = wgid / nig, fm = gid * WGM, gsz = (nM - fm) < WGM ? (nM - fm) : WGM;
        u.pm = fm + ((wgid % nig) % gsz); u.pn = (wgid % nig) / gsz; return true;
    }
    __device__ __forceinline__ void a_ready(const Unit&) const {}
    __device__ __forceinline__ void done(const Unit&) const {}
};

typedef float cvt_f32x2_t __attribute__((ext_vector_type(2))); typedef __bf16 cvt_bf16x2_t __attribute__((ext_vector_type(2)));
__device__ __forceinline__ unsigned cvt_pk_bf16(float lo, float hi) { const cvt_f32x2_t v = {lo, hi}; const cvt_bf16x2_t b = __builtin_convertvector(v, cvt_bf16x2_t); return __builtin_bit_cast(unsigned, b); }
typedef float f32x2 __attribute__((ext_vector_type(2)));
__device__ __forceinline__ f32x2 gelu_pk(f32x2 v) {
    const f32x2 av = __builtin_elementwise_abs(v), d = av * 0.2316418882f + 1.0f;
    f32x2 t; t.x = __builtin_amdgcn_rcpf(d.x); t.y = __builtin_amdgcn_rcpf(d.y);
    f32x2 q = t * 0.5307027145f + (-0.7265760135f); q = q * t + 0.7107068705f; q = q * t + (-0.142248368f); q = q * t + 0.127414796f; q = q * t;
    const f32x2 s = (v * v) * (-0.72134752044f);
    f32x2 e; e.x = __builtin_amdgcn_exp2f(s.x); e.y = __builtin_amdgcn_exp2f(s.y);
    const f32x2 m = v * (q * e), r = v - m;
    f32x2 o; o.x = v.x < 0.f ? m.x : r.x; o.y = v.y < 0.f ? m.y : r.y; return o;
}

template <int ACT  > struct EpiBf16 {
    static constexpr bool PERM = true, AFTER_DRAIN = false; static_assert(ACT == 0 || ACT == 1, "EpiBf16: ACT is 0 (none) or 1 (gelu_pk)");
    bf16_t* O; int ldc; const float* bias; int split_cols; size_t split_stride; float scale0;
    __device__ __forceinline__ void operator()(const f32x4 (&acc)[2][2][4][2], const Unit& u, int wr, int wc, int fr, int fq) const {
        const int row0 = u.pm * BM + wr * 64 + fr; int colt = u.pn * BM; bf16_t* base = O;
        float sc = 1.f; if (split_cols) { const int t = colt / split_cols; base += (size_t)t * split_stride; colt -= t * split_cols; if (t == 0) sc = scale0; }
        const int col0 = colt + wc * 32 + 8 * fq, bcol0 = u.pn * BM + wc * 32 + 8 * fq;
        f32x4 bv[2][2];
#pragma unroll
        for (int bj = 0; bj < 2; ++bj)
#pragma unroll
            for (int n = 0; n < 2; ++n) bv[bj][n] = bias ? *(const f32x4*)(bias + bcol0 + bj * HALF + 4 * n) : (f32x4){0.f, 0.f, 0.f, 0.f};
#pragma unroll
        for (int ai = 0; ai < 2; ++ai)
#pragma unroll
            for (int m = 0; m < 4; ++m) { bf16_t* rowp = base + (size_t)(row0 + ai * HALF + m * 16) * ldc + col0;
#pragma unroll
                for (int bj = 0; bj < 2; ++bj) { f32x4 v0 = acc[ai][bj][m][0] + bv[bj][0], v1 = acc[ai][bj][m][1] + bv[bj][1];
                    if (ACT == 1) { f32x2 a = gelu_pk((f32x2){v0[0], v0[1]}), b = gelu_pk((f32x2){v0[2], v0[3]}), c = gelu_pk((f32x2){v1[0], v1[1]}), d = gelu_pk((f32x2){v1[2], v1[3]});
                        v0 = (f32x4){a.x, a.y, b.x, b.y}; v1 = (f32x4){c.x, c.y, d.x, d.y}; }
                    v0 = v0 * sc; v1 = v1 * sc; u32x4 w; w.x = cvt_pk_bf16(v0[0], v0[1]); w.y = cvt_pk_bf16(v0[2], v0[3]); w.z = cvt_pk_bf16(v1[0], v1[1]); w.w = cvt_pk_bf16(v1[2], v1[3]);
                    *(u32x4*)(rowp + bj * HALF) = w; } }
    }
};


constexpr float RMS_EPS_F = 1e-6f;
__device__ __forceinline__ float rstd_of(float ss) { return 1.0f / sqrtf(ss * (1.0f / 1024.0f) + RMS_EPS_F); }
__device__ __forceinline__ float rstd_slots(const float* ss, int row, int ns, int fq) {
    const f32x4* p = (const f32x4*)(ss + (size_t)row * ns + fq * (ns >> 2)); f32x4 v = p[0]; float s = (v[0] + v[1]) + (v[2] + v[3]);
    if (ns == 32) { v = p[1]; s += (v[0] + v[1]) + (v[2] + v[3]); }
    s += __shfl_xor(s, 16); s += __shfl_xor(s, 32); return rstd_of(s); }
__device__ __forceinline__ u32x4 pack8(f32x4 v0, f32x4 v1) { u32x4 w; w.x = cvt_pk_bf16(v0[0], v0[1]); w.y = cvt_pk_bf16(v0[2], v0[3]); w.z = cvt_pk_bf16(v1[0], v1[1]); w.w = cvt_pk_bf16(v1[2], v1[3]); return w; }
__device__ __forceinline__ float fast_sigmoid(float x) { return __builtin_amdgcn_rcpf(1.0f + __builtin_amdgcn_exp2f(-1.4426950408889634f * x)); }
__device__ __forceinline__ f32x2 gelu_tanh2(f32x2 y) {
    const f32x2 t = y * y, u = y * (t * (-0.10294324f) + (-2.3022082f));
    f32x2 e; e.x = __builtin_amdgcn_exp2f(u.x); e.y = __builtin_amdgcn_exp2f(u.y);
    const f32x2 d = e + 1.0f; f32x2 r; r.x = __builtin_amdgcn_rcpf(d.x); r.y = __builtin_amdgcn_rcpf(d.y);
    return y * r;
}

struct EpiQKV {
    static constexpr bool PERM = true, AFTER_DRAIN = false;
    bf16_t* Kb; const PG8_LAS float* rb; float scale0; mutable int ui = 0;
    __device__ __forceinline__ void operator()(const f32x4 (&acc)[2][2][4][2], const Unit& u, int wr, int wc, int fr, int fq) const {
        int colt = u.pn * BM; const int t = colt >> 10; colt &= 1023; const int slot = (t == 0) ? 2 : (t - 1); bf16_t* base = Kb + (size_t)slot * (16u << 20); const float sc = (t == 0) ? scale0 : 1.f;
        const int col0 = colt + wc * 32 + 8 * fq, row0 = u.pm * BM + wr * 64 + fr;
        const PG8_LAS float* rq = rb + ui * 256; ++ui;
#pragma unroll
        for (int ai = 0; ai < 2; ++ai)
#pragma unroll
            for (int m = 0; m < 4; ++m) { const int row = row0 + ai * HALF + m * 16; const float rs = rq[wr * 64 + fr + ai * HALF + m * 16] * sc; bf16_t* rowp = base + (size_t)row * 1024 + col0;
#pragma unroll
                for (int bj = 0; bj < 2; ++bj) *(u32x4*)(rowp + bj * HALF) = pack8(acc[ai][bj][m][0] * rs, acc[ai][bj][m][1] * rs); }
    }
};
struct EpiMLP1 {
    static constexpr bool PERM = true, AFTER_DRAIN = false;
    bf16_t* O; const PG8_LAS float* rb; mutable int ui = 0;
    __device__ __forceinline__ void operator()(const f32x4 (&acc)[2][2][4][2], const Unit& u, int wr, int wc, int fr, int fq) const {
        const int row0 = u.pm * BM + wr * 64 + fr; const PG8_LAS float* rq = rb + ui * 256; ++ui;
#pragma unroll
        for (int ai = 0; ai < 2; ++ai)
#pragma unroll
            for (int m = 0; m < 4; ++m) { const int row = row0 + ai * HALF + m * 16; const float rs = rq[wr * 64 + fr + ai * HALF + m * 16]; bf16_t* rowp = O + ((size_t)u.pn * 16384 + row) * 256 + wc * 32 + 8 * fq;
#pragma unroll
                for (int bj = 0; bj < 2; ++bj) { f32x4 v0 = acc[ai][bj][m][0] * rs, v1 = acc[ai][bj][m][1] * rs;
#pragma unroll
                    for (int e = 0; e < 4; ++e) { const float a = fmaxf(v0[e], 0.f), b = fmaxf(v1[e], 0.f); v0[e] = a * a; v1[e] = b * b; }
                    *(u32x4*)(rowp + bj * HALF) = pack8(v0, v1); } }
    }
};
__device__ __forceinline__ float bflo(unsigned w) { return __uint_as_float(w << 16); }
__device__ __forceinline__ float bfhi(unsigned w) { return __uint_as_float(w & 0xffff0000u); }
template <bool GLU> struct EpiRes {
    static constexpr bool PERM = true, AFTER_DRAIN = false;
    const float* hin32; bf16_t* hb; float* ss;
    __device__ __forceinline__ void operator()(const f32x4 (&acc)[2][2][4][2], const Unit& u, int wr, int wc, int fr, int fq) const {
        constexpr int NB = GLU ? 1 : 2;
        const int row0 = u.pm * BM + wr * 64 + fr, colb = GLU ? (u.pn * HALF + wc * 32 + 8 * fq) : (u.pn * BM + wc * 32 + 8 * fq);
#pragma unroll
        for (int ai = 0; ai < 2; ++ai) {
            f32x4 r0[4][NB], r1[4][NB];
            if (hin32) {
#pragma unroll
                for (int m = 0; m < 4; ++m)
#pragma unroll
                    for (int bj = 0; bj < NB; ++bj) { const size_t off = (size_t)(row0 + ai * HALF + m * 16) * 1024 + colb + bj * HALF; r0[m][bj] = __builtin_nontemporal_load((const f32x4*)(hin32 + off)); r1[m][bj] = __builtin_nontemporal_load((const f32x4*)(hin32 + off + 4)); }
            } else { u32x4 w[4][NB];
#pragma unroll
                for (int m = 0; m < 4; ++m)
#pragma unroll
                    for (int bj = 0; bj < NB; ++bj) w[m][bj] = *(const u32x4*)(hb + (size_t)(row0 + ai * HALF + m * 16) * 1024 + colb + bj * HALF);
#pragma unroll
                for (int m = 0; m < 4; ++m)
#pragma unroll
                    for (int bj = 0; bj < NB; ++bj) { const u32x4 x = w[m][bj]; r0[m][bj] = (f32x4){bflo(x.x), bfhi(x.x), bflo(x.y), bfhi(x.y)}; r1[m][bj] = (f32x4){bflo(x.z), bfhi(x.z), bflo(x.w), bfhi(x.w)}; } }
#pragma unroll
            for (int m = 0; m < 4; ++m) { const int row = row0 + ai * HALF + m * 16; float s = 0.f;
#pragma unroll
                for (int bj = 0; bj < NB; ++bj) { const size_t off = (size_t)row * 1024 + colb + bj * HALF; f32x4 o[2] = {r0[m][bj], r1[m][bj]};
#pragma unroll
                    for (int n = 0; n < 2; ++n) { f32x4 v = acc[ai][bj][m][n];
                        if (GLU) { const f32x4 gt = acc[ai][1][m][n];
#pragma unroll
                            for (int e = 0; e < 4; ++e) v[e] = v[e] * fast_sigmoid(gt[e]); }
                        o[n] = o[n] + v;
                        s += (o[n][0] * o[n][0] + o[n][1] * o[n][1]) + (o[n][2] * o[n][2] + o[n][3] * o[n][3]); }
                    *(u32x4*)(hb + off) = pack8(o[0], o[1]); }
                s += __shfl_xor(s, 16); s += __shfl_xor(s, 32);
                if (ss && fq == 0) ss[(size_t)row * (GLU ? 32 : 16) + u.pn * 4 + wc] = s; } }
    }
};
typedef float f2v_t __attribute__((ext_vector_type(2)));
struct EpiSlocScan {
    static constexpr bool PERM = true, AFTER_DRAIN = true;
    const f2v_t* lampow; bf16_t* UX;
    __device__ __forceinline__ void fused(f32x4 (&acc)[2][2][4][2], const Unit& u, int wr, int wc, int fr, int fq, PG8_LAS unsigned char* lds, int wid, int lane) const {
        constexpr int TP = 132;
        PG8_LAS float* T = (PG8_LAS float*)lds; const int col = wc * 32 + 8 * fq;
#pragma unroll
        for (int ai = 0; ai < 2; ++ai)
#pragma unroll
            for (int m = 0; m < 4; ++m) { const int n = ai * HALF + wr * 64 + m * 16 + fr; PG8_LAS float* p = T + n * TP + col;
                *(PG8_LAS f32x4*)(p) = acc[ai][0][m][0]; *(PG8_LAS f32x4*)(p + 4) = acc[ai][0][m][1]; }
        asm volatile("s_waitcnt lgkmcnt(0)" ::: "memory"); __builtin_amdgcn_s_barrier(); asm volatile("" ::: "memory");
        { const int g = u.pn, p = lane; const f2v_t lt = lampow[(size_t)(g * 64 + p) * 33 + 32]; float xr = 0.f, xi = 0.f;
          PG8_LAS float* Tw = T + (wid * 32) * TP + p; PG8_LAS float* E = T + 256 * TP;
#pragma unroll 4
          for (int k = 0; k < 32; ++k) { const float sr = Tw[k * TP], si = Tw[k * TP + 64]; const float nr = lt.x * xr - lt.y * xi + sr, ni = lt.x * xi + lt.y * xr + si; xr = nr; xi = ni; }
          E[wid * 128 + p] = xr; E[wid * 128 + 64 + p] = xi;
          f2v_t l32 = lt;
#pragma unroll
          for (int q = 0; q < 5; ++q) { const float a = l32.x * l32.x - l32.y * l32.y, b = 2.f * l32.x * l32.y; l32.x = a; l32.y = b; }
          asm volatile("s_waitcnt lgkmcnt(0)" ::: "memory"); __builtin_amdgcn_s_barrier(); asm volatile("" ::: "memory");
          xr = 0.f; xi = 0.f;
          for (int v = 0; v < wid; ++v) { const float er = E[v * 128 + p], ei = E[v * 128 + 64 + p]; const float nr = l32.x * xr - l32.y * xi + er, ni = l32.x * xi + l32.y * xr + ei; xr = nr; xi = ni; }
          bf16_t* ux = UX + (size_t)(u.pm * 256 + wid * 32) * 640 + 512 + p;
#pragma unroll 4
          for (int k = 0; k < 32; ++k) { const float sr = Tw[k * TP], si = Tw[k * TP + 64]; const unsigned w = cvt_pk_bf16(xr, xi);
              ux[(size_t)k * 640] = (bf16_t)(w & 0xffffu); ux[(size_t)k * 640 + 64] = (bf16_t)(w >> 16);
              const float nr = lt.x * xr - lt.y * xi + sr, ni = lt.x * xi + lt.y * xr + si; xr = nr; xi = ni; } }
    }
};
struct EpiY {
    static constexpr bool PERM = true, AFTER_DRAIN = false;
    bf16_t* Z;
    __device__ __forceinline__ void operator()(const f32x4 (&acc)[2][2][4][2], const Unit& u, int wr, int wc, int fr, int fq) const {
        const int g = u.pm >> 1, i = u.pm & 1, j = u.pn & 1;
#pragma unroll
        for (int ai = 0; ai < 2; ++ai)
#pragma unroll
            for (int m = 0; m < 4; ++m) { const int n = 256 * i + ai * HALF + wr * 64 + m * 16 + fr;
#pragma unroll
                for (int bj = 0; bj < 2; ++bj) { const int cc = 256 * j + 128 * bj + 32 * wc + 8 * fq, t = cc >> 4, c0 = cc & 15;
                    f32x4 v0 = acc[ai][bj][m][0], v1 = acc[ai][bj][m][1];
                    { const f32x2 a = gelu_tanh2((f32x2){v0[0], v0[1]}), b = gelu_tanh2((f32x2){v0[2], v0[3]}), c = gelu_tanh2((f32x2){v1[0], v1[1]}), d = gelu_tanh2((f32x2){v1[2], v1[3]});
                      v0 = (f32x4){a.x, a.y, b.x, b.y}; v1 = (f32x4){c.x, c.y, d.x, d.y}; }
                    *(u32x4*)(Z + ((size_t)g * 16384 + (32 * n + t)) * 16 + c0) = pack8(v0, v1); } }
    }
};
struct OrderSloc {
    int G, c;
    __device__ __forceinline__ bool next(int i, Unit& u) const { const int L = i * G + c; if (L >= 128) return false;
        int g, h; if (G >= 128 && (G & 7) == 0) { const int x = L & 7, sl = L >> 3; g = x * 8 + (sl >> 1); h = sl & 1; } else { g = L >> 1; h = L & 1; }
        u.pm = 2 * g + h; u.pn = g; return true; }
    __device__ __forceinline__ void a_ready(const Unit&) const {}
    __device__ __forceinline__ void done(const Unit&) const {}
};
struct OrderY {
    int G, c;
    __device__ __forceinline__ bool next(int i, Unit& u) const { const int L = i * G + c; if (L >= 256) return false;
        int g, q; if (G == 256) { const int x = L & 7, sl = L >> 3; g = x * 8 + (sl >> 2); q = sl & 3; } else { g = L >> 2; q = L & 3; }
        u.pm = 2 * g + (q >> 1); u.pn = 2 * g + (q & 1); return true; }
    __device__ __forceinline__ void a_ready(const Unit&) const {}
    __device__ __forceinline__ void done(const Unit&) const {}
};

template <class Epi, class Sched, bool ALIGN_EPI = false, bool SP2 = false>
__device__ __forceinline__ void gemm_phase(PG8_LAS unsigned char* lds, const Gemm g, const Sched& S, const Epi& E) {
    const int tid = ltid(), wid = __builtin_amdgcn_readfirstlane(tid >> 6), lane = tid & 63, wr = wid >> 2, wc = wid & 3, fr = lane & 15, fq = lane >> 4;
    const int K = g.K, nt = K / BK;
    unsigned voffA[2], voffB[2];
#pragma unroll
    for (int i = 0; i < 2; ++i) { int R, C; stage_rc(tid * 16 + i * 8192, R, C); const int Rb = Epi::PERM ? ((R & ~31) + perm32(R & 31)) : R;
        voffA[i] = (unsigned)(R * g.lda * 2 + (C >> 4) * g.a_gs + (C & 15) * 2); voffB[i] = (unsigned)(Rb * g.ldb + C) * 2u; }
    const size_t kstep = (size_t)(BK * 2);
#define PG8_AOFF(x) ((size_t)((x) >> 2) * (size_t)g.a_ts + (size_t)((x) & 3) * (size_t)g.a_ks)
    const size_t hstepA = (size_t)HALF * g.lda * 2, hstepB = (size_t)HALF * g.ldb * 2;
    const size_t tstepA = 2 * hstepA, tstepB = 2 * hstepB;
    const unsigned ldsw = (unsigned)wid * 1024u;
    const int aoff = lds_byte(wr * 64 + fr, fq * 8), boff = lds_byte(wc * 32 + fr, fq * 8);
#define PG8_SA(b, h) (((b) * 2 + (h)) * HTB)
#define PG8_SB(b, h) ((4 + (b) * 2 + (h)) * HTB)
#define PG8_STAGE(bufoff, gbase, voff) do { _Pragma("unroll") for (int _i = 0; _i < 2; ++_i) \
        __builtin_amdgcn_global_load_lds((const unsigned*)((const char*)(gbase) + (voff)[_i]), (PG8_LAS unsigned*)(lds + (bufoff) + ldsw + _i * 8192), 16, 0, 0); } while (0)
#define PG8_LDA(dst, b, h) do { _Pragma("unroll") for (int m = 0; m < 4; ++m) _Pragma("unroll") for (int k = 0; k < 2; ++k) dst[m][k] = *(const PG8_LAS bf16x8*)(lds + PG8_SA(b, h) + aoff + m * 2048 + k * 1024); } while (0)
#define PG8_LDB(dst, b, h) do { _Pragma("unroll") for (int n = 0; n < 2; ++n) _Pragma("unroll") for (int k = 0; k < 2; ++k) dst[n][k] = *(const PG8_LAS bf16x8*)(lds + PG8_SB(b, h) + boff + n * 2048 + k * 1024); } while (0)
#define PG8_MMA(ai, bj, At, Bt) do { __builtin_amdgcn_s_setprio(1); _Pragma("unroll") for (int m = 0; m < 4; ++m) _Pragma("unroll") for (int n = 0; n < 2; ++n) _Pragma("unroll") for (int k = 0; k < 2; ++k) \
        acc[ai][bj][m][n] = __builtin_amdgcn_mfma_f32_16x16x32_bf16(Bt[n][k], At[m][k], acc[ai][bj][m][n], 0, 0, 0); __builtin_amdgcn_s_setprio(0); } while (0)
#define PG8_WAIT_V(n) asm volatile("s_waitcnt vmcnt(" #n ")" ::: "memory")
#define PG8_WAIT_L(n) asm volatile("s_waitcnt lgkmcnt(" #n ")" ::: "memory")
#define PG8_BAR __builtin_amdgcn_s_barrier()
#define PG8_SCHED __builtin_amdgcn_sched_barrier(0)
    Unit cur, nxt; int ui = 0;
    if (!S.next(0, cur)) return;
    f32x4 acc[2][2][4][2];
#pragma unroll
    for (int a = 0; a < 2; ++a)
#pragma unroll
        for (int b = 0; b < 2; ++b)
#pragma unroll
            for (int m = 0; m < 4; ++m)
#pragma unroll
                for (int n = 0; n < 2; ++n) acc[a][b][m][n] = (f32x4){0.f, 0.f, 0.f, 0.f};
    bf16x8 At[4][2], B0[2][2], B1[2][2];
    const char* cA = (const char*)g.A + (size_t)cur.pm * tstepA; const char* cB = (const char*)g.Bt + (size_t)cur.pn * tstepB;
    S.a_ready(cur);
    if constexpr (SP2) {
        PG8_STAGE(PG8_SB(0, 0), cB, voffB); PG8_STAGE(PG8_SB(0, 1), cB + hstepB, voffB); PG8_STAGE(PG8_SA(0, 0), cA, voffA); PG8_STAGE(PG8_SA(0, 1), cA + hstepA, voffA);
        if (wr == 1) PG8_BAR;
        PG8_WAIT_V(2); PG8_BAR;
        PG8_STAGE(PG8_SB(1, 0), cB + kstep, voffB); PG8_STAGE(PG8_SA(1, 0), cA + PG8_AOFF(1), voffA); PG8_STAGE(PG8_SB(1, 1), cB + hstepB + kstep, voffB);
        PG8_WAIT_V(6); PG8_BAR;
    } else {
        PG8_STAGE(PG8_SB(0, 0), cB, voffB); PG8_STAGE(PG8_SA(0, 0), cA, voffA); PG8_STAGE(PG8_SB(0, 1), cB + hstepB, voffB); PG8_STAGE(PG8_SA(0, 1), cA + hstepA, voffA);
        if (wr == 1) PG8_BAR;
        PG8_WAIT_V(4); PG8_BAR;
        PG8_STAGE(PG8_SB(1, 0), cB + kstep, voffB); PG8_STAGE(PG8_SA(1, 0), cA + PG8_AOFF(1), voffA); PG8_STAGE(PG8_SB(1, 1), cB + hstepB + kstep, voffB);
        PG8_WAIT_V(6); PG8_BAR;
    }
    for (;;) {
        const bool has_next = S.next(ui + 1, nxt);
        const char* nA = has_next ? (const char*)g.A + (size_t)nxt.pm * tstepA : cA; const char* nB = has_next ? (const char*)g.Bt + (size_t)nxt.pn * tstepB : cB;
        for (int t = 0; t < nt; t += 2) {
            const bool last = (t == nt - 2);
            const char* a1 = cA + PG8_AOFF(t + 1);
            const char* a2 = last ? nA : cA + PG8_AOFF(t + 2); const char* b2 = last ? nB : cB + (size_t)(t + 2) * kstep;
            const char* a3 = a2 + (size_t)g.a_ks; const char* b3 = b2 + kstep;
            if (last && has_next) S.a_ready(nxt);
            if constexpr (SP2) {
            PG8_LDB(B0, 0, 0); PG8_LDB(B1, 0, 1); PG8_SCHED; PG8_LDA(At, 0, 0); PG8_STAGE(PG8_SA(1, 1), a1 + hstepA, voffA);
            PG8_WAIT_V(8); PG8_WAIT_L(0); PG8_BAR; PG8_MMA(0, 0, At, B0); PG8_MMA(0, 1, At, B1); PG8_BAR; PG8_SCHED;
            PG8_LDA(At, 0, 1); PG8_STAGE(PG8_SB(0, 0), b2, voffB); PG8_STAGE(PG8_SB(0, 1), b2 + hstepB, voffB); PG8_STAGE(PG8_SA(0, 0), a2, voffA);
            PG8_WAIT_V(8); PG8_WAIT_L(0); PG8_BAR; PG8_MMA(1, 0, At, B0); PG8_MMA(1, 1, At, B1); PG8_BAR; PG8_SCHED;
            PG8_LDB(B0, 1, 0); PG8_LDB(B1, 1, 1); PG8_SCHED; PG8_LDA(At, 1, 0); PG8_STAGE(PG8_SA(0, 1), a2 + hstepA, voffA);
            PG8_WAIT_V(8); PG8_WAIT_L(0); PG8_BAR; PG8_MMA(0, 0, At, B0); PG8_MMA(0, 1, At, B1); PG8_BAR; PG8_SCHED;
            PG8_LDA(At, 1, 1); PG8_STAGE(PG8_SB(1, 0), b3, voffB); PG8_STAGE(PG8_SB(1, 1), b3 + hstepB, voffB); PG8_STAGE(PG8_SA(1, 0), a3, voffA);
            PG8_WAIT_V(8); PG8_WAIT_L(0); PG8_BAR; PG8_MMA(1, 0, At, B0); PG8_MMA(1, 1, At, B1); PG8_BAR; PG8_SCHED;
            } else {
            PG8_LDB(B0, 0, 0); PG8_SCHED; PG8_LDA(At, 0, 0); PG8_STAGE(PG8_SA(1, 1), a1 + hstepA, voffA);
            PG8_WAIT_L(8); PG8_BAR; PG8_WAIT_L(0); PG8_MMA(0, 0, At, B0); PG8_BAR; PG8_SCHED;
            PG8_LDB(B1, 0, 1); PG8_STAGE(PG8_SB(0, 0), b2, voffB);
            PG8_BAR; PG8_WAIT_L(0); PG8_MMA(0, 1, At, B1); PG8_BAR;
            PG8_LDA(At, 0, 1); PG8_STAGE(PG8_SA(0, 0), a2, voffA);
            PG8_BAR; PG8_WAIT_L(0); PG8_MMA(1, 0, At, B0); PG8_BAR; PG8_SCHED;
            PG8_STAGE(PG8_SB(0, 1), b2 + hstepB, voffB);
            PG8_WAIT_V(6); PG8_BAR; PG8_MMA(1, 1, At, B1); PG8_BAR;
            PG8_LDB(B0, 1, 0); PG8_SCHED; PG8_LDA(At, 1, 0); PG8_STAGE(PG8_SA(0, 1), a2 + hstepA, voffA);
            PG8_WAIT_L(8); PG8_BAR; PG8_WAIT_L(0); PG8_MMA(0, 0, At, B0); PG8_BAR; PG8_SCHED;
            PG8_LDB(B1, 1, 1); PG8_STAGE(PG8_SB(1, 0), b3, voffB);
            PG8_BAR; PG8_WAIT_L(0); PG8_MMA(0, 1, At, B1); PG8_BAR;
            PG8_LDA(At, 1, 1); PG8_STAGE(PG8_SA(1, 0), a3, voffA);
            PG8_BAR; PG8_WAIT_L(0); PG8_MMA(1, 0, At, B0); PG8_BAR; PG8_SCHED;
            PG8_STAGE(PG8_SB(1, 1), b3 + hstepB, voffB);
            PG8_WAIT_V(6); PG8_BAR; PG8_MMA(1, 1, At, B1); PG8_BAR;
            }
        }
        if constexpr (ALIGN_EPI) { if (wr == 0) PG8_BAR; }
        if constexpr (!Epi::AFTER_DRAIN) { E(acc, cur, wr, wc, fr, fq); S.done(cur); }
        if (!has_next) break;
#pragma unroll
        for (int a = 0; a < 2; ++a)
#pragma unroll
            for (int b = 0; b < 2; ++b)
#pragma unroll
                for (int m = 0; m < 4; ++m)
#pragma unroll
                    for (int n = 0; n < 2; ++n) acc[a][b][m][n] = (f32x4){0.f, 0.f, 0.f, 0.f};
        cur = nxt; cA = nA; cB = nB; ++ui;
        if constexpr (ALIGN_EPI) { if (wr == 1) PG8_BAR; }
    }
    PG8_WAIT_V(0);
    if constexpr (!ALIGN_EPI) { if (wr == 0) PG8_BAR; }
    PG8_BAR;
    if constexpr (Epi::AFTER_DRAIN) { E.fused(acc, cur, wr, wc, fr, fq, lds, wid, lane); S.done(cur); }
#undef PG8_AOFF
#undef PG8_SA
#undef PG8_SB
#undef PG8_STAGE
#undef PG8_LDA
#undef PG8_LDB
#undef PG8_MMA
#undef PG8_WAIT_V
#undef PG8_WAIT_L
#undef PG8_BAR
#undef PG8_SCHED
}
}
namespace attn_body {
using bf16=__hip_bfloat16;
using bf16x8=__attribute__((ext_vector_type(8)))short;
using s16x4=__attribute__((ext_vector_type(4)))short;
using f32x16=__attribute__((ext_vector_type(16)))float;
using u32x4=__attribute__((ext_vector_type(4)))unsigned;
using f32x4_t=__attribute__((ext_vector_type(4)))float;
constexpr int BATCH=2,NHEAD=16,SEQ=8192,D=64,DM=NHEAD*D;
constexpr int NW=8,QBLK=32,QB=QBLK*NW,KVBLK=64,NQB=SEQ/QB;
constexpr int ATTN_PITCH=DM, ATTN_UNIT_ROWS=QB;
__device__ __forceinline__ int crow(int r,int hi){return (r&3)+8*(r>>2)+4*hi;}
#define SBAR() __builtin_amdgcn_sched_barrier(0)
__device__ __forceinline__ void cmask(f32x16&p0,f32x16&p1,int jb,int qrel,int hi){
  const float NEG=-INFINITY; int kb=64*jb+4*hi;
  #pragma unroll
  for(int r=0;r<16;++r){int kv=kb+(r&3)+8*(r>>2); if(kv>qrel)p0[r]=NEG; if(kv+32>qrel)p1[r]=NEG;}
}

constexpr int NSLOT=3, SLOTB=8192;
constexpr int LDS_K=0, LDS_V=NSLOT*SLOTB, LDS_WS=2*NSLOT*SLOTB, LDS_OST=LDS_WS+NW*64*4, LDS_GT=LDS_OST+NW*4096, LDS_QM=LDS_GT+SEQ*4, LDS_CF=LDS_QM+64, LDS_ORD=LDS_CF+512, LDS_BYTES=LDS_ORD+256;
constexpr float C2=0.125f*1.4426950408889634f;
__device__ __forceinline__ void glds16(const void*gsrc,unsigned lds_dst){unsigned keep;
  asm volatile("s_mov_b32 %0, m0\n\ts_mov_b32 m0, %2\n\ts_nop 0\n\tglobal_load_lds_dwordx4 %1, off\n\ts_mov_b32 m0, %0":"=&s"(keep):"v"(gsrc),"s"(lds_dst):"memory");}
__device__ __forceinline__ float max3f(float a,float b,float c){float r;asm("v_max3_f32 %0, %1, %2, %3":"=v"(r):"v"(a),"v"(b),"v"(c));return r;}
__device__ __forceinline__ float max2f(float a,float b){float r;asm("v_max_f32_e32 %0, %1, %2":"=v"(r):"v"(a),"v"(b));return r;}
__device__ __forceinline__ float fadd_s(float a,float b){float r;asm("v_add_f32_e32 %0, %1, %2":"=v"(r):"v"(a),"v"(b));return r;}
__device__ __forceinline__ float fsub_s(float a,float b){float r;asm("v_sub_f32_e32 %0, %1, %2":"=v"(r):"v"(a),"v"(b));return r;}
typedef float f32x2_t __attribute__((ext_vector_type(2))); typedef __bf16 bf16x2_t __attribute__((ext_vector_type(2)));
__device__ __forceinline__ unsigned cvtpk_s(float lo,float hi){f32x2_t v={lo,hi};bf16x2_t b=__builtin_convertvector(v,bf16x2_t);return __builtin_bit_cast(unsigned,b);}
#define WAIT_BAR(N) asm volatile("s_waitcnt vmcnt(" #N ") lgkmcnt(0)\n\ts_barrier":::"memory")

__device__ __forceinline__ void qkt(f32x16&p0,f32x16&p1,const char*Kslot,const bf16x8*qr,int r32,int hi){
  const char*kb=Kslot+hi*1024+r32*16;
  #pragma unroll
  for(int d0=0;d0<4;++d0){
    const bf16x8 b0=*reinterpret_cast<const bf16x8*>(kb+d0*2048);
    const bf16x8 b1=*reinterpret_cast<const bf16x8*>(kb+d0*2048+512);
    {p0=__builtin_amdgcn_mfma_f32_32x32x16_bf16(b0,qr[d0],p0,0,0,0);p1=__builtin_amdgcn_mfma_f32_32x32x16_bf16(b1,qr[d0],p1,0,0,0);}}
}
typedef __attribute__((address_space(3))) const char* lds_cptr;
typedef short v4i16_t __attribute__((ext_vector_type(4)));
__device__ __forceinline__ void kload8(bf16x8*kf,lds_cptr kp){
  kf[0]=*(const __attribute__((address_space(3))) bf16x8*)(kp);      kf[1]=*(const __attribute__((address_space(3))) bf16x8*)(kp+512);
  kf[2]=*(const __attribute__((address_space(3))) bf16x8*)(kp+2048); kf[3]=*(const __attribute__((address_space(3))) bf16x8*)(kp+2560);
  kf[4]=*(const __attribute__((address_space(3))) bf16x8*)(kp+4096); kf[5]=*(const __attribute__((address_space(3))) bf16x8*)(kp+4608);
  kf[6]=*(const __attribute__((address_space(3))) bf16x8*)(kp+6144); kf[7]=*(const __attribute__((address_space(3))) bf16x8*)(kp+6656);
}
__device__ __forceinline__ void kload2(bf16x8*kf,lds_cptr kp,int j){ kf[2*j]=*(const __attribute__((address_space(3))) bf16x8*)(kp+j*2048); kf[2*j+1]=*(const __attribute__((address_space(3))) bf16x8*)(kp+j*2048+512); }
__device__ __forceinline__ s16x4 vtr(lds_cptr p){ return __builtin_bit_cast(s16x4,__builtin_amdgcn_ds_read_tr16_b64_v4i16((__attribute__((address_space(3))) v4i16_t*)p)); }
__device__ __forceinline__ float rowmax(const f32x16&p0,const f32x16&p1){
  float a=max3f(p0[0],p0[1],p1[0]),b=max3f(p0[2],p0[3],p1[1]);a=max3f(a,p1[2],p1[3]);
  #pragma unroll
  for(int r=4;r<16;r+=4){a=max3f(a,p0[r],p0[r+1]);b=max3f(b,p0[r+2],p0[r+3]);a=max3f(a,p1[r],p1[r+1]);b=max3f(b,p1[r+2],p1[r+3]);}
  const float m=max2f(a,b);
  auto rr=__builtin_amdgcn_permlane32_swap(__float_as_uint(m),__float_as_uint(m),false,false);
  return max2f(__uint_as_float(rr[0]),__uint_as_float(rr[1]));
}
__device__ __forceinline__ void pv(f32x16*o,int vb,bf16x8 pa0,bf16x8 pa1,bf16x8 pa2,bf16x8 pa3){
  #pragma unroll
  for(int d0=0;d0<2;++d0){s16x4 lo[4],hi[4];
    #pragma unroll
    for(int ks=0;ks<4;++ks){
      asm volatile("ds_read_b64_tr_b16 %0,%1 offset:%c2":"=&v"(lo[ks]):"v"(vb),"i"(d0*4096+ks*1024):"memory");
      asm volatile("ds_read_b64_tr_b16 %0,%1 offset:%c2":"=&v"(hi[ks]):"v"(vb),"i"(d0*4096+ks*1024+512):"memory");}
    asm volatile("s_waitcnt lgkmcnt(0)":::"memory");SBAR();
    #define PK(k) (bf16x8){lo[k][0],lo[k][1],lo[k][2],lo[k][3],hi[k][0],hi[k][1],hi[k][2],hi[k][3]}
    o[d0]=__builtin_amdgcn_mfma_f32_32x32x16_bf16(pa0,PK(0),o[d0],0,0,0);
    o[d0]=__builtin_amdgcn_mfma_f32_32x32x16_bf16(pa1,PK(1),o[d0],0,0,0);
    o[d0]=__builtin_amdgcn_mfma_f32_32x32x16_bf16(pa2,PK(2),o[d0],0,0,0);
    o[d0]=__builtin_amdgcn_mfma_f32_32x32x16_bf16(pa3,PK(3),o[d0],0,0,0);
    #undef PK
  }
}

#ifndef ATTN_STORE16
#define ATTN_STORE16(p,v) (*(u32x4*)(p)=(v))
#endif
template<int THRL> __device__ __forceinline__ void attn_unit(int b,int h,int qb,const bf16*Q,const bf16*__restrict__ K,const bf16*__restrict__ V,bf16*O,const float*__restrict__ Gg,float kmax,char*shm){
  const int tid=ltid(),lane=tid&63,r32=lane&31,hi=lane>>5; const int wid=__builtin_amdgcn_readfirstlane(tid>>6);
  const long rowbase=(long)b*SEQ; const int q0=qb*QB;
  const bf16*Qw=Q+(rowbase+q0+wid*QBLK)*DM+h*D;
  const lds_cptr shm3=(lds_cptr)shm;
  bf16x8 qr[4];
  #pragma unroll
  for(int d0=0;d0<4;++d0)qr[d0]=*reinterpret_cast<const bf16x8*>(&Qw[(long)r32*DM+d0*16+hi*8]);
  { const int nk=q0+QB; const float gb=q0?Gg[q0-1]:0.f;
    f32x4_t g4_[4]; float ge_[4];
    #pragma unroll
    for(int k_=0;k_<4;++k_){ const int i=tid*4+k_*2048; if(i<nk){ g4_[k_]=*(const f32x4_t*)(Gg+i); ge_[k_]=(i>=q0)?gb:Gg[i|63]; } }
    #pragma unroll
    for(int k_=0;k_<4;++k_){ const int i=tid*4+k_*2048; if(i<nk){ const float ge=ge_[k_]; const f32x4_t g4=g4_[k_]; *(__attribute__((address_space(3))) f32x4_t*)(shm3+LDS_GT+i*4)=(f32x4_t){g4[0]-ge,g4[1]-ge,g4[2]-ge,g4[3]-ge}; } }
    if(tid<(nk>>6)){ const float c_=(tid==0||64*tid>=q0)?1.f:__builtin_amdgcn_exp2f(Gg[64*tid-1]-Gg[64*tid+63]); *(__attribute__((address_space(3))) float*)(shm3+LDS_CF+tid*4)=c_; } }
  { float qs=0.f;
    #pragma unroll
    for(int d0=0;d0<4;++d0){
      #pragma unroll
      for(int e=0;e<8;++e){const float f=__uint_as_float(((unsigned)(unsigned short)qr[d0][e])<<16);qs+=f*f;}}
    {auto rr=__builtin_amdgcn_permlane32_swap(__float_as_uint(qs),__float_as_uint(qs),false,false);qs=__uint_as_float(rr[0])+__uint_as_float(rr[1]);}
    #pragma unroll
    for(int o_=1;o_<32;o_<<=1)qs=fmaxf(qs,__shfl_xor(qs,o_));
    if(lane==0)*(__attribute__((address_space(3))) float*)(shm3+LDS_QM+wid*4)=qs; }
  asm volatile("s_waitcnt vmcnt(0) lgkmcnt(0)\n\ts_barrier":::"memory");
  int j0;
  { float qm=0.f;
    #pragma unroll
    for(int w=0;w<8;++w)qm=fmaxf(qm,*(const __attribute__((address_space(3))) float*)(shm3+LDS_QM+w*4));
    const float lim=Gg[q0]-(2.f*sqrtf(qm)*kmax*1.01f+150.f);
    const int nt0=4*qb; int ln_=lane; asm volatile("":"+v"(ln_)); const bool c0=(ln_<nt0)&&(Gg[64*ln_+63]<lim); const bool c1=(ln_+64<nt0)&&(Gg[64*ln_+4096+63]<lim);
    j0=(__popcll(__ballot(c0))+__popcll(__ballot(c1)))&~1; j0=__builtin_amdgcn_readfirstlane(j0); }
  const bf16*Kh=K+(rowbase+(long)j0*KVBLK)*DM+h*D,*Vh=V+(rowbase+(long)j0*KVBLK)*DM+h*D;
  const lds_cptr cf0=shm3+LDS_CF+j0*4;
  const lds_cptr gp0=shm3+LDS_GT+j0*256+hi*16;
  const unsigned lds0=(unsigned)(uintptr_t)shm;
  float*wsf=(float*)(shm+LDS_WS)+wid*64;
  const bf16*ksrc=Kh+(long)lane*DM+wid*8;
  const bf16*vsrc=Vh+(long)(16*(wid&3)+(lane>>2))*DM+(wid>>2)*32+(lane&3)*8;
  const unsigned kdst=lds0+LDS_K+wid*1024, vdst=lds0+LDS_V+wid*1024;
  #define DMA_K(t,slot) glds16(ksrc+(long)(t)*KVBLK*DM,(unsigned)__builtin_amdgcn_readfirstlane(kdst+(slot)))
  #define DMA_V(t,slot) glds16(vsrc+(long)(t)*KVBLK*DM,(unsigned)__builtin_amdgcn_readfirstlane(vdst+(slot)))
  const char*Kbase=shm+LDS_K; bf16x8 kf[8];
  const lds_cptr kp0=shm3+LDS_K+hi*1024+r32*16; const lds_cptr vp0=shm3+LDS_V+((lane>>4)&1)*32+(lane&3)*8+(4*hi+((lane&15)>>2))*64;
  const int NT=(q0+QB)/KVBLK-j0;
  DMA_K(0,0);DMA_V(0,0);DMA_K(1,SLOTB);
  float mhat=0.f,l_reg=0.f;f32x16 o[2];o[0]=f32x16{};o[1]=f32x16{};
  const int qrel=wid*QBLK+r32;
  #define CMASK(P0,P1,t) do{int jb_=(t)-(NT-4); if(jb_>=0)cmask(P0,P1,jb_,qrel,hi);}while(0)
  #define BIASINIT(P0,P1,t) do{ const lds_cptr gp_=gp0+(t)*256; \
    _Pragma("unroll") for(int i_=0;i_<4;++i_){ const f32x4_t ga_=*(const __attribute__((address_space(3))) f32x4_t*)(gp_+i_*32), gb_=*(const __attribute__((address_space(3))) f32x4_t*)(gp_+128+i_*32); \
      P0[4*i_]=ga_[0]-mhat;P0[4*i_+1]=ga_[1]-mhat;P0[4*i_+2]=ga_[2]-mhat;P0[4*i_+3]=ga_[3]-mhat; P1[4*i_]=gb_[0]-mhat;P1[4*i_+1]=gb_[1]-mhat;P1[4*i_+2]=gb_[2]-mhat;P1[4*i_+3]=gb_[3]-mhat; } }while(0)
  bool resc=false;
  #define START(P0,P1) do{ const float rm=rowmax(P0,P1); resc=false; \
    { const float dl=rm; mhat=fadd_s(mhat,dl); \
      _Pragma("unroll") for(int r=0;r<16;++r){P0[r]=fsub_s(P0[r],dl);P1[r]=fsub_s(P1[r],dl);} \
      } \
    _Pragma("unroll") for(int r=0;r<16;++r)P0[r]=__builtin_amdgcn_exp2f(P0[r]); }while(0)
  #define RESC(t) do{ const float cf_=*(const __attribute__((address_space(3))) float*)(cf0+(t)*4); l_reg*=cf_; \
      if(resc){ asm volatile("s_waitcnt lgkmcnt(0)":::"memory"); \
        _Pragma("unroll") for(int d_=0;d_<2;++d_) _Pragma("unroll") for(int r=0;r<16;++r)o[d_][r]*=cf_*wsf[crow(r,hi)]; } \
      else { _Pragma("unroll") for(int d_=0;d_<2;++d_) _Pragma("unroll") for(int r=0;r<16;++r)o[d_][r]*=cf_; } }while(0)
  f32x16 pA0,pA1,pB0,pB1;
  int sl_prev=0,sl_cur=0,sl_next=SLOTB;
  #define ROT() do{sl_prev=sl_cur;sl_cur=sl_next;sl_next=(sl_next==(NSLOT-1)*SLOTB)?0:sl_next+SLOTB;}while(0)
  DMA_K(2,2*SLOTB);
  WAIT_BAR(3);
  BIASINIT(pA0,pA1,0);qkt(pA0,pA1,Kbase,qr,r32,hi);asm volatile("s_nop 15\n\ts_nop 7":"+v"(pA0),"+v"(pA1));CMASK(pA0,pA1,0);
  START(pA0,pA1);
  _Pragma("unroll") for(int r=0;r<16;++r)pA1[r]=__builtin_amdgcn_exp2f(pA1[r]);
  WAIT_BAR(0);
  DMA_K(3,0);DMA_V(1,SLOTB);
  ROT();
  kload8(kf,kp0+sl_cur);
  WAIT_BAR(2);
  s16x4 vlo[8],vhi[8]; u32x4 pw0,pw1,pw2,pw3;
  #define PKW(P,B) cvtpk_s(P[B],P[B+1])
  #define PAF(k) __builtin_bit_cast(bf16x8,pw##k)
  #define VFR(i) (bf16x8){vlo[i][0],vlo[i][1],vlo[i][2],vlo[i][3],vhi[i][0],vhi[i][1],vhi[i][2],vhi[i][3]}
  #define PIN(x) asm volatile("":"+v"(x))
  #define MX3(a,b,c) __builtin_fmaxf(__builtin_fmaxf((a),(b)),(c))
  #define GAPA(MF,A0,A1,A2,A3,W0,W1,PW) do{ MF; sacc+=A0; sacc+=A1; sacc+=A2; sacc+=A3; PIN(sacc); W0; W1; PIN(PW); SBAR(); }while(0)
  #define EX(v) __builtin_amdgcn_exp2f(v)
  #define GAPB(MF,X,B) do{ MF; X[B]=EX(X[B]); X[B+1]=EX(X[B+1]); X[B+2]=EX(X[B+2]); X[B+3]=EX(X[B+3]); PIN(X); SBAR(); }while(0)
  #define VRD(i) do{ vlo[i]=vtr(vp_+(((i)>>2)*4096+((i)&3)*1024)); vhi[i]=vtr(vp_+(((i)>>2)*4096+((i)&3)*1024+512)); }while(0)
  #define KRD(G,j) do{ if(G){ kload2(kf,kp0+sl_next,j); SBAR(); } }while(0)
  #define STEP(C0,C1,P0,P1,t,GK,GV,GL) do{ SBAR(); BIASINIT(C0,C1,t); SBAR(); \
    const lds_cptr vp_=vp0+sl_prev; \
    VRD(0); SBAR(); float sacc=(P0[0]+P0[1]); \
    GAPA(C0=__builtin_amdgcn_mfma_f32_32x32x16_bf16(kf[0],qr[0],C0,0,0,0), P0[2],P0[3],P0[4],P0[5],     pw0[0]=PKW(P0,0), pw0[1]=PKW(P0,2), pw0); \
    VRD(4); SBAR(); GAPA(C1=__builtin_amdgcn_mfma_f32_32x32x16_bf16(kf[1],qr[0],C1,0,0,0), P0[6],P0[7],P0[8],P0[9],     pw0[2]=PKW(P0,4), pw0[3]=PKW(P0,6), pw0); \
    VRD(1); SBAR(); GAPA(C0=__builtin_amdgcn_mfma_f32_32x32x16_bf16(kf[2],qr[1],C0,0,0,0),   P0[10],P0[11],P0[12],P0[13], pw1[0]=PKW(P0,8), pw1[1]=PKW(P0,10), pw1); \
    VRD(5); SBAR(); GAPA(C1=__builtin_amdgcn_mfma_f32_32x32x16_bf16(kf[3],qr[1],C1,0,0,0),   P0[14],P0[15],P1[0],P1[1],   pw1[2]=PKW(P0,12),pw1[3]=PKW(P0,14), pw1); \
    VRD(2); SBAR(); GAPA(C0=__builtin_amdgcn_mfma_f32_32x32x16_bf16(kf[4],qr[2],C0,0,0,0),   P1[2],P1[3],P1[4],P1[5],     pw2[0]=PKW(P1,0), pw2[1]=PKW(P1,2), pw2); \
    VRD(6); SBAR(); GAPA(C1=__builtin_amdgcn_mfma_f32_32x32x16_bf16(kf[5],qr[2],C1,0,0,0),   P1[6],P1[7],P1[8],P1[9],     pw2[2]=PKW(P1,4), pw2[3]=PKW(P1,6), pw2); \
    VRD(3); SBAR(); GAPA(C0=__builtin_amdgcn_mfma_f32_32x32x16_bf16(kf[6],qr[3],C0,0,0,0),   P1[10],P1[11],P1[12],P1[13], pw3[0]=PKW(P1,8), pw3[1]=PKW(P1,10), pw3); \
    VRD(7); SBAR(); GAPA(C1=__builtin_amdgcn_mfma_f32_32x32x16_bf16(kf[7],qr[3],C1,0,0,0),   P1[14],P1[15],0.f,0.f,       pw3[2]=PKW(P1,12),pw3[3]=PKW(P1,14), pw3); \
    l_reg+=sacc; \
    if(GK){DMA_K((t)+3,sl_cur);} if(GV){DMA_V((t)+1,sl_next);} \
    CMASK(C0,C1,t); \
    { float a=MX3(C0[0],C0[1],C1[0]),b=MX3(C0[2],C0[3],C1[1]); a=MX3(a,C1[2],C1[3]); \
      _Pragma("unroll") for(int r=4;r<16;r+=4){a=MX3(a,C0[r],C0[r+1]);b=MX3(b,C0[r+2],C0[r+3]);a=MX3(a,C1[r],C1[r+1]);b=MX3(b,C1[r+2],C1[r+3]);} \
      float rm=__builtin_fmaxf(a,b); { auto rr=__builtin_amdgcn_permlane32_swap(__float_as_uint(rm),__float_as_uint(rm),false,false); rm=__builtin_fmaxf(__uint_as_float(rr[0]),__uint_as_float(rr[1])); } \
      resc=false; \
      if(__builtin_expect(__any(rm>(float)THRL),0)){ const float dl=__builtin_fmaxf(rm,0.f); mhat+=dl; \
        _Pragma("unroll") for(int r=0;r<16;++r){C0[r]-=dl;C1[r]-=dl;} \
        const float f=__builtin_amdgcn_exp2f(-dl); l_reg*=f; if(hi==0)wsf[r32]=f; resc=true; } } \
    SBAR(); \
    GAPB(o[0]=__builtin_amdgcn_mfma_f32_32x32x16_bf16(PAF(0),VFR(0),o[0],0,0,0), C0,0); \
    GAPB(o[1]=__builtin_amdgcn_mfma_f32_32x32x16_bf16(PAF(0),VFR(4),o[1],0,0,0), C0,4); \
    KRD(GL,0); GAPB(o[0]=__builtin_amdgcn_mfma_f32_32x32x16_bf16(PAF(1),VFR(1),o[0],0,0,0), C0,8); \
    KRD(GL,1); GAPB(o[1]=__builtin_amdgcn_mfma_f32_32x32x16_bf16(PAF(1),VFR(5),o[1],0,0,0), C0,12); \
    KRD(GL,2); GAPB(o[0]=__builtin_amdgcn_mfma_f32_32x32x16_bf16(PAF(2),VFR(2),o[0],0,0,0), C1,0); \
    KRD(GL,3); GAPB(o[1]=__builtin_amdgcn_mfma_f32_32x32x16_bf16(PAF(2),VFR(6),o[1],0,0,0), C1,4); \
    GAPB(o[0]=__builtin_amdgcn_mfma_f32_32x32x16_bf16(PAF(3),VFR(3),o[0],0,0,0), C1,8); \
    GAPB(o[1]=__builtin_amdgcn_mfma_f32_32x32x16_bf16(PAF(3),VFR(7),o[1],0,0,0), C1,12); \
    }while(0)
  int t=1;
  #undef CMASK
  #define CMASK(P0,P1,t) do{}while(0)
  for(;t+5<NT;t+=2){
    STEP(pB0,pB1,pA0,pA1,t,true,true,true);     WAIT_BAR(2); RESC(t); ROT();
    STEP(pA0,pA1,pB0,pB1,t+1,true,true,true);   WAIT_BAR(2); RESC(t+1); ROT();
  }
  #undef CMASK
  #define CMASK(P0,P1,t) do{int jb_=(t)-(NT-4); if(jb_>=0)cmask(P0,P1,jb_,qrel,hi);}while(0)
  #define ENDW(tt) do{ if((tt)+3<NT){WAIT_BAR(2);} else if((tt)+2<NT){WAIT_BAR(1);} else {WAIT_BAR(0);} }while(0)
  for(;t+1<NT;t+=2){
    STEP(pB0,pB1,pA0,pA1,t,(t+3<NT),(t+1<NT),(t+1<NT));       ENDW(t);   RESC(t); ROT();
    STEP(pA0,pA1,pB0,pB1,t+1,(t+4<NT),(t+2<NT),(t+2<NT));     ENDW(t+1); RESC(t+1); ROT();
  }
  STEP(pB0,pB1,pA0,pA1,NT-1,false,false,false); RESC(NT-1);
  { float sacc=pB0[0]+pB0[1]; _Pragma("unroll") for(int r=2;r<16;++r)sacc+=pB0[r]; _Pragma("unroll") for(int r=0;r<16;++r)sacc+=pB1[r]; l_reg+=sacc;
    pw0=(u32x4){PKW(pB0,0),PKW(pB0,2),PKW(pB0,4),PKW(pB0,6)};pw1=(u32x4){PKW(pB0,8),PKW(pB0,10),PKW(pB0,12),PKW(pB0,14)};pw2=(u32x4){PKW(pB1,0),PKW(pB1,2),PKW(pB1,4),PKW(pB1,6)};pw3=(u32x4){PKW(pB1,8),PKW(pB1,10),PKW(pB1,12),PKW(pB1,14)};
    SBAR(); pv(o,(int)(lds0+LDS_V)+((lane>>4)&1)*32+(lane&3)*8+(4*hi+((lane&15)>>2))*64+sl_cur,PAF(0),PAF(1),PAF(2),PAF(3)); }
  #undef PKW
  #undef PAF
  #undef VFR
  #undef PIN
  #undef MX3
  #undef GAPA
  #undef GAPB
  #undef EX
  #undef VRD
  #undef KRD
  #undef STEP
  #undef ENDW
  {auto rr=__builtin_amdgcn_permlane32_swap(__float_as_uint(l_reg),__float_as_uint(l_reg),false,false);l_reg=__uint_as_float(rr[0])+__uint_as_float(rr[1]);}
  if(hi==0)wsf[32+r32]=l_reg;asm volatile("s_waitcnt lgkmcnt(0)":::"memory");
  float rli[16];
  #pragma unroll
  for(int r=0;r<16;++r)rli[r]=__builtin_amdgcn_rcpf(wsf[32+crow(r,hi)]);
  bf16*Ow=O+(rowbase+q0+wid*QBLK)*DM+h*D;
  { bf16*stg=(bf16*)(shm+LDS_OST)+wid*2048;
    #pragma unroll
    for(int r=0;r<16;++r){const int orow=crow(r,hi);
      #pragma unroll
      for(int d0=0;d0<2;++d0)stg[orow*64+d0*32+r32]=__float2bfloat16(o[d0][r]*rli[r]);}
    asm volatile("s_waitcnt lgkmcnt(0)":::"memory");
    #pragma unroll
    for(int i=0;i<4;++i){const int row=i*8+(lane>>3),ch=lane&7; const u32x4 v=*(const u32x4*)(stg+row*64+ch*8); ATTN_STORE16(Ow+(long)row*DM+ch*8,v);} }
  asm volatile("s_waitcnt lgkmcnt(0)\n\ts_barrier":::"memory");
  #undef DMA_K
  #undef DMA_V
  #undef CMASK
  #undef BIASINIT
  #undef START
  #undef RESC
  #undef ROT
}
constexpr int ATTN_LDS_BYTES=LDS_BYTES;
struct AttnTensors { const bf16* Q; const bf16* K; const bf16* V; bf16* O; const float* G; const float* kmax; };
template<int THRL=8> __device__ __forceinline__ void attn_phase(char*lds,const AttnTensors&T,unsigned*counter){
  const lds_cptr shm3=(lds_cptr)lds;
  { const int t_=threadIdx.x;
    if(t_<32)*(__attribute__((address_space(3))) float*)(shm3+LDS_ORD+t_*4)=T.G[(size_t)t_*SEQ+SEQ-1];
    asm volatile("s_waitcnt vmcnt(0) lgkmcnt(0)\n\ts_barrier":::"memory");
    if(t_<32){ const float g_=*(const __attribute__((address_space(3))) float*)(shm3+LDS_ORD+t_*4); int r_=0;
      for(int j=0;j<32;++j){ const float o_=*(const __attribute__((address_space(3))) float*)(shm3+LDS_ORD+j*4); r_+=(o_<g_||(o_==g_&&j<t_))?1:0; }
      *(__attribute__((address_space(3))) int*)(shm3+LDS_ORD+128+r_*4)=t_; }
    asm volatile("s_waitcnt lgkmcnt(0)\n\ts_barrier":::"memory"); }
  for(;;){
    if(threadIdx.x==0){ const unsigned v=atomicAdd(counter,1u); *(__attribute__((address_space(3))) unsigned*)(shm3+LDS_QM+32)=v; }
    asm volatile("s_waitcnt vmcnt(0) lgkmcnt(0)\n\ts_barrier":::"memory");
    const unsigned idx=*(const __attribute__((address_space(3))) unsigned*)(shm3+LDS_QM+32);
    if(idx>=(unsigned)(BATCH*NHEAD*NQB))break;
    const int bh=*(const __attribute__((address_space(3))) int*)(shm3+LDS_ORD+128+(idx>>5)*4), qb=NQB-1-(int)(idx&31u);
    attn_unit<THRL>(bh/NHEAD,bh%NHEAD,qb,T.Q,T.K,T.V,T.O,T.G+(size_t)bh*SEQ,T.kmax[bh],lds);
  }
}
#undef SBAR
#undef WAIT_BAR
}

#define LAS __attribute__((address_space(3)))
typedef unsigned short bf16;
typedef unsigned v4u __attribute__((ext_vector_type(4)));
typedef float f32x4 __attribute__((ext_vector_type(4)));
typedef short bf16x8 __attribute__((ext_vector_type(8)));
typedef float f2v __attribute__((ext_vector_type(2)));
__device__ __forceinline__ f2v mk2(float a, float b) { f2v r; r.x = a; r.y = b; return r; }

constexpr int M = 16384, D = 1024, FF = 4096, SEQ = 8192, NPH = 25;
constexpr int TCH = 32, NCHUNK = M / TCH  , KUX = 640  ;
constexpr size_t MiB = 1u << 20;
constexpr size_t OFF_CTL = 0, OFF_BAR = 4096, ZERO_BYTES = 32768;
constexpr int LDS_MISC = 147456 - 64;
constexpr size_t OFF_LOGF = 1 * MiB, OFF_G = 2 * MiB, OFF_KMAX = 3 * MiB, OFF_WF = 3 * MiB + 4096;
constexpr size_t OFF_LAMPOW = 4 * MiB, OFF_BBAR = 4 * MiB + 1310720, OFF_KTAB = 6 * MiB;
constexpr size_t OFF_SS = OFF_KTAB;
constexpr size_t OFF_W1 = 8 * MiB, OFF_W2 = 16 * MiB, OFF_MIX = 24 * MiB, OFF_HB = 32 * MiB;
constexpr size_t OFF_K = 64 * MiB, OFF_V = 96 * MiB;
constexpr size_t OFF_A2 = 64 * MiB, OFF_WEND = 104 * MiB;
constexpr size_t OFF_A = 128 * MiB;
constexpr size_t OFF_UX = 128 * MiB, OFF_SL = 168 * MiB, OFF_Z = 192 * MiB, OFF_QO = 128 * MiB;
constexpr size_t WS_END = 256 * MiB;
constexpr int LDS_BYTES = 147456;

struct Params { const float* in[20]; float* out; unsigned char* ws; int ph_lo, ph_hi; };
enum { I_X = 0, I_MIXN, I_MLPN, I_W1, I_W2, I_LOGDT, I_ARE, I_AIM, I_BRE, I_BIM, I_CRE, I_CIM, I_DSK, I_WGLU, I_KVN, I_WKVF, I_BF, I_WQ, I_WO, I_FINN };

struct Frame { LAS unsigned char* lds; int tid, lane, wave, G; };
typedef const float* cfp_t;
__device__ __forceinline__ cfp_t kin(int i) { asm volatile("" : "+s"(i)); const __attribute__((address_space(4))) cfp_t* k = (const __attribute__((address_space(4))) cfp_t*)__builtin_amdgcn_kernarg_segment_ptr(); return k[i]; }
static_assert(offsetof(Params, in) == 0, "kin() reads Params::in at kernarg offset 0");

__device__ __forceinline__ float wave_sum(float v) {
#pragma unroll
    for (int o = 1; o < 64; o <<= 1) v += __shfl_xor(v, o);
    return v;
}
__device__ __forceinline__ unsigned pk2(float lo, float hi) { return pg8::cvt_pk_bf16(lo, hi); }
__device__ __forceinline__ float bf2f(unsigned short b) { return __uint_as_float(((unsigned)b) << 16); }

template <int MODE> __device__ __forceinline__ void conv_w(const Frame& F, const float* W, int K, int srcN, int n0, int ncols, bf16* WT, const float* gk, int b0 = 0) {
    constexpr int SP = 33;
    LAS float* scr = (LAS float*)(F.lds + F.wave * (64 * SP * 4));
    if (b0 > 0 && (int)blockIdx.x < b0) return;
    const int gw = ((int)blockIdx.x - b0) * 8 + F.wave, NGW = (F.G - b0) * 8, lane = F.lane;
    const int nblk = ncols / 32, nitems = (K / 64) * nblk;
    for (int it = gw; it < nitems; it += NGW) {
        const int kb = it / nblk, nb = it % nblk, k0 = 64 * kb, nn0 = 32 * nb;
        const float* src = W + (size_t)(k0 + (lane >> 3)) * srcN + n0 + nn0 + (lane & 7) * 4;
        f32x4 w[8];
#pragma unroll
        for (int i = 0; i < 8; ++i) w[i] = __builtin_nontemporal_load((const f32x4*)(src + (size_t)(8 * i) * srcN));
#pragma unroll
        for (int i = 0; i < 8; ++i) { const int kk = 8 * i + (lane >> 3); const float g = gk ? gk[k0 + kk] : 1.f; LAS float* d = scr + kk * SP + (lane & 7) * 4;
            d[0] = w[i][0] * g; d[1] = w[i][1] * g; d[2] = w[i][2] * g; d[3] = w[i][3] * g; }
        asm volatile("s_waitcnt lgkmcnt(0)" ::: "memory");
        const int c = lane & 7;
#pragma unroll
        for (int j = 0; j < 4; ++j) { const int n = (lane >> 3) + 8 * j; const LAS float* s = scr + (8 * c) * SP + n;
            v4u o; o.x = pk2(s[0 * SP], s[1 * SP]); o.y = pk2(s[2 * SP], s[3 * SP]); o.z = pk2(s[4 * SP], s[5 * SP]); o.w = pk2(s[6 * SP], s[7 * SP]);
            const int nn = nn0 + n; const int row = (MODE == 1) ? (((nn & 1023) >> 7) * 256 + ((nn >> 10) & 1) * 128 + (nn & 127)) : nn;
            *(v4u*)(WT + (size_t)row * K + k0 + 8 * c) = o; }
        asm volatile("s_waitcnt lgkmcnt(0)" ::: "memory");
    }
}
__device__ __forceinline__ void conv_wf(const Frame& F, const float* wkvf, const float* kvn, bf16* WF) {
    for (int e = blockIdx.x * 512 + F.tid; e < 16 * 1024; e += F.G * 512) { const int j = e >> 10, k = e & 1023; const float w = wkvf[(size_t)k * 2064 + 2048 + j] * kvn[k];
        unsigned u = __float_as_uint(w); u = (u + 0x7fffu + ((u >> 16) & 1u)) >> 16; WF[e] = (bf16)u; }
}

__device__ __forceinline__ double dconst(double c) { asm volatile("" : "+s"(c)); return c; }
__device__ __forceinline__ double exp_d(double x) {
    const double n = rint(x * dconst(1.4426950408889634074)); const double r = (x - n * dconst(6.93147180369123816490e-01)) - n * dconst(1.90821492927058770002e-10);
    double s = 1.0, t = 1.0;
#pragma unroll 1
    for (int k = 1; k <= 16; ++k) { t *= r / (double)k; s += t; }
    const long long bits = ((long long)((int)n + 1023)) << 52; return s * __longlong_as_double(bits);
}
__device__ __forceinline__ void sincos_d(double x, double& s, double& c) {
    const double q = rint(x * dconst(0.63661977236758134308)); const int qi = (int)q;
    double r = x - q * dconst(1.57079632679489655800e+00); r -= q * dconst(6.12323399573676603587e-17);
    const double r2 = r * r;
    double sr = r, cr = 1.0, ts = r, tc = 1.0;
#pragma unroll 1
    for (int n = 1; n <= 10; ++n) { ts *= -r2 / (double)((2 * n) * (2 * n + 1)); sr += ts; tc *= -r2 / (double)((2 * n - 1) * (2 * n)); cr += tc; }
    switch (qi & 3) { case 0: s = sr; c = cr; break; case 1: s = cr; c = -sr; break; case 2: s = -sr; c = -cr; break; default: s = -cr; c = sr; break; }
}
__device__ __forceinline__ void s5_tables(const Frame& F, const Params& P, int L) {
    f2v* lampow = (f2v*)(P.ws + OFF_LAMPOW); f2v* Bbar = (f2v*)(P.ws + OFF_BBAR); float* Ktab = (float*)(P.ws + OFF_KTAB);
    LAS f2v* lp = (LAS f2v*)(F.lds);
    LAS f2v* bb = lp + 64 * 33;
    LAS f2v* cc = bb + 64 * 16;
    LAS f2v* cf = cc + 16 * 64;
    for (int item = blockIdx.x; item < 256; item += F.G) { const int g = item >> 2, qt = item & 3;
        if (F.tid < 64) { const int p = F.tid; const double dt = exp_d((double)kin(I_LOGDT)[L * 64 + g]);
            const double ar = (double)kin(I_ARE)[(L * 64 + g) * 64 + p], ai = (double)kin(I_AIM)[(L * 64 + g) * 64 + p];
            const double mag = exp_d(ar * dt); double sn, cs; sincos_d(ai * dt, sn, cs); const double lr = mag * cs, li = mag * sn;
            double pr = 1.0, pi = 0.0;
            for (int tau = 0; tau <= 32; ++tau) { const f2v v = mk2((float)pr, (float)pi); lp[p * 33 + tau] = v; if (qt == 0) lampow[(size_t)(g * 64 + p) * 33 + tau] = v; const double nr = pr * lr - pi * li, ni = pr * li + pi * lr; pr = nr; pi = ni; }
            const double nr = lr - 1.0, ni = li, den = ar * ar + ai * ai; cf[p] = mk2((float)((nr * ar + ni * ai) / den), (float)((ni * ar - nr * ai) / den)); }
        __syncthreads();
        { const float* bre_ = kin(I_BRE) + (size_t)((L * 64 + g) * 64) * 16; const float* bim_ = kin(I_BIM) + (size_t)((L * 64 + g) * 64) * 16; const float* cre_ = kin(I_CRE) + (size_t)(L * 64 + g) * 1024; const float* cim_ = kin(I_CIM) + (size_t)(L * 64 + g) * 1024;
          for (int e = F.tid; e < 1024; e += 512) { const int p = e >> 4; const float br = bre_[e], bi = bim_[e]; const f2v c = cf[p];
            const f2v v = mk2(c.x * br - c.y * bi, c.x * bi + c.y * br); bb[e] = v; if (qt == 0) Bbar[(size_t)g * 1024 + e] = v;
            cc[e] = mk2(cre_[e], cim_[e]); } }
        __syncthreads();
        { const float* dsk_ = kin(I_DSK) + L * 1024 + 16 * g;
          for (int e = qt * 2048 + F.tid; e < (qt + 1) * 2048; e += 512) { const int tau = e >> 8, cp = (e >> 4) & 15, c = e & 15; float acc = 0.f;
            for (int p = 0; p < 64; ++p) { const f2v C = cc[cp * 64 + p], l = lp[p * 33 + tau], B = bb[p * 16 + c]; const float tr = C.x * l.x - C.y * l.y, ti = C.x * l.y + C.y * l.x; acc += tr * B.x - ti * B.y; }
            if (tau == 0 && cp == c) acc += dsk_[c];
            Ktab[(size_t)g * 8192 + e] = acc; } }
        __syncthreads();
    }
}
__device__ __forceinline__ void s5_expand(const Frame& F, const Params& P, int L) {
    const f2v* lampow = (const f2v*)(P.ws + OFF_LAMPOW); const f2v* Bbar = (const f2v*)(P.ws + OFF_BBAR); const float* Ktab = (const float*)(P.ws + OFF_KTAB);
    bf16* A2 = (bf16*)(P.ws + OFF_A2); bf16* Wend = (bf16*)(P.ws + OFF_WEND);
    const int gt = blockIdx.x * 512 + F.tid, GT = F.G * 512;
    const float* cre_ = kin(I_CRE) + (size_t)L * 65536; const float* cim_ = kin(I_CIM) + (size_t)L * 65536;
#pragma unroll 4
    for (int ch = gt; ch < 32768 * 64; ch += GT) { const int row = ch >> 6, c8 = (ch & 63) * 8, g = row >> 9, tc = row & 511, t = tc >> 4, cp = tc & 15, s = c8 >> 4, c0 = c8 & 15;
        const int lag = (t - s) < 0 ? 0 : (t - s); const float* kp = Ktab + ((size_t)(g * 32 + lag) * 256 + cp * 16 + c0); f32x4 a = *(const f32x4*)kp, b = *(const f32x4*)(kp + 4);
        if (s > t) { a = (f32x4){0.f, 0.f, 0.f, 0.f}; b = a; }
        v4u o; o.x = pk2(a[0], a[1]); o.y = pk2(a[2], a[3]); o.z = pk2(b[0], b[1]); o.w = pk2(b[2], b[3]);
        *(v4u*)(A2 + (size_t)row * KUX + c8) = o; }
#pragma unroll 2
    for (int ch = gt; ch < 32768 * 16; ch += GT) { const int row = ch >> 4, j = (ch & 15) * 8, g = row >> 9, tc = row & 511, t = tc >> 4, cp = tc & 15, im = j >> 6, p0 = j & 63; float v[8];
        const size_t ci = (size_t)(g * 16 + cp) * 64 + p0; const f32x4 cr0 = *(const f32x4*)(cre_ + ci), cr1 = *(const f32x4*)(cre_ + ci + 4), ci0 = *(const f32x4*)(cim_ + ci), ci1 = *(const f32x4*)(cim_ + ci + 4);
#pragma unroll
        for (int e = 0; e < 8; ++e) { const float cr = e < 4 ? cr0[e & 3] : cr1[e & 3], cim = e < 4 ? ci0[e & 3] : ci1[e & 3]; const f2v l = lampow[(size_t)(g * 64 + p0 + e) * 33 + t + 1];
            v[e] = im ? -(cr * l.y + cim * l.x) : (cr * l.x - cim * l.y); }
        v4u o; o.x = pk2(v[0], v[1]); o.y = pk2(v[2], v[3]); o.z = pk2(v[4], v[5]); o.w = pk2(v[6], v[7]);
        *(v4u*)(A2 + (size_t)row * KUX + 512 + j) = o; }
#pragma unroll 2
    for (int ch = gt; ch < 16384 * 64; ch += GT) { const int row = ch >> 6, c8 = (ch & 63) * 8, g = row >> 8, rho = row & 255, s = c8 >> 4, c0 = c8 & 15, p = rho & 63, im = (rho >> 6) & 1; float v[8];
        const f2v l = lampow[(size_t)(g * 64 + p) * 33 + 31 - s]; const f2v* Bp = Bbar + (size_t)(g * 64 + p) * 16 + c0;
#pragma unroll
        for (int e = 0; e < 8; ++e) { const f2v B = Bp[e]; const float x = im ? (l.x * B.y + l.y * B.x) : (l.x * B.x - l.y * B.y); v[e] = (rho < 128) ? x : 0.f; }
        v4u o; o.x = pk2(v[0], v[1]); o.y = pk2(v[2], v[3]); o.z = pk2(v[4], v[5]); o.w = pk2(v[6], v[7]);
        *(v4u*)(Wend + (size_t)row * 512 + c8) = o; }
}
template <bool BF> __device__ __forceinline__ void phase_normu(const Frame& F, const void* hin, const float* gw, bf16* UX) {
    constexpr int PITCH = 1032;
    LAS bf16* tile = (LAS bf16*)F.lds;
    for (int n = blockIdx.x; n < NCHUNK; n += F.G) {
        f32x4 v[4][4]; float ss[4];
#pragma unroll
        for (int q = 0; q < 4; ++q) { const size_t ro = (size_t)(TCH * n + F.wave * 4 + q) * D;
            if (BF) { const v4u* xr = (const v4u*)((const bf16*)hin + ro) + 2 * F.lane; const v4u a = xr[0], b = xr[1];
                v[q][0] = (f32x4){pg8::bflo(a.x), pg8::bfhi(a.x), pg8::bflo(a.y), pg8::bfhi(a.y)}; v[q][1] = (f32x4){pg8::bflo(a.z), pg8::bfhi(a.z), pg8::bflo(a.w), pg8::bfhi(a.w)};
                v[q][2] = (f32x4){pg8::bflo(b.x), pg8::bfhi(b.x), pg8::bflo(b.y), pg8::bfhi(b.y)}; v[q][3] = (f32x4){pg8::bflo(b.z), pg8::bfhi(b.z), pg8::bflo(b.w), pg8::bfhi(b.w)}; }
            else { const f32x4* xr = (const f32x4*)((const float*)hin + ro) + F.lane;
#pragma unroll
                for (int j = 0; j < 4; ++j) v[q][j] = __builtin_nontemporal_load(xr + 64 * j); } }
#pragma unroll
        for (int q = 0; q < 4; ++q) { float s = 0.f;
#pragma unroll
            for (int j = 0; j < 4; ++j) s += (v[q][j][0] * v[q][j][0] + v[q][j][1] * v[q][j][1]) + (v[q][j][2] * v[q][j][2] + v[q][j][3] * v[q][j][3]);
            ss[q] = pg8::rstd_of(wave_sum(s)); }
#pragma unroll
        for (int j = 0; j < 4; ++j) { const int e0 = BF ? (16 * F.lane + 4 * j) : (4 * (F.lane + 64 * j)); const f32x4 g4 = *(const f32x4*)(gw + e0);
#pragma unroll
            for (int q = 0; q < 4; ++q) { const f32x4 u = v[q][j] * ss[q] * g4; LAS unsigned* dst = (LAS unsigned*)(tile + (F.wave * 4 + q) * PITCH + e0); dst[0] = pk2(u[0], u[1]); dst[1] = pk2(u[2], u[3]); } }
        __syncthreads();
#pragma unroll 1
        for (int pass = 0; pass < 8; ++pass) { const int g = pass * 8 + (F.tid >> 6), s = (F.tid & 63) >> 1, half = F.tid & 1;
            const v4u val = *(const LAS v4u*)(tile + s * PITCH + 16 * g + 8 * half);
            *(v4u*)(UX + (size_t)(g * NCHUNK + n) * KUX + s * 16 + 8 * half) = val; }
        __syncthreads();
    }
}
__device__ __forceinline__ void phase_scan(const Frame& F, const Params& P) {
    const f2v* lampow = (const f2v*)(P.ws + OFF_LAMPOW); const float* Sl = (const float*)(P.ws + OFF_SL); bf16* UX = (bf16*)(P.ws + OFF_UX);
    for (int bg = F.wave * F.G + blockIdx.x; bg < 128; bg += 8 * F.G) { const int b = bg >> 6, g = bg & 63, p = F.lane;
        const f2v lt = lampow[(size_t)(g * 64 + p) * 33 + 32]; float xr = 0.f, xi = 0.f;
        const float* sl = Sl + (size_t)(g * NCHUNK + b * 256) * 128 + p; bf16* ux = UX + (size_t)(g * NCHUNK + b * 256) * KUX + 512 + p;
#pragma unroll 1
        for (int k0 = 0; k0 < 256; k0 += 8) { float sr[8], si[8];
#pragma unroll
            for (int j = 0; j < 8; ++j) { sr[j] = sl[(size_t)(k0 + j) * 128]; si[j] = sl[(size_t)(k0 + j) * 128 + 64]; }
#pragma unroll
            for (int j = 0; j < 8; ++j) { const unsigned w = pk2(xr, xi); ux[(size_t)(k0 + j) * KUX] = (bf16)(w & 0xffffu); ux[(size_t)(k0 + j) * KUX + 64] = (bf16)(w >> 16);
                const float nr = lt.x * xr - lt.y * xi + sr[j], ni = lt.x * xi + lt.y * xr + si[j]; xr = nr; xi = ni; } }
    }
}
__device__ __forceinline__ void phase_flogit(const Frame& F, const Params& P, const float* ss) {
    const bf16* hb = (const bf16*)(P.ws + OFF_HB); const bf16* WF = (const bf16*)(P.ws + OFF_WF); float* logf = (float*)(P.ws + OFF_LOGF);
    const int r = F.lane & 15, kq = F.lane >> 4; const float* bf_ = kin(I_BF);
    for (int task = blockIdx.x * 8 + F.wave; task < M / 16; task += F.G * 8) { const int row = task * 16 + r; f32x4 acc = {0.f, 0.f, 0.f, 0.f};
        const bf16* ap = hb + (size_t)row * D + kq * 8; const bf16* bp = WF + (size_t)r * D + kq * 8;
#pragma unroll 8
        for (int ks = 0; ks < 32; ++ks) { const bf16x8 a = *(const bf16x8*)(ap + ks * 32), b = *(const bf16x8*)(bp + ks * 32); acc = __builtin_amdgcn_mfma_f32_16x16x32_bf16(b, a, acc, 0, 0, 0); }
        const float rs = pg8::rstd_slots(ss, row, 16, kq); f32x4 o;
#pragma unroll
        for (int i = 0; i < 4; ++i) { const float x = acc[i] * rs + bf_[4 * kq + i]; o[i] = fminf(x, 0.f) - 0.6931471805599453f * __builtin_amdgcn_logf(1.0f + __builtin_amdgcn_exp2f(-1.4426950408889634f * fabsf(x))); }
        *(f32x4*)(logf + (size_t)row * 16 + 4 * kq) = o; }
}
__device__ __forceinline__ void phase_fscan(const Frame& F, const Params& P) {
    const float* logf = (const float*)(P.ws + OFF_LOGF); float* Gt = (float*)(P.ws + OFF_G); float* kmax = (float*)(P.ws + OFF_KMAX); const bf16* Kb = (const bf16*)(P.ws + OFF_K);
    LAS float* wsum = (LAS float*)F.lds; LAS float* wmax = wsum + 8;
    for (int bh = blockIdx.x; bh < 32; bh += F.G) { const int b = bh >> 4, h = bh & 15, t0 = F.tid * 16; float v[16]; float s = 0.f;
#pragma unroll
        for (int i = 0; i < 16; ++i) { v[i] = -1.4426950408889634f * logf[(size_t)(b * SEQ + t0 + i) * 16 + h]; s += v[i]; }
        float incl = s;
#pragma unroll
        for (int o = 1; o < 64; o <<= 1) { const float t = __shfl_up(incl, o); if (F.lane >= o) incl += t; }
        float km = 0.f;
#pragma unroll 4
        for (int i = 0; i < 16; ++i) { const bf16* kp = Kb + (size_t)(b * SEQ + t0 + i) * D + 64 * h; float q = 0.f;
#pragma unroll
            for (int c = 0; c < 8; ++c) { const bf16x8 kv = *(const bf16x8*)(kp + 8 * c);
#pragma unroll
                for (int e = 0; e < 8; ++e) { const float f = bf2f((unsigned short)kv[e]); q += f * f; } }
            km = fmaxf(km, q); }
#pragma unroll
        for (int o = 1; o < 64; o <<= 1) km = fmaxf(km, __shfl_xor(km, o));
        if (F.lane == 63) wsum[F.wave] = incl;
        if (F.lane == 0) wmax[F.wave] = km;
        __syncthreads();
        float base = 0.f, kmx = 0.f;
#pragma unroll
        for (int w = 0; w < 8; ++w) { if (w < F.wave) base += wsum[w]; kmx = fmaxf(kmx, wmax[w]); }
        float run = base + incl - s;
#pragma unroll
        for (int i = 0; i < 16; ++i) { run += v[i]; v[i] = run; }
#pragma unroll
        for (int i = 0; i < 4; ++i) *(f32x4*)(Gt + (size_t)bh * SEQ + t0 + 4 * i) = (f32x4){v[4 * i], v[4 * i + 1], v[4 * i + 2], v[4 * i + 3]};
        if (F.tid == 0) kmax[bh] = sqrtf(kmx);
        __syncthreads();
    }
}
__device__ __forceinline__ void phase_final(const Frame& F, const bf16* hb, float* out, const float* gw) {
    f32x4 g4[4];
#pragma unroll
    for (int j = 0; j < 4; ++j) g4[j] = *(const f32x4*)(gw + 16 * F.lane + 4 * j);
    const int stride = F.G * 8;
    for (int m0 = blockIdx.x * 8 + F.wave; m0 < M; m0 += 2 * stride) { v4u a[2], b[2];
#pragma unroll
        for (int r = 0; r < 2; ++r) { const int m = (m0 + r * stride < M) ? m0 + r * stride : m0; const v4u* xr = (const v4u*)(hb + (size_t)m * D) + 2 * F.lane; a[r] = xr[0]; b[r] = xr[1]; }
#pragma unroll
        for (int r = 0; r < 2; ++r) { const int m = m0 + r * stride; if (m >= M) break; f32x4 v[4];
            v[0] = (f32x4){pg8::bflo(a[r].x), pg8::bfhi(a[r].x), pg8::bflo(a[r].y), pg8::bfhi(a[r].y)}; v[1] = (f32x4){pg8::bflo(a[r].z), pg8::bfhi(a[r].z), pg8::bflo(a[r].w), pg8::bfhi(a[r].w)};
            v[2] = (f32x4){pg8::bflo(b[r].x), pg8::bfhi(b[r].x), pg8::bflo(b[r].y), pg8::bfhi(b[r].y)}; v[3] = (f32x4){pg8::bflo(b[r].z), pg8::bfhi(b[r].z), pg8::bflo(b[r].w), pg8::bfhi(b[r].w)};
            float ss = 0.f;
#pragma unroll
            for (int j = 0; j < 4; ++j) ss += (v[j][0] * v[j][0] + v[j][1] * v[j][1]) + (v[j][2] * v[j][2] + v[j][3] * v[j][3]);
            const float rstd = pg8::rstd_of(wave_sum(ss)); f32x4* o = (f32x4*)(out + (size_t)m * D + 16 * F.lane);
#pragma unroll
            for (int j = 0; j < 4; ++j) o[j] = v[j] * rstd * g4[j]; } }
}

__device__ __forceinline__ void conv_w1(const Frame& F, const Params& P, int L, int b0 = 0) { conv_w<0>(F, kin(I_W1) + (size_t)L * D * FF, D, FF, 0, FF, (bf16*)(P.ws + OFF_W1), kin(I_MLPN) + L * D, b0); }
__device__ __forceinline__ void conv_w2(const Frame& F, const Params& P, int L, int b0 = 0) { conv_w<0>(F, kin(I_W2) + (size_t)L * FF * D, FF, D, 0, D, (bf16*)(P.ws + OFF_W2), nullptr, b0); }
__device__ __forceinline__ void conv_glu(const Frame& F, const Params& P, int L) { conv_w<1>(F, kin(I_WGLU) + (size_t)L * D * 2 * D, D, 2 * D, 0, 2 * D, (bf16*)(P.ws + OFF_MIX), nullptr); }
__device__ __forceinline__ void conv_attn(const Frame& F, const Params& P, int j, bool with_kv) {
    bf16* mix = (bf16*)(P.ws + OFF_MIX);
    conv_w<0>(F, kin(I_WQ) + (size_t)j * D * D, D, D, 0, D, mix, kin(I_MIXN) + (2 + j) * D);
    conv_w<0>(F, kin(I_WO) + (size_t)j * D * D, D, D, 0, D, mix + (size_t)3 * D * D, nullptr);
    if (with_kv) { conv_w<0>(F, kin(I_WKVF), D, 2064, 0, 2 * D, mix + (size_t)D * D, kin(I_KVN)); conv_wf(F, kin(I_WKVF), kin(I_KVN), (bf16*)(P.ws + OFF_WF)); }
}
__device__ __forceinline__ bool side_jobs(const Frame& F, const Params& P, int ph) {
    switch (ph) {
    case 0:  s5_tables(F, P, 0); conv_glu(F, P, 0); return true;
    case 2:  { const int b0 = (F.G > 128) ? 128 : 0; conv_w1(F, P, 0, b0); conv_w2(F, P, 0, b0); } return true;
    case 5:  conv_glu(F, P, 1); return true;
    case 6:  s5_tables(F, P, 1); return true;
    case 8:  { const int b0 = (F.G > 128) ? 128 : 0; conv_w1(F, P, 1, b0); conv_w2(F, P, 1, b0); } return true;
    case 11: conv_attn(F, P, 0, true); return true;
    case 14: { const int b0 = (F.G > 32) ? 32 : 0; conv_w1(F, P, 2, b0); conv_w2(F, P, 2, b0); } return true;
    case 17: conv_attn(F, P, 1, false); return true;
    case 18: conv_w1(F, P, 3); return true;
    case 19: conv_w2(F, P, 3); return true;
    default: return false;
    }
}

#define XB_TMO      128
#define XB_XCNT(j)  (256  + 64 * (j))
#define XB_XSUB(j)  (1280 + 64 * (j))
#define XB_XGEN(j)  (2304 + 64 * (j))
#define XB_TOP      3328
#define XB_TOPGEN   3392
#define XCD_BAR_WORDS 3456
#define XB_SPIN_CAP (1u << 18)

__device__ __forceinline__ unsigned xb_ld(unsigned* p)              { return __hip_atomic_load(p, __ATOMIC_RELAXED, __HIP_MEMORY_SCOPE_AGENT); }
__device__ __forceinline__ unsigned xb_add(unsigned* p, unsigned v) { return __hip_atomic_fetch_add(p, v, __ATOMIC_RELAXED, __HIP_MEMORY_SCOPE_AGENT); }
__device__ __forceinline__ unsigned xb_xcc_id() { return (unsigned)__builtin_amdgcn_s_getreg((3 << 11) | 20) & 0xFu; }
#define XB_SPIN(cond, bar) do { unsigned _sp = 0; while (cond) { __builtin_amdgcn_s_sleep(1); \
    if ((++_sp & 255u) == 0u) { if (xb_ld(&(bar)[XB_TMO])) break; if (_sp > XB_SPIN_CAP) { atomicAdd(&(bar)[XB_TMO], 1u); break; } } } } while (0)

struct XcdBarrier {
    unsigned* bar; unsigned x;
    volatile LAS unsigned* st;
};

__device__ __forceinline__ XcdBarrier xcd_barrier_post(unsigned* bar, volatile LAS unsigned* st) {
    XcdBarrier b; b.bar = bar; b.x = xb_xcc_id(); b.st = st;
    if (threadIdx.x == 0) (void)xb_add(&bar[XB_XCNT(b.x)], 1u);
    return b;
}
__device__ __forceinline__ void xcd_barrier_complete(unsigned* bar, unsigned x, unsigned& nloc, unsigned& nx) {
    const unsigned G = gridDim.x * gridDim.y * gridDim.z;
    unsigned sum, cnt, mine, sp = 0u;
    for (;;) {
        sum = 0u; cnt = 0u; mine = 0u;
#pragma unroll
        for (unsigned j = 0; j < 16; ++j) { const unsigned c = xb_ld(&bar[XB_XCNT(j)]); sum += c; cnt += (c > 0u) ? 1u : 0u; mine = (j == x) ? c : mine; }
        if (sum == G) break;
        __builtin_amdgcn_s_sleep(1);
        if ((++sp & 255u) == 0u) { if (xb_ld(&bar[XB_TMO])) break; if (sp > XB_SPIN_CAP) { atomicAdd(&bar[XB_TMO], 1u); break; } }
    }
    nloc = mine > 0u ? mine : 1u; nx = cnt > 0u ? cnt : 1u;
}

__device__ __forceinline__ void xcd_barrier(const XcdBarrier& b) {
    asm volatile("s_waitcnt vmcnt(0)" ::: "memory");
    __syncthreads();
    if (ltid() == 0) {
        unsigned* bar = b.bar;
        __builtin_amdgcn_s_waitcnt(0);
        unsigned nloc = b.st[0], nx = b.st[1];
        if (nloc == 0u) { xcd_barrier_complete(bar, b.x, nloc, nx); b.st[0] = nloc; b.st[1] = nx; }
        const unsigned old = xb_add(&bar[XB_XSUB(b.x)], 1u);
        const unsigned gen = old / nloc;
        if (old + 1u == (gen + 1u) * nloc) {
            __builtin_amdgcn_fence(__ATOMIC_RELEASE, "agent");
            asm volatile("s_waitcnt vmcnt(0)" ::: "memory");
            const unsigned og = xb_add(&bar[XB_TOP], 1u);
            const unsigned tg = og / nx;
            if (og + 1u == (tg + 1u) * nx) xb_add(&bar[XB_TOPGEN], 1u);
            else XB_SPIN(xb_ld(&bar[XB_TOPGEN]) == tg, bar);
            __builtin_amdgcn_fence(__ATOMIC_ACQUIRE, "agent");
            xb_add(&bar[XB_XGEN(b.x)], 1u);
            asm volatile("s_waitcnt vmcnt(0)" ::: "memory");
        } else {
            XB_SPIN(xb_ld(&bar[XB_XGEN(b.x)]) == gen, bar);
            __builtin_amdgcn_fence(__ATOMIC_ACQUIRE, "agent");
            asm volatile("s_waitcnt vmcnt(0)" ::: "memory");
        }
    }
    __syncthreads();
}

constexpr int LDS_RSTD = 131072 + 1024;
template <class Sched> __device__ __forceinline__ void precompute_rstd(const Frame& F, const Sched& S, const float* ss, int ns) {
    LAS float* rb = (LAS float*)(F.lds + LDS_RSTD); pg8::Unit u;
    for (int i = 0; i < 8 && S.next(i, u); ++i) { const int row = F.tid >> 1, half = F.tid & 1; const f32x4* p = (const f32x4*)(ss + (size_t)(u.pm * 256 + row) * ns + half * (ns >> 1));
        f32x4 v = p[0]; float s = (v[0] + v[1]) + (v[2] + v[3]); v = p[1]; s += (v[0] + v[1]) + (v[2] + v[3]);
        if (ns == 32) { v = p[2]; s += (v[0] + v[1]) + (v[2] + v[3]); v = p[3]; s += (v[0] + v[1]) + (v[2] + v[3]); }
        s += __shfl_xor(s, 1); if (!half) rb[i * 256 + row] = pg8::rstd_of(s); }
    __syncthreads();
}

__global__ void __launch_bounds__(512, 2) trunk_fwd(Params P) {
    extern __shared__ __attribute__((aligned(16))) unsigned char lds[];
    Frame F; F.lds = (LAS unsigned char*)lds; F.G = gridDim.x;
    volatile LAS unsigned* bst = (volatile LAS unsigned*)((LAS unsigned char*)lds + LDS_MISC);
    if (threadIdx.x < 2) bst[threadIdx.x] = 0u;
    __syncthreads();
    const bool one_launch = (P.ph_hi - P.ph_lo) > 1;
    XcdBarrier bar; bar.bar = (unsigned*)(P.ws + OFF_BAR); bar.x = 0; bar.st = bst;
    if (one_launch) bar = xcd_barrier_post((unsigned*)(P.ws + OFF_BAR), bst);
    unsigned char* ws = P.ws;
    float* ssp = (float*)(ws + OFF_SS);
    bf16* HB = (bf16*)(ws + OFF_HB);
    bool dup_done = false;
    for (int ph = P.ph_lo; ph < P.ph_hi; ++ph) {
        F.tid = ltid(); F.lane = F.tid & 63; F.wave = __builtin_amdgcn_readfirstlane(F.tid >> 6); { int g_ = (int)gridDim.x; asm volatile("" : "+s"(g_)); F.G = g_; }
        int kind, L;
        if (ph == 0) { kind = 0; L = 0; }
        else if (ph <= 12) { L = (ph - 1) / 6; const int k = (ph - 1) % 6; kind = (k < 2) ? 1 + k : 2 + k; }
        else if (ph <= 18) { L = 2; const int k = ph - 13; kind = (k < 4) ? 8 + k : 2 + k; }
        else if (ph <= 23) { L = 3; const int k = ph - 19; kind = (k == 0) ? 8 : (k <= 2 ? 9 + k : 3 + k); }
        else { kind = 12; L = 3; }
        if (DBG_SIDE_REPS > 1 && !dup_done) { side_jobs(F, P, ph); asm volatile("s_waitcnt vmcnt(0) lgkmcnt(0)" ::: "memory"); __syncthreads(); }
        if (((DBG_KM >> 0) & 1) && !dup_done && side_jobs(F, P, ph)) { asm volatile("s_waitcnt vmcnt(0) lgkmcnt(0)" ::: "memory"); __syncthreads(); }
        switch (kind) {
        case 1: if constexpr ((DBG_KM >> 1) & 1) { s5_expand(F, P, L); if (L == 0) phase_normu<false>(F, kin(I_X), kin(I_MIXN), (bf16*)(ws + OFF_UX)); else phase_normu<true>(F, HB, kin(I_MIXN) + L * D, (bf16*)(ws + OFF_UX)); } break;
        case 2: if constexpr ((DBG_KM >> 2) & 1) { pg8::Gemm g{(const bf16*)(ws + OFF_UX), (const bf16*)(ws + OFF_WEND), KUX, 512, 512}; pg8::OrderSloc S{F.G, (int)blockIdx.x};
                  pg8::EpiSlocScan E{(const pg8::f2v_t*)(ws + OFF_LAMPOW), (bf16*)(ws + OFF_UX)};
                  pg8::gemm_phase<pg8::EpiSlocScan, pg8::OrderSloc, true, true>(F.lds, g, S, E); } break;
        case 4: if constexpr ((DBG_KM >> 4) & 1) { pg8::Gemm g{(const bf16*)(ws + OFF_UX), (const bf16*)(ws + OFF_A2), KUX, KUX, KUX}; pg8::OrderY S{F.G, (int)blockIdx.x}; pg8::EpiY E{(bf16*)(ws + OFF_Z)};
                  pg8::gemm_phase<pg8::EpiY, pg8::OrderY, true, true>(F.lds, g, S, E); } break;
        case 5: if constexpr ((DBG_KM >> 5) & 1) { pg8::Gemm g{(const bf16*)(ws + OFF_Z), (const bf16*)(ws + OFF_MIX), 16, D, D, M * 32, 4 * M * 32, 16 * M * 32};      pg8::StaticOrder S; S.init(M, 2 * D, F.G, (int)blockIdx.x);
                  pg8::EpiRes<true> E{(L == 0) ? kin(I_X) : (const float*)nullptr, HB, ssp};
                  pg8::gemm_phase<pg8::EpiRes<true>, pg8::StaticOrder, true, true>(F.lds, g, S, E); } break;
        case 6: if constexpr ((DBG_KM >> 6) & 1) { const int ns = (L < 2) ? 32 : 16;
                  pg8::Gemm g{HB, (const bf16*)(ws + OFF_W1), D, D, D}; pg8::StaticOrder S; S.init(M, FF, F.G, (int)blockIdx.x); precompute_rstd(F, S, ssp, ns); pg8::EpiMLP1 E{(bf16*)(ws + OFF_A), (const LAS float*)(F.lds + LDS_RSTD)};
                  pg8::gemm_phase<pg8::EpiMLP1, pg8::StaticOrder, true, true>(F.lds, g, S, E); } break;
        case 7: case 11: if constexpr ((DBG_KM >> 7) & 1) { const bool mlp = (kind == 7); const bool need_ss = !(mlp && (L == 0 || L == 3));
                  pg8::Gemm g{mlp ? (const bf16*)(ws + OFF_A) : (const bf16*)(ws + OFF_Z), mlp ? (const bf16*)(ws + OFF_W2) : (const bf16*)(ws + OFF_MIX) + (size_t)3 * D * D, mlp ? 256 : D, mlp ? FF : D, mlp ? FF : D, 32, 128, mlp ? M * 512 : 512};
                  pg8::StaticOrder S; S.init(M, D, F.G, (int)blockIdx.x); pg8::EpiRes<false> E{(const float*)nullptr, HB, need_ss ? ssp : (float*)nullptr};
                  pg8::gemm_phase<pg8::EpiRes<false>, pg8::StaticOrder, true, true>(F.lds, g, S, E); } break;
        case 8: if constexpr ((DBG_KM >> 8) & 1) { const float* ss = ssp;
                  if (L == 2) phase_flogit(F, P, ss);
                  pg8::Gemm g{HB, (const bf16*)(ws + OFF_MIX), D, D, D}; pg8::StaticOrder S; S.init(M, (L == 2) ? 3 * D : D, F.G, (int)blockIdx.x);
                  static_assert(OFF_V == OFF_K + 32 * MiB && OFF_QO == OFF_K + 64 * MiB, "EpiQKV slot map"); precompute_rstd(F, S, ss, 16); pg8::EpiQKV E{(bf16*)(ws + OFF_K), (const LAS float*)(F.lds + LDS_RSTD), attn_body::C2};
                  pg8::gemm_phase<pg8::EpiQKV, pg8::StaticOrder, true, true>(F.lds, g, S, E); } break;
        case 9: if constexpr ((DBG_KM >> 9) & 1) { phase_fscan(F, P); } break;
        case 10: if constexpr ((DBG_KM >> 10) & 1) { const attn_body::AttnTensors AT{(const attn_body::bf16*)(ws + OFF_QO), (const attn_body::bf16*)(ws + OFF_K), (const attn_body::bf16*)(ws + OFF_V), (attn_body::bf16*)(ws + OFF_Z), (const float*)(ws + OFF_G), (const float*)(ws + OFF_KMAX)};
                  attn_body::attn_phase<32>((char*)lds, AT, (unsigned*)(ws + OFF_CTL) + 64 * (L - 2) + (dup_done ? 128 : 0)); } break;
        case 12: if constexpr ((DBG_KM >> 12) & 1) { phase_final(F, HB, P.out, kin(I_FINN)); } break;
        default: break;
        }
        if (DBG_DUP != 0u) { if (((DBG_DUP >> kind) & 1u) && !dup_done) { dup_done = true; --ph; xcd_barrier(bar); continue; } dup_done = false; }
        if (ph + 1 < P.ph_hi) {
            for (int r_ = 0; r_ < DBG_SYNC_REPS; ++r_) xcd_barrier(bar);
        }
        if (P.ph_hi < 0) cg::this_grid().sync();
    }
}

extern "C" void kernel_launch(void* const* d_in, const int* in_sizes, int n_in, void* d_out, int out_size, void* d_ws, size_t ws_size, hipStream_t stream) {
    static int grid = 0;
    if (grid == 0) {
        if (n_in != 20 || in_sizes[0] != M * D || out_size != M * D || ws_size < WS_END) { fprintf(stderr, "kernel_launch: unexpected shapes (n_in %d, in0 %d, out %d, ws %zu); nothing launched\n", n_in, n_in > 0 ? in_sizes[0] : -1, out_size, ws_size); grid = -1; return; }
        int dev = 0, cus = 0, per_cu = 0;
        if (hipGetDevice(&dev) != hipSuccess || hipDeviceGetAttribute(&cus, hipDeviceAttributeMultiprocessorCount, dev) != hipSuccess) { grid = -1; return; }
        if (hipFuncSetAttribute((const void*)trunk_fwd, hipFuncAttributeMaxDynamicSharedMemorySize, LDS_BYTES) != hipSuccess) { fprintf(stderr, "kernel_launch: hipFuncSetAttribute failed\n"); grid = -1; return; }
        if (hipOccupancyMaxActiveBlocksPerMultiprocessor(&per_cu, (const void*)trunk_fwd, 512, LDS_BYTES) != hipSuccess || per_cu < 1) { fprintf(stderr, "kernel_launch: occupancy query says %d\n", per_cu); per_cu = 1; }
        (void)hipGetLastError();
        grid = cus * per_cu;
    }
    if (grid < 0) return;
    (void)hipMemsetAsync((char*)d_ws + OFF_CTL, 0, ZERO_BYTES, stream);
    Params p{};
    for (int i = 0; i < 20; ++i) p.in[i] = (const float*)d_in[i];
    p.out = (float*)d_out; p.ws = (unsigned char*)d_ws;
#if MK_MULTI_LAUNCH
    for (int ph = 0; ph < NPH; ++ph) { p.ph_lo = ph; p.ph_hi = ph + 1; hipLaunchKernelGGL(trunk_fwd, dim3(grid), dim3(512), LDS_BYTES, stream, p); }
#else
    p.ph_lo = 0; p.ph_hi = NPH;
    void* args[] = {&p};
    const hipError_t e = hipLaunchCooperativeKernel((const void*)trunk_fwd, dim3(grid), dim3(512), args, LDS_BYTES, stream);
    if (e != hipSuccess) fprintf(stderr, "kernel_launch: cooperative launch failed: %s (grid %d)\n", hipGetErrorString(e), grid);
#endif
}
```
